# Optimizing an MI355X kernel written in HIP

```python
import math
import jax, jax.numpy as jnp
from jax import lax
import numpy as np

D_MODEL = 4096
BATCH = 4
SEQ = 2048
DEPTH = 2
DEC_BATCH = 1
DEC_SEQ = 8192
PAST_LEN = 128

HEAD_DIM = 128
RET_HEADS = 16
ATT_Q_HEADS = 16
ATT_KV_HEADS = 4
GQA_GROUP = ATT_Q_HEADS // ATT_KV_HEADS
RET_W = RET_HEADS * HEAD_DIM
ATT_Q_W = ATT_Q_HEADS * HEAD_DIM
ATT_KV_W = ATT_KV_HEADS * HEAD_DIM
MIX_W = RET_W + ATT_Q_W
IN_PROJ_W = 4 * RET_W + ATT_Q_W + 2 * ATT_KV_W
SPLITS = (RET_W, 2 * RET_W, 3 * RET_W, 4 * RET_W, 4 * RET_W + ATT_Q_W, 4 * RET_W + ATT_Q_W + ATT_KV_W)
RET_CHUNK = 128
Q_BLOCK = 128
GRID_W = 64
ROPE_THETA = 10000.0
MEM_TOKENS = 256
MEM_HEADS = 4
MEM_HEAD_DIM = 128
MEM_W = MEM_HEADS * MEM_HEAD_DIM
D_FF = 11008
CONV_W = 3
EPS = 1e-6

kernel_name = "hybrid_retention_gqa_encoder"

F32 = jnp.float32


def rms_norm(x, g):
    xf = x.astype(F32)
    y = xf * lax.rsqrt(jnp.mean(xf * xf, axis=-1, keepdims=True) + EPS)
    return (y * g.astype(F32)).astype(x.dtype)


def axial_rope_tables(seq_len):
    rows = seq_len // GRID_W
    r, c = jnp.meshgrid(jnp.arange(rows), jnp.arange(GRID_W), indexing="ij")
    r = r.reshape(-1).astype(F32)
    c = c.reshape(-1).astype(F32)
    half = HEAD_DIM // 2
    freqs = ROPE_THETA ** (-jnp.arange(0, half, 2, dtype=F32) / half)
    ang_r = r[:, None] * freqs
    ang_c = c[:, None] * freqs
    return (jnp.cos(ang_r), jnp.sin(ang_r), jnp.cos(ang_c), jnp.sin(ang_c))


def _rotate(x, cos, sin):
    x1, x2 = jnp.split(x, 2, axis=-1)
    cos = cos[:, None, :]
    sin = sin[:, None, :]
    return jnp.concatenate([x1 * cos - x2 * sin, x2 * cos + x1 * sin], axis=-1)


def apply_axial_rope(x, tables):
    cos_r, sin_r, cos_c, sin_c = tables
    xf = x.astype(F32)
    half = HEAD_DIM // 2
    out = jnp.concatenate([_rotate(xf[..., :half], cos_r, sin_r),
                           _rotate(xf[..., half:], cos_c, sin_c)], axis=-1)
    return out.astype(x.dtype)


def retention_one_direction(q, k, v, log_g, strict):
    B, H, S, dk = q.shape
    dv = v.shape[-1]
    nc = S // RET_CHUNK
    qc = q.reshape(B, H, nc, RET_CHUNK, dk)
    kc = k.reshape(B, H, nc, RET_CHUNK, dk)
    vc = v.reshape(B, H, nc, RET_CHUNK, dv)
    idx = jnp.arange(RET_CHUNK, dtype=F32)
    diff = idx[:, None] - idx[None, :]
    mask = (diff > 0) if strict else (diff >= 0)
    decay = jnp.where(mask, jnp.exp(jnp.maximum(diff, 0.0) * log_g[:, None, None]), 0.0)
    scores = jnp.einsum("bhncd,bhnmd->bhncm", qc, kc) * decay[None, :, None]
    intra = jnp.einsum("bhncm,bhnme->bhnce", scores, vc)
    zeta = jnp.exp((RET_CHUNK - 1 - idx)[None, :] * log_g[:, None])
    kv = jnp.einsum("bhnmd,hm,bhnme->nbhde", kc, zeta, vc)
    chunk_decay = jnp.exp(RET_CHUNK * log_g)[None, :, None, None]

    def step(state, kv_n):
        return chunk_decay * state + kv_n, state

    _, prev = lax.scan(step, jnp.zeros((B, H, dk, dv), F32), kv)
    xi = jnp.exp((idx + 1)[None, :] * log_g[:, None])
    inter = jnp.einsum("bhncd,hc,nbhde->bhnce", qc, xi, prev)
    return (intra + inter).reshape(B, H, S, dv)


def bidirectional_retention(q, k, v, g, log_g):
    B, S, H, dh = v.shape
    qf = q.astype(F32).transpose(0, 2, 1, 3)
    kf = (k.astype(F32) * HEAD_DIM ** -0.5).transpose(0, 2, 1, 3)
    vf = v.astype(F32).transpose(0, 2, 1, 3)
    fw = retention_one_direction(qf, kf, vf, log_g[0], False)
    bw = retention_one_direction(qf[:, :, ::-1], kf[:, :, ::-1], vf[:, :, ::-1], log_g[1], True)[:, :, ::-1]
    y = fw + bw
    y = y * lax.rsqrt(jnp.mean(y * y, axis=-1, keepdims=True) + EPS)
    y = y.transpose(0, 2, 1, 3)
    out = jax.nn.silu(g.astype(F32)) * y
    return out.reshape(B, S, H * dh).astype(v.dtype)


def blocked_gqa(q, k, v):
    B, S, _, dh = q.shape
    nb = S // Q_BLOCK
    qb = q.reshape(B, nb, Q_BLOCK, ATT_KV_HEADS, GQA_GROUP, dh).transpose(1, 0, 3, 4, 2, 5)
    scale = dh ** -0.5

    def one_block(qi):
        s = jnp.einsum("bkgqd,bskd->bkgqs", qi, k, preferred_element_type=F32) * scale
        p = jax.nn.softmax(s, axis=-1)
        return jnp.einsum("bkgqs,bskd->bkgqd", p.astype(v.dtype), v)

    o = lax.map(one_block, qb)
    return o.transpose(1, 0, 4, 2, 3, 5).reshape(B, S, ATT_Q_HEADS * dh)


def memory_cross_attention(xn, memn, w_cq, w_ckv, w_co):
    B, S, _ = xn.shape
    M = memn.shape[1]
    q = (xn @ w_cq).reshape(B, S, MEM_HEADS, MEM_HEAD_DIM)
    kv = (memn @ w_ckv).reshape(B, M, 2, MEM_HEADS, MEM_HEAD_DIM)
    k, v = kv[:, :, 0], kv[:, :, 1]
    s = jnp.einsum("bshd,bmhd->bhsm", q, k, preferred_element_type=F32) * MEM_HEAD_DIM ** -0.5
    p = jax.nn.softmax(s, axis=-1)
    o = jnp.einsum("bhsm,bmhd->bshd", p.astype(v.dtype), v).reshape(B, S, MEM_W)
    return o @ w_co


def conv_gated_ffn(xn, w_up, conv_w, conv_b, w_down):
    h = xn @ w_up
    hp = jnp.pad(h, ((0, 0), (1, 1), (0, 0)))
    c = hp[:, :-2] * conv_w[0] + hp[:, 1:-1] * conv_w[1] + hp[:, 2:] * conv_w[2] + conv_b
    a, u = jnp.split(c, 2, axis=-1)
    return (jax.nn.gelu(a, approximate=False) * u) @ w_down


def encoder_trunk(x, mem, w_in, w_out, ret_decay_logit, q_norm, k_norm, norm_mix, norm_cross,
                  norm_mem, w_cq, w_ckv, w_co, norm_ffn, w_up, conv_w, conv_b, w_down, norm_final):
    B, S, _ = x.shape
    rope = axial_rope_tables(S)
    for l in range(DEPTH):
        n = rms_norm(x, norm_mix[l])
        proj = n @ w_in[l]
        rq, rk, rv, rg, aq, ak, av = jnp.split(proj, SPLITS, axis=-1)
        rq = apply_axial_rope(rq.reshape(B, S, RET_HEADS, HEAD_DIM), rope)
        rk = apply_axial_rope(rk.reshape(B, S, RET_HEADS, HEAD_DIM), rope)
        rv = rv.reshape(B, S, RET_HEADS, HEAD_DIM)
        rg = rg.reshape(B, S, RET_HEADS, HEAD_DIM)
        log_g = jax.nn.log_sigmoid(ret_decay_logit[l].astype(F32))
        ret_out = bidirectional_retention(rq, rk, rv, rg, log_g)
        aq = rms_norm(aq.reshape(B, S, ATT_Q_HEADS, HEAD_DIM), q_norm[l])
        ak = rms_norm(ak.reshape(B, S, ATT_KV_HEADS, HEAD_DIM), k_norm[l])
        aq = apply_axial_rope(aq, rope)
        ak = apply_axial_rope(ak, rope)
        av = av.reshape(B, S, ATT_KV_HEADS, HEAD_DIM)
        att_out = blocked_gqa(aq, ak, av)
        x = x + jnp.concatenate([ret_out, att_out], axis=-1) @ w_out[l]
        memn = rms_norm(mem, norm_mem[l])
        x = x + memory_cross_attention(rms_norm(x, norm_cross[l]), memn, w_cq[l], w_ckv[l], w_co[l])
        x = x + conv_gated_ffn(rms_norm(x, norm_ffn[l]), w_up[l], conv_w[l], conv_b[l], w_down[l])
    return rms_norm(x, norm_final)


def setup_inputs(seed: int = 0) -> dict:
    key = jax.random.key(seed)
    ks = jax.random.split(key, 24)
    nrm = jax.random.normal
    h = jnp.arange(RET_HEADS, dtype=F32)
    base_logit = jnp.log(2.0 ** (5.0 + h) - 1.0)
    return {
        "x_prompt": nrm(ks[0], (BATCH, SEQ, D_MODEL), F32),
        "x_sample": nrm(ks[1], (DEC_BATCH, DEC_SEQ, D_MODEL), F32),
        "mem_prompt": nrm(ks[2], (BATCH, MEM_TOKENS, D_MODEL), F32),
        "mem_sample": nrm(ks[3], (DEC_BATCH, MEM_TOKENS, D_MODEL), F32),
        "w_in": nrm(ks[4], (DEPTH, D_MODEL, IN_PROJ_W), F32) * D_MODEL ** -0.5,
        "w_out": nrm(ks[5], (DEPTH, MIX_W, D_MODEL), F32) * MIX_W ** -0.5,
        "ret_decay_logit": base_logit[None, None, :] + 0.05 * nrm(ks[6], (DEPTH, 2, RET_HEADS), F32),
        "q_norm": 1.0 + 0.02 * nrm(ks[7], (DEPTH, HEAD_DIM), F32),
        "k_norm": 1.0 + 0.02 * nrm(ks[8], (DEPTH, HEAD_DIM), F32),
        "norm_mix": 1.0 + 0.02 * nrm(ks[9], (DEPTH, D_MODEL), F32),
        "norm_cross": 1.0 + 0.02 * nrm(ks[10], (DEPTH, D_MODEL), F32),
        "norm_mem": 1.0 + 0.02 * nrm(ks[11], (DEPTH, D_MODEL), F32),
        "w_cq": nrm(ks[12], (DEPTH, D_MODEL, MEM_W), F32) * D_MODEL ** -0.5,
        "w_ckv": nrm(ks[13], (DEPTH, D_MODEL, 2 * MEM_W), F32) * D_MODEL ** -0.5,
        "w_co": nrm(ks[14], (DEPTH, MEM_W, D_MODEL), F32) * MEM_W ** -0.5,
        "norm_ffn": 1.0 + 0.02 * nrm(ks[15], (DEPTH, D_MODEL), F32),
        "w_up": nrm(ks[16], (DEPTH, D_MODEL, 2 * D_FF), F32) * D_MODEL ** -0.5,
        "conv_w": nrm(ks[17], (DEPTH, CONV_W, 2 * D_FF), F32) * CONV_W ** -0.5,
        "conv_b": 0.02 * nrm(ks[18], (DEPTH, 2 * D_FF), F32),
        "w_down": nrm(ks[19], (DEPTH, D_FF, D_MODEL), F32) * D_FF ** -0.5,
        "norm_final": 1.0 + 0.02 * nrm(ks[20], (D_MODEL,), F32),
    }


def reference(x_prompt, x_sample, mem_prompt, mem_sample, w_in, w_out, ret_decay_logit, q_norm, k_norm,
              norm_mix, norm_cross, norm_mem, w_cq, w_ckv, w_co, norm_ffn, w_up, conv_w, conv_b, w_down,
              norm_final):
    y_prompt = encoder_trunk(x_prompt, mem_prompt, w_in, w_out, ret_decay_logit, q_norm, k_norm, norm_mix,
                             norm_cross, norm_mem, w_cq, w_ckv, w_co, norm_ffn, w_up, conv_w, conv_b, w_down,
                             norm_final)
    y_sample = encoder_trunk(x_sample, mem_sample, w_in, w_out, ret_decay_logit, q_norm, k_norm, norm_mix,
                             norm_cross, norm_mem, w_cq, w_ckv, w_co, norm_ffn, w_up, conv_w, conv_b, w_down,
                             norm_final)
    return (y_prompt, y_sample)
```

```cpp
#include <hip/hip_runtime.h>
#include <cstdio>
#include <cstdint>

#define GAS __attribute__((address_space(1)))
#define LAS __attribute__((address_space(3)))
typedef unsigned short bf16_t;
typedef short bf16x8 __attribute__((ext_vector_type(8)));
typedef short s16x4 __attribute__((ext_vector_type(4)));
typedef float f32x4 __attribute__((ext_vector_type(4)));
typedef float f32x2 __attribute__((ext_vector_type(2)));
typedef float f32x16 __attribute__((ext_vector_type(16)));
typedef unsigned u32x4 __attribute__((ext_vector_type(4)));
typedef unsigned u32x2 __attribute__((ext_vector_type(2)));

constexpr int DM = 4096, MROWS = 16384, NIN = 11264, DFF = 11008, NUP = 22016, MEMROWS = 1280, MEMW = 512;
constexpr float EPS = 1e-6f;
#ifndef MK_N_LAUNCHES
#define MK_N_LAUNCHES 1
#endif

__device__ __forceinline__ unsigned cvt_pk_bf16(float lo, float hi) { unsigned r; asm volatile("v_cvt_pk_bf16_f32 %0, %1, %2" : "=v"(r) : "v"(lo), "v"(hi)); return r; }
__device__ __forceinline__ float bf_lo(unsigned w) { return __uint_as_float(w << 16); }
__device__ __forceinline__ float bf_hi(unsigned w) { return __uint_as_float(w & 0xffff0000u); }
__device__ __forceinline__ float bf2f(bf16_t b) { return __uint_as_float(((unsigned)b) << 16); }
__device__ __forceinline__ bf16_t f2bf(float f) { return (bf16_t)(cvt_pk_bf16(f, 0.f) & 0xffffu); }

namespace pg8 {
#define PG8_LAS __attribute__((address_space(3)))
constexpr int BM = 256, BK = 64, HALF = 128, HTB = HALF * BK * 2  , STAGE_BYTES = 8 * HTB, NXCD = 8, WGM = 8;

__host__ __device__ __forceinline__ int lds_byte(int r, int c) { const int st = (r >> 4) * 2 + (c >> 5), rr = r & 15, cc = c & 31, ob = rr * 64 + cc * 2; return st * 1024 + (ob ^ (((ob >> 9) & 1) << 5)); }
__host__ __device__ __forceinline__ void stage_rc(int b, int& R, int& C) { const int st = b / 1024, sb = b % 1024, swz = sb ^ (((sb >> 9) & 1) << 5); R = (st >> 1) * 16 + swz / 64; C = (st & 1) * 32 + (swz % 64) / 2; }
__host__ __device__ __forceinline__ int perm32(int rho) { const int n = rho >> 4, i = rho & 15; return 8 * (i >> 2) + 4 * n + (i & 3); }

struct Unit { int pm, pn, kt0, nkt, fin; };
struct Gemm { const bf16_t* A; const bf16_t* Bt; int M, N, K; };

struct StaticOrder {
    int nM, nN, nwg, G, c, pn_inner;
    __host__ __device__ void init(int M, int N, int G_, int c_, int pn_inner_ = 0) { nM = M / BM; nN = N / BM; nwg = nM * nN; G = G_; c = c_; pn_inner = pn_inner_; }
    __host__ __device__ bool next(int i, Unit& u) const { return map((long)i * G + c, u); }
    __host__ __device__ bool map(long L, Unit& u) const {
        if (L >= nwg) return false;
        int wgid = (int)L; { const int q = nwg / NXCD, r = nwg % NXCD, xcd = wgid % NXCD, off = wgid / NXCD; wgid = (xcd < r ? xcd * (q + 1) : r * (q + 1) + (xcd - r) * q) + off; }
        const int nig = WGM * nN, gid = wgid / nig, fm = gid * WGM, gsz = (nM - fm) < WGM ? (nM - fm) : WGM;
        if (pn_inner) { u.pm = fm + ((wgid % nig) / nN); u.pn = (wgid % nig) % nN; } else { u.pm = fm + ((wgid % nig) % gsz); u.pn = (wgid % nig) / gsz; }
        u.kt0 = 0; u.nkt = 0; u.fin = 1; return true;
    }
    __device__ __forceinline__ void a_ready(const Unit&) const {}
    __device__ __forceinline__ void done(const Unit&) const {}
};

struct AliasOrder : StaticOrder {
    int am, an;
    __device__ bool next(int i, Unit& u) const { const bool r = StaticOrder::next(i, u); u.pm &= am; u.pn &= an; return r; }
};
struct SplitLastOrder : StaticOrder {
    int full, ntl;
    __device__ bool next(int i, Unit& u) const {
        if (i < full) return StaticOrder::next(i, u);
        if (i > full) return false;
        const int half = G / 2, cc = c < half ? c : c - half;
        if (!map((long)full * G + cc, u)) return false;
        u.nkt = ntl / 2; u.kt0 = c < half ? 0 : ntl / 2; u.fin = c < half ? 2 : 3; return true;
    }
};

#define SPLITK_HANDOFF() \
    if (u.fin == 3) { \
            f32x4* dst = (f32x4*)scr + ((size_t)slot * 32) * 512 + (((wr * 4 + wc) * 4 + fq) * 16 + fr); \
_Pragma("unroll") \
            for (int ai = 0; ai < 2; ++ai) \
_Pragma("unroll") \
                for (int bj = 0; bj < 2; ++bj) \
_Pragma("unroll") \
                    for (int m = 0; m < 4; ++m) \
_Pragma("unroll") \
                        for (int n = 0; n < 2; ++n) { const int k = ((ai * 2 + bj) * 4 + m) * 2 + n; f32x4* p = dst + (size_t)k * 512; \
                            asm volatile("global_store_dwordx4 %0, %1, off sc1" :: "v"(p), "v"(acc[ai][bj][m][n]) : "memory"); } \
            asm volatile("s_waitcnt vmcnt(0)" ::: "memory"); __builtin_amdgcn_s_barrier(); asm volatile("" ::: "memory"); \
            if (wr == 0 && wc == 0 && fq == 0 && fr == 0) __hip_atomic_store(flag + slot * 16, 1u, __ATOMIC_RELAXED, __HIP_MEMORY_SCOPE_AGENT); \
            return; \
        } \
    if (u.fin == 2) { \
            if (wr == 0 && wc == 0) { unsigned sp = 0; \
                while ((unsigned)__builtin_amdgcn_readfirstlane(__hip_atomic_load(flag + slot * 16, __ATOMIC_RELAXED, __HIP_MEMORY_SCOPE_AGENT)) == 0u) { __builtin_amdgcn_s_sleep(2); if (++sp > (1u << 20)) break; } \
                __builtin_amdgcn_fence(__ATOMIC_ACQUIRE, "agent"); asm volatile("s_waitcnt vmcnt(0)" ::: "memory"); } \
            asm volatile("" ::: "memory"); __builtin_amdgcn_s_barrier(); asm volatile("" ::: "memory"); \
            const f32x4* src = (const f32x4*)scr + ((size_t)slot * 32) * 512 + (((wr * 4 + wc) * 4 + fq) * 16 + fr); \
_Pragma("unroll") \
            for (int ai = 0; ai < 2; ++ai) \
_Pragma("unroll") \
                for (int bj = 0; bj < 2; ++bj) \
_Pragma("unroll") \
                    for (int m = 0; m < 4; ++m) \
_Pragma("unroll") \
                        for (int n = 0; n < 2; ++n) { const int k = ((ai * 2 + bj) * 4 + m) * 2 + n; acc[ai][bj][m][n] += src[(size_t)k * 512]; } \
        }

__device__ __forceinline__ f32x2 gelu_pk(f32x2 v) {
    const f32x2 av = __builtin_elementwise_abs(v), d = av * 0.2316418882f + 1.0f;
    f32x2 t; t.x = __builtin_amdgcn_rcpf(d.x); t.y = __builtin_amdgcn_rcpf(d.y);
    f32x2 q = t * 0.5307027145f + (-0.7265760135f); q = q * t + 0.7107068705f; q = q * t + (-0.142248368f); q = q * t + 0.127414796f; q = q * t;
    const f32x2 s = (v * v) * (-0.72134752044f);
    f32x2 e; e.x = __builtin_amdgcn_exp2f(s.x); e.y = __builtin_amdgcn_exp2f(s.y);
    const f32x2 m = v * (q * e), r = v - m;
    f32x2 o; o.x = v.x < 0.f ? m.x : r.x; o.y = v.y < 0.f ? m.y : r.y; return o;
}

struct EpiProj {
    static constexpr bool PERM = true, AFTER_DRAIN = false;
    bf16_t* O; int ldc; const unsigned long long* ssq; const float* ssqf;
    unsigned long long* scr; unsigned* flag; int slot;
    __device__ __forceinline__ void operator()(f32x4 (&acc)[2][2][4][2], const Unit& u, int wr, int wc, int fr_, int fq_, PG8_LAS unsigned char*) const {
        int fr = fr_, fq = fq_; asm volatile("" : "+v"(fr), "+v"(fq));
        SPLITK_HANDOFF()
        const int row0 = u.pm * BM + wr * 64 + fr, col0 = u.pn * BM + wc * 32 + 8 * fq;
        float rsv[8];
        if (ssq) { unsigned long long q[8];
#pragma unroll
            for (int k = 0; k < 8; ++k) q[k] = ssq[row0 + (k >> 2) * HALF + (k & 3) * 16];
            asm volatile("" : "+v"(q[0]), "+v"(q[1]), "+v"(q[2]), "+v"(q[3]), "+v"(q[4]), "+v"(q[5]), "+v"(q[6]), "+v"(q[7]));
#pragma unroll
            for (int k = 0; k < 8; ++k) rsv[k] = __builtin_amdgcn_rsqf((float)q[k] * (1.0f / 1048576.0f / 4096.0f) + EPS);
        } else { float q[8];
#pragma unroll
            for (int k = 0; k < 8; ++k) q[k] = ssqf[row0 + (k >> 2) * HALF + (k & 3) * 16];
            asm volatile("" : "+v"(q[0]), "+v"(q[1]), "+v"(q[2]), "+v"(q[3]), "+v"(q[4]), "+v"(q[5]), "+v"(q[6]), "+v"(q[7]));
#pragma unroll
            for (int k = 0; k < 8; ++k) rsv[k] = __builtin_amdgcn_rsqf(q[k] * (1.0f / 4096.0f) + EPS);
        }
#pragma unroll
        for (int ai = 0; ai < 2; ++ai)
#pragma unroll
            for (int m = 0; m < 4; ++m) { const int row = row0 + ai * HALF + m * 16; const float rs = rsv[ai * 4 + m];
                bf16_t* rowp = O + (size_t)row * ldc + col0;
#pragma unroll
                for (int bj = 0; bj < 2; ++bj) { const f32x4 v0 = acc[ai][bj][m][0] * rs, v1 = acc[ai][bj][m][1] * rs;
                    u32x4 w; w.x = cvt_pk_bf16(v0[0], v0[1]); w.y = cvt_pk_bf16(v0[2], v0[3]); w.z = cvt_pk_bf16(v1[0], v1[1]); w.w = cvt_pk_bf16(v1[2], v1[3]);
                    *(u32x4*)(rowp + bj * HALF) = w; } }
    }
};
struct EpiNull {
    static constexpr bool PERM = true, AFTER_DRAIN = false;
    float* sink;
    __device__ __forceinline__ void operator()(f32x4 (&acc)[2][2][4][2], const Unit& u, int wr, int wc, int fr, int fq, PG8_LAS unsigned char*) const {
        float s = 0.f;
#pragma unroll
        for (int ai = 0; ai < 2; ++ai)
#pragma unroll
            for (int bj = 0; bj < 2; ++bj)
#pragma unroll
                for (int m = 0; m < 4; ++m)
#pragma unroll
                    for (int n = 0; n < 2; ++n) s += acc[ai][bj][m][n][0] + acc[ai][bj][m][n][1] + acc[ai][bj][m][n][2] + acc[ai][bj][m][n][3];
        if (s == 123456.789f) sink[u.pm + wr + wc + fr + fq] = s;
    }
};
struct EpiProjRope {
    static constexpr bool PERM = true, AFTER_DRAIN = false;
    bf16_t* O; const unsigned long long* ssq; const f32x2* rope; const float* qn; const float* kn;
    __device__ __forceinline__ void operator()(f32x4 (&acc)[2][2][4][2], const Unit& u, int wr, int wc, int fr_, int fq_, PG8_LAS unsigned char* xl) const {
        int fr = fr_, fq = fq_; asm volatile("" : "+v"(fr), "+v"(fq));
        const int row0 = u.pm * BM + wr * 64 + fr, col0 = u.pn * BM + wc * 32 + 8 * fq;
        const int kind = u.pn < 16 ? 1 : (u.pn >= 32 && u.pn < 42 ? 2 : 0);
        const int qp = 4 * wc + fq, hf = qp >> 3, fi = 4 * (qp & 7);
        float rsv[8];
        { unsigned long long q[8];
#pragma unroll
            for (int k = 0; k < 8; ++k) q[k] = ssq[row0 + (k >> 2) * HALF + (k & 3) * 16];
            asm volatile("" : "+v"(q[0]), "+v"(q[1]), "+v"(q[2]), "+v"(q[3]), "+v"(q[4]), "+v"(q[5]), "+v"(q[6]), "+v"(q[7]));
#pragma unroll
            for (int k = 0; k < 8; ++k) rsv[k] = __builtin_amdgcn_rsqf((float)q[k] * (1.0f / 1048576.0f / 4096.0f) + EPS); }
#pragma unroll
        for (int ai = 0; ai < 2; ++ai)
#pragma unroll
            for (int m = 0; m < 4; ++m) { const float rs = rsv[ai * 4 + m];
#pragma unroll
                for (int bj = 0; bj < 2; ++bj) { acc[ai][bj][m][0] *= rs; acc[ai][bj][m][1] *= rs; } }
        if (kind == 2) {
            PG8_LAS float* PART = (PG8_LAS float*)xl;
#pragma unroll
            for (int ai = 0; ai < 2; ++ai)
#pragma unroll
                for (int m = 0; m < 4; ++m)
#pragma unroll
                    for (int bj = 0; bj < 2; ++bj) { const f32x4 a = acc[ai][bj][m][0], b = acc[ai][bj][m][1];
                        float s = ((a[0] * a[0] + a[1] * a[1]) + (a[2] * a[2] + a[3] * a[3])) + ((b[0] * b[0] + b[1] * b[1]) + (b[2] * b[2] + b[3] * b[3]));
                        s += __shfl_xor(s, 16); s += __shfl_xor(s, 32);
                        if (fq == 0) PART[((ai * HALF + wr * 64 + m * 16 + fr) * 2 + bj) * 4 + wc] = s; }
            asm volatile("s_waitcnt lgkmcnt(0)" ::: "memory"); __builtin_amdgcn_s_barrier(); asm volatile("" ::: "memory");
            const float* gn = (u.pn < 40) ? qn : kn;
            const f32x4 g0 = *(const f32x4*)(gn + 64 * hf + fi), g1 = *(const f32x4*)(gn + 64 * hf + fi + 32);
#pragma unroll
            for (int ai = 0; ai < 2; ++ai)
#pragma unroll
                for (int m = 0; m < 4; ++m)
#pragma unroll
                    for (int bj = 0; bj < 2; ++bj) { const f32x4 ps = *(const PG8_LAS f32x4*)(PART + ((ai * HALF + wr * 64 + m * 16 + fr) * 2 + bj) * 4);
                        const float rh = __builtin_amdgcn_rsqf(((ps[0] + ps[1]) + (ps[2] + ps[3])) * (1.0f / 128.0f) + EPS);
                        acc[ai][bj][m][0] *= g0 * rh; acc[ai][bj][m][1] *= g1 * rh; }
        }
#pragma unroll
        for (int ai = 0; ai < 2; ++ai)
#pragma unroll
            for (int m = 0; m < 4; ++m) { const int row = row0 + ai * HALF + m * 16;
                bf16_t* rowp = O + (size_t)row * NIN + col0;
                f32x4 cs0 = {1.f, 0.f, 1.f, 0.f}, cs1 = cs0;
                if (kind != 0) { const int t = row < 8192 ? (row & 2047) : (row - 8192); const int pos = hf ? (t & 63) : (t >> 6);
                    const f32x4* rp = (const f32x4*)(rope + pos * 32 + fi); cs0 = rp[0]; cs1 = rp[1]; }
#pragma unroll
                for (int bj = 0; bj < 2; ++bj) { f32x4 v0 = acc[ai][bj][m][0], v1 = acc[ai][bj][m][1];
                    if (kind != 0) { const f32x4 c = {cs0[0], cs0[2], cs1[0], cs1[2]}, s = {cs0[1], cs0[3], cs1[1], cs1[3]};
                        const f32x4 y0 = v0 * c - v1 * s, y1 = v1 * c + v0 * s; v0 = y0; v1 = y1; }
                    u32x4 w; w.x = cvt_pk_bf16(v0[0], v0[1]); w.y = cvt_pk_bf16(v0[2], v0[3]); w.z = cvt_pk_bf16(v1[0], v1[1]); w.w = cvt_pk_bf16(v1[2], v1[3]);
                    __builtin_nontemporal_store(w, (u32x4*)(rowp + bj * HALF)); } }
    }
};
struct EpiRes {
    static constexpr bool PERM = true, AFTER_DRAIN = false;
    bf16_t* xb; unsigned long long* ssq_out;
    __device__ __forceinline__ void operator()(f32x4 (&acc)[2][2][4][2], const Unit& u, int wr, int wc, int fr_, int fq_, PG8_LAS unsigned char*) const {
        int fr = fr_, fq = fq_; asm volatile("" : "+v"(fr), "+v"(fq));
        const int row0 = u.pm * BM + wr * 64 + fr, col0 = u.pn * BM + wc * 32 + 8 * fq;
#pragma unroll
        for (int ai = 0; ai < 2; ++ai) {
            u32x4 xv[4][2];
#pragma unroll
            for (int m = 0; m < 4; ++m)
#pragma unroll
                for (int bj = 0; bj < 2; ++bj) xv[m][bj] = *(const u32x4*)(xb + (size_t)(row0 + ai * HALF + m * 16) * DM + col0 + bj * HALF);
#pragma unroll
            for (int m = 0; m < 4; ++m) { const int row = row0 + ai * HALF + m * 16; bf16_t* rowp = xb + (size_t)row * DM + col0; float s = 0.f;
#pragma unroll
                for (int bj = 0; bj < 2; ++bj) { const u32x4 x = xv[m][bj];
                    const f32x4 v0 = (f32x4){bf_lo(x.x), bf_hi(x.x), bf_lo(x.y), bf_hi(x.y)} + acc[ai][bj][m][0], v1 = (f32x4){bf_lo(x.z), bf_hi(x.z), bf_lo(x.w), bf_hi(x.w)} + acc[ai][bj][m][1];
                    u32x4 w; w.x = cvt_pk_bf16(v0[0], v0[1]); w.y = cvt_pk_bf16(v0[2], v0[3]); w.z = cvt_pk_bf16(v1[0], v1[1]); w.w = cvt_pk_bf16(v1[2], v1[3]);
                    *(u32x4*)(rowp + bj * HALF) = w;
                    s += ((v0[0] * v0[0] + v0[1] * v0[1]) + (v0[2] * v0[2] + v0[3] * v0[3])) + ((v1[0] * v1[0] + v1[1] * v1[1]) + (v1[2] * v1[2] + v1[3] * v1[3])); }
                s += __shfl_xor(s, 16); s += __shfl_xor(s, 32);
                if (fq == 0) __hip_atomic_fetch_add(ssq_out + row, (unsigned long long)(s * 1048576.0f + 0.5f), __ATOMIC_RELAXED, __HIP_MEMORY_SCOPE_AGENT); }
            asm volatile("" ::: "memory");
        }
    }
};
struct EpiResFinal {
    static constexpr bool PERM = true, AFTER_DRAIN = false;
    const bf16_t* xb; unsigned long long* ssq; unsigned* cnt; const float* gain; float* out;
    __device__ __forceinline__ void operator()(f32x4 (&acc)[2][2][4][2], const Unit& u, int wr, int wc, int fr_, int fq_, PG8_LAS unsigned char* xl) const {
        int fr = fr_, fq = fq_; asm volatile("" : "+v"(fr), "+v"(fq));
        const int row0 = u.pm * BM + wr * 64 + fr, col0 = u.pn * BM + wc * 32 + 8 * fq;
#pragma unroll
        for (int ai = 0; ai < 2; ++ai) {
            u32x4 xv[4][2];
#pragma unroll
            for (int m = 0; m < 4; ++m)
#pragma unroll
                for (int bj = 0; bj < 2; ++bj) xv[m][bj] = *(const u32x4*)(xb + (size_t)(row0 + ai * HALF + m * 16) * DM + col0 + bj * HALF);
#pragma unroll
            for (int m = 0; m < 4; ++m) { const int row = row0 + ai * HALF + m * 16; float s = 0.f;
#pragma unroll
                for (int bj = 0; bj < 2; ++bj) { const u32x4 x = xv[m][bj];
                    const f32x4 v0 = (f32x4){bf_lo(x.x), bf_hi(x.x), bf_lo(x.y), bf_hi(x.y)} + acc[ai][bj][m][0], v1 = (f32x4){bf_lo(x.z), bf_hi(x.z), bf_lo(x.w), bf_hi(x.w)} + acc[ai][bj][m][1];
                    acc[ai][bj][m][0] = v0; acc[ai][bj][m][1] = v1;
                    s += ((v0[0] * v0[0] + v0[1] * v0[1]) + (v0[2] * v0[2] + v0[3] * v0[3])) + ((v1[0] * v1[0] + v1[1] * v1[1]) + (v1[2] * v1[2] + v1[3] * v1[3])); }
                s += __shfl_xor(s, 16); s += __shfl_xor(s, 32);
                if (fq == 0) __hip_atomic_fetch_add(ssq + row, (unsigned long long)(s * 1048576.0f + 0.5f), __ATOMIC_RELAXED, __HIP_MEMORY_SCOPE_AGENT); }
            asm volatile("" ::: "memory");
        }
        f32x4 g[2][2];
#pragma unroll
        for (int bj = 0; bj < 2; ++bj) { g[bj][0] = *(const f32x4*)(gain + col0 + bj * HALF); g[bj][1] = *(const f32x4*)(gain + col0 + bj * HALF + 4); }
        asm volatile("s_waitcnt vmcnt(0)" ::: "memory"); __builtin_amdgcn_s_barrier(); asm volatile("" ::: "memory");
        PG8_LAS float* RS = (PG8_LAS float*)xl;
        if (wr == 0 && wc == 0) {
            unsigned* c = cnt + u.pm * 16;
            if (fq == 0 && fr == 0) __hip_atomic_fetch_add(c, 1u, __ATOMIC_RELAXED, __HIP_MEMORY_SCOPE_AGENT);
            unsigned sp = 0;
            while ((unsigned)__builtin_amdgcn_readfirstlane(__hip_atomic_load(c, __ATOMIC_RELAXED, __HIP_MEMORY_SCOPE_AGENT)) < 16u) { __builtin_amdgcn_s_sleep(2); if (++sp > (1u << 20)) break; }
            __builtin_amdgcn_fence(__ATOMIC_ACQUIRE, "agent");
            const unsigned long long* p = ssq + u.pm * BM + (fq * 16 + fr); unsigned long long s0, s1, s2, s3;
            asm volatile("global_load_dwordx2 %0, %4, off sc1\n\tglobal_load_dwordx2 %1, %4, off offset:512 sc1\n\tglobal_load_dwordx2 %2, %4, off offset:1024 sc1\n\tglobal_load_dwordx2 %3, %4, off offset:1536 sc1\n\ts_waitcnt vmcnt(0)"
                         : "=&v"(s0), "=&v"(s1), "=&v"(s2), "=&v"(s3) : "v"(p) : "memory");
            const int l64 = fq * 16 + fr;
            RS[l64] = __builtin_amdgcn_rsqf((float)s0 * (1.0f / 1048576.0f / 4096.0f) + EPS); RS[64 + l64] = __builtin_amdgcn_rsqf((float)s1 * (1.0f / 1048576.0f / 4096.0f) + EPS);
            RS[128 + l64] = __builtin_amdgcn_rsqf((float)s2 * (1.0f / 1048576.0f / 4096.0f) + EPS); RS[192 + l64] = __builtin_amdgcn_rsqf((float)s3 * (1.0f / 1048576.0f / 4096.0f) + EPS);
        }
        __syncthreads();
#pragma unroll
        for (int ai = 0; ai < 2; ++ai)
#pragma unroll
            for (int m = 0; m < 4; ++m) { const int rt = wr * 64 + fr + ai * HALF + m * 16; const float rs = RS[rt]; float* rowp = out + (size_t)(u.pm * BM + rt) * DM + col0;
#pragma unroll
                for (int bj = 0; bj < 2; ++bj) { __builtin_nontemporal_store(acc[ai][bj][m][0] * rs * g[bj][0], (f32x4*)(rowp + bj * HALF)); __builtin_nontemporal_store(acc[ai][bj][m][1] * rs * g[bj][1], (f32x4*)(rowp + bj * HALF + 4)); } }
    }
};
struct EpiConv {
    static constexpr bool PERM = true, AFTER_DRAIN = false;
    unsigned char* ws; size_t gh_off, hb_off, ssq_off; const float* cw; const float* cb; unsigned long long* scr; unsigned* flag; int slot;
    __device__ __forceinline__ void operator()(f32x4 (&acc)[2][2][4][2], const Unit& u, int wr, int wc, int fr_, int fq_, PG8_LAS unsigned char* xl) const {
        int fr = fr_, fq = fq_; asm volatile("" : "+v"(fr), "+v"(fq));
        PG8_LAS float* BND = (PG8_LAS float*)xl;
        bf16_t* GH = (bf16_t*)(ws + gh_off); float* HB = (float*)(ws + hb_off); const unsigned long long* ssq = (const unsigned long long*)(ws + ssq_off);
        const int colw = wc * 32 + 8 * fq;
        SPLITK_HANDOFF()
        PG8_LAS float* CW = (PG8_LAS float*)(xl + 8192);
        const int cwi = (((wr * 4 + wc) * 4 + fq) * 16 + fr) * 2, cwa = cwi >> 8, cwh = (cwi >> 7) & 1, cwc = cwi & 127;
        const f32x2 cwreg = *(const f32x2*)((cwa < 3 ? cw + cwa * NUP : cb) + cwh * DFF + u.pn * 128 + cwc);
        float rsv[8];
        { unsigned long long q[8]; const int row0 = u.pm * BM + wr * 64 + fr;
#pragma unroll
            for (int k = 0; k < 8; ++k) q[k] = ssq[row0 + (k >> 2) * HALF + (k & 3) * 16];
            asm volatile("" : "+v"(q[0]), "+v"(q[1]), "+v"(q[2]), "+v"(q[3]), "+v"(q[4]), "+v"(q[5]), "+v"(q[6]), "+v"(q[7]));
#pragma unroll
            for (int k = 0; k < 8; ++k) rsv[k] = __builtin_amdgcn_rsqf((float)q[k] * (1.0f / 1048576.0f / 4096.0f) + EPS); }
#pragma unroll
        for (int ai = 0; ai < 2; ++ai)
#pragma unroll
            for (int m = 0; m < 4; ++m) { const float rs = rsv[ai * 4 + m];
#pragma unroll
                for (int bj = 0; bj < 2; ++bj)
#pragma unroll
                    for (int n = 0; n < 2; ++n) acc[ai][bj][m][n] *= rs;
                asm volatile("" : "+v"(acc[ai][0][m][0]), "+v"(acc[ai][0][m][1]), "+v"(acc[ai][1][m][0]), "+v"(acc[ai][1][m][1])); }
#pragma unroll
        for (int ai = 0; ai < 2; ++ai)
#pragma unroll
            for (int bj = 0; bj < 2; ++bj)
#pragma unroll
                for (int n = 0; n < 2; ++n) {
                    if (fr == 0)  *(PG8_LAS f32x4*)(BND + ((((ai * 2 + wr) * 2 + 0) * 2 + bj) * 128) + colw + 4 * n) = acc[ai][bj][0][n];
                    if (fr == 15) *(PG8_LAS f32x4*)(BND + ((((ai * 2 + wr) * 2 + 1) * 2 + bj) * 128) + colw + 4 * n) = acc[ai][bj][3][n];
                }
        if (wr == 0 && fr < 2) {
#pragma unroll
            for (int bj = 0; bj < 2; ++bj)
#pragma unroll
                for (int n = 0; n < 2; ++n) *(f32x4*)(HB + (size_t)(u.pm * 4 + fr) * NUP + bj * DFF + u.pn * 128 + colw + 4 * n) = acc[0][bj][0][n];
        }
        if (wr == 1 && fr >= 14) {
#pragma unroll
            for (int bj = 0; bj < 2; ++bj)
#pragma unroll
                for (int n = 0; n < 2; ++n) *(f32x4*)(HB + (size_t)(u.pm * 4 + 2 + (fr - 14)) * NUP + bj * DFF + u.pn * 128 + colw + 4 * n) = acc[1][bj][3][n];
        }
        *(PG8_LAS f32x2*)(CW + cwi) = cwreg;
        asm volatile("s_waitcnt lgkmcnt(0)" ::: "memory"); __builtin_amdgcn_s_barrier(); asm volatile("" ::: "memory");
#define DPPF(oldv, srcv, ctrl) __builtin_bit_cast(float, __builtin_amdgcn_update_dpp(__builtin_bit_cast(int, (float)(oldv)), __builtin_bit_cast(int, (float)(srcv)), (ctrl), 0xf, 0xf, false))
#pragma unroll
        for (int bj = 0; bj < 2; ++bj)
#pragma unroll
            for (int n = 0; n < 2; ++n) {
                const f32x4 w0 = *(const PG8_LAS f32x4*)(CW + (0 * 2 + bj) * 128 + colw + 4 * n), w1 = *(const PG8_LAS f32x4*)(CW + (1 * 2 + bj) * 128 + colw + 4 * n), w2 = *(const PG8_LAS f32x4*)(CW + (2 * 2 + bj) * 128 + colw + 4 * n), bb = *(const PG8_LAS f32x4*)(CW + (3 * 2 + bj) * 128 + colw + 4 * n);
#pragma unroll
                for (int ai = 0; ai < 2; ++ai) {
                    f32x4 pv = {0.f, 0.f, 0.f, 0.f}, nv = pv;
                    if (wr == 1) pv = *(PG8_LAS f32x4*)(BND + ((((ai * 2 + 0) * 2 + 1) * 2 + bj) * 128) + colw + 4 * n);
                    else if (ai == 1) pv = *(PG8_LAS f32x4*)(BND + ((((0 * 2 + 1) * 2 + 1) * 2 + bj) * 128) + colw + 4 * n);
                    if (wr == 0) nv = *(PG8_LAS f32x4*)(BND + ((((ai * 2 + 1) * 2 + 0) * 2 + bj) * 128) + colw + 4 * n);
                    else if (ai == 0) nv = *(PG8_LAS f32x4*)(BND + ((((1 * 2 + 0) * 2 + 0) * 2 + bj) * 128) + colw + 4 * n);
#pragma unroll
                    for (int j = 0; j < 4; ++j) {
                        const float c0 = acc[ai][bj][0][n][j], c1 = acc[ai][bj][1][n][j], c2 = acc[ai][bj][2][n][j], c3 = acc[ai][bj][3][n][j];
                        const float u0 = DPPF(pv[j], c0, 0x111), u1 = DPPF(DPPF(0.f, c0, 0x121), c1, 0x111), u2 = DPPF(DPPF(0.f, c1, 0x121), c2, 0x111), u3 = DPPF(DPPF(0.f, c2, 0x121), c3, 0x111);
                        const float d0 = DPPF(DPPF(0.f, c1, 0x12f), c0, 0x101), d1 = DPPF(DPPF(0.f, c2, 0x12f), c1, 0x101), d2 = DPPF(DPPF(0.f, c3, 0x12f), c2, 0x101), d3 = DPPF(nv[j], c3, 0x101);
                        acc[ai][bj][0][n][j] = w0[j] * u0 + w1[j] * c0 + w2[j] * d0 + bb[j];
                        acc[ai][bj][1][n][j] = w0[j] * u1 + w1[j] * c1 + w2[j] * d1 + bb[j];
                        acc[ai][bj][2][n][j] = w0[j] * u2 + w1[j] * c2 + w2[j] * d2 + bb[j];
                        acc[ai][bj][3][n][j] = w0[j] * u3 + w1[j] * c3 + w2[j] * d3 + bb[j];
                    }
                    asm volatile("" : "+v"(acc[ai][bj][0][n]), "+v"(acc[ai][bj][1][n]), "+v"(acc[ai][bj][2][n]), "+v"(acc[ai][bj][3][n]));
                }
            }
#undef DPPF
#pragma unroll
        for (int ai = 0; ai < 2; ++ai)
#pragma unroll
            for (int m = 0; m < 4; ++m) {
                const int row = u.pm * BM + ai * HALF + wr * 64 + m * 16 + fr;
                const f32x4 a0 = acc[ai][0][m][0], a1 = acc[ai][0][m][1], u0 = acc[ai][1][m][0], u1 = acc[ai][1][m][1];
                const f32x2 g0 = gelu_pk((f32x2){a0[0], a0[1]}), g1 = gelu_pk((f32x2){a0[2], a0[3]}), g2 = gelu_pk((f32x2){a1[0], a1[1]}), g3 = gelu_pk((f32x2){a1[2], a1[3]});
                u32x4 w; w.x = cvt_pk_bf16(g0.x * u0[0], g0.y * u0[1]); w.y = cvt_pk_bf16(g1.x * u0[2], g1.y * u0[3]); w.z = cvt_pk_bf16(g2.x * u1[0], g2.y * u1[1]); w.w = cvt_pk_bf16(g3.x * u1[2], g3.y * u1[3]);
                __builtin_nontemporal_store(w, (u32x4*)(GH + (size_t)row * DFF + u.pn * 128 + colw));
            }
    }
};
template <class Epi, class Sched, bool ALIGN_EPI = false, bool SP2 = false, int BAUX = 0  >
__device__ __forceinline__ void gemm_phase(PG8_LAS unsigned char* lds, PG8_LAS unsigned char* xlds, const Gemm g, const Sched& S, const Epi& E) {
    int tid_ = threadIdx.x; asm volatile("" : "+v"(tid_)); const int tid = tid_, wid = __builtin_amdgcn_readfirstlane(tid >> 6), lane = tid & 63, wr = wid >> 2, wc = wid & 3, fr = lane & 15, fq = lane >> 4;
    const int K = g.K, nt = K / BK;
    unsigned voffA[2], voffB[2];
#pragma unroll
    for (int i = 0; i < 2; ++i) { int R, C; stage_rc(tid * 16 + i * 8192, R, C); const int Rb = Epi::PERM ? ((R & ~31) + perm32(R & 31)) : R;
        voffA[i] = (unsigned)(R * K + C) * 2u; voffB[i] = (unsigned)(Rb * K + C) * 2u; }
    const size_t kstep = (size_t)(BK * 2);
    const size_t hstep = (size_t)HALF * K * 2;
    const size_t tstep = 2 * hstep;
    const unsigned ldsw = (unsigned)wid * 1024u;
    const int aoff = lds_byte(wr * 64 + fr, fq * 8), boff = lds_byte(wc * 32 + fr, fq * 8);
#define PG8_SA(b, h) (((b) * 2 + (h)) * HTB)
#define PG8_SB(b, h) ((4 + (b) * 2 + (h)) * HTB)
#define PG8_STAGE(bufoff, gbase, voff) do { _Pragma("unroll") for (int _i = 0; _i < 2; ++_i) \
        __builtin_amdgcn_global_load_lds((const unsigned*)((const char*)(gbase) + (voff)[_i]), (PG8_LAS unsigned*)(lds + (bufoff) + ldsw + _i * 8192), 16, 0, 0); } while (0)
#define PG8_STAGEB(bufoff, gbase, voff) do { _Pragma("unroll") for (int _i = 0; _i < 2; ++_i) \
        __builtin_amdgcn_global_load_lds((const unsigned*)((const char*)(gbase) + (voff)[_i]), (PG8_LAS unsigned*)(lds + (bufoff) + ldsw + _i * 8192), 16, 0, BAUX); } while (0)
#define PG8_LDA(dst, b, h) do { _Pragma("unroll") for (int m = 0; m < 4; ++m) _Pragma("unroll") for (int k = 0; k < 2; ++k) dst[m][k] = *(const PG8_LAS bf16x8*)(lds + PG8_SA(b, h) + aoff + m * 2048 + k * 1024); } while (0)
#define PG8_LDB(dst, b, h) do { _Pragma("unroll") for (int n = 0; n < 2; ++n) _Pragma("unroll") for (int k = 0; k < 2; ++k) dst[n][k] = *(const PG8_LAS bf16x8*)(lds + PG8_SB(b, h) + boff + n * 2048 + k * 1024); } while (0)
#define PG8_MMA(ai, bj, At, Bt) do { __builtin_amdgcn_s_setprio(1); _Pragma("unroll") for (int m = 0; m < 4; ++m) _Pragma("unroll") for (int n = 0; n < 2; ++n) _Pragma("unroll") for (int k = 0; k < 2; ++k) \
        acc[ai][bj][m][n] = __builtin_amdgcn_mfma_f32_16x16x32_bf16(Bt[n][k], At[m][k], acc[ai][bj][m][n], 0, 0, 0); __builtin_amdgcn_s_setprio(0); } while (0)
#define PG8_WAIT_V(n) asm volatile("s_waitcnt vmcnt(" #n ")" ::: "memory")
#define PG8_WAIT_L(n) asm volatile("s_waitcnt lgkmcnt(" #n ")" ::: "memory")
#define PG8_BAR __builtin_amdgcn_s_barrier()
#define PG8_SCHED __builtin_amdgcn_sched_barrier(0)
    Unit cur, nxt; int ui = 0;
    if (!S.next(0, cur)) return;
    f32x4 acc[2][2][4][2];
#pragma unroll
    for (int a = 0; a < 2; ++a)
#pragma unroll
        for (int b = 0; b < 2; ++b)
#pragma unroll
            for (int m = 0; m < 4; ++m)
#pragma unroll
                for (int n = 0; n < 2; ++n) acc[a][b][m][n] = (f32x4){0.f, 0.f, 0.f, 0.f};
    bf16x8 At[4][2], B0[2][2], B1[2][2];
    const char* cA = (const char*)g.A + (size_t)cur.pm * tstep + (size_t)cur.kt0 * kstep; const char* cB = (const char*)g.Bt + (size_t)cur.pn * tstep + (size_t)cur.kt0 * kstep;
    S.a_ready(cur);
    if constexpr (SP2) {
        PG8_STAGEB(PG8_SB(0, 0), cB, voffB); PG8_STAGEB(PG8_SB(0, 1), cB + hstep, voffB); PG8_STAGE(PG8_SA(0, 0), cA, voffA); PG8_STAGE(PG8_SA(0, 1), cA + hstep, voffA);
        if (wr == 1) PG8_BAR;
        PG8_WAIT_V(2); PG8_BAR;
        PG8_STAGEB(PG8_SB(1, 0), cB + kstep, voffB); PG8_STAGE(PG8_SA(1, 0), cA + kstep, voffA); PG8_STAGEB(PG8_SB(1, 1), cB + hstep + kstep, voffB);
        PG8_WAIT_V(6); PG8_BAR;
    } else {
        PG8_STAGEB(PG8_SB(0, 0), cB, voffB); PG8_STAGE(PG8_SA(0, 0), cA, voffA); PG8_STAGEB(PG8_SB(0, 1), cB + hstep, voffB); PG8_STAGE(PG8_SA(0, 1), cA + hstep, voffA);
        if (wr == 1) PG8_BAR;
        PG8_WAIT_V(4); PG8_BAR;
        PG8_STAGEB(PG8_SB(1, 0), cB + kstep, voffB); PG8_STAGE(PG8_SA(1, 0), cA + kstep, voffA); PG8_STAGEB(PG8_SB(1, 1), cB + hstep + kstep, voffB);
        PG8_WAIT_V(6); PG8_BAR;
    }
    for (;;) {
        const bool has_next = S.next(ui + 1, nxt);
        const char* nA = has_next ? (const char*)g.A + (size_t)nxt.pm * tstep + (size_t)nxt.kt0 * kstep : cA; const char* nB = has_next ? (const char*)g.Bt + (size_t)nxt.pn * tstep + (size_t)nxt.kt0 * kstep : cB;
        const int ntu = cur.nkt ? cur.nkt : nt;
        for (int t = 0; t < ntu; t += 2) {
            const bool last = (t == ntu - 2);
            const char* a1 = cA + (size_t)(t + 1) * kstep;
            const char* a2 = last ? nA : cA + (size_t)(t + 2) * kstep; const char* b2 = last ? nB : cB + (size_t)(t + 2) * kstep;
            const char* a3 = a2 + kstep; const char* b3 = b2 + kstep;
            if (last && has_next) S.a_ready(nxt);
            if constexpr (SP2) {
            PG8_LDB(B0, 0, 0); PG8_LDB(B1, 0, 1); PG8_SCHED; PG8_LDA(At, 0, 0); PG8_STAGE(PG8_SA(1, 1), a1 + hstep, voffA);
            PG8_WAIT_V(8); PG8_WAIT_L(0); PG8_BAR; PG8_MMA(0, 0, At, B0); PG8_MMA(0, 1, At, B1); PG8_BAR; PG8_SCHED;
            PG8_LDA(At, 0, 1); PG8_STAGEB(PG8_SB(0, 0), b2, voffB); PG8_STAGEB(PG8_SB(0, 1), b2 + hstep, voffB); PG8_STAGE(PG8_SA(0, 0), a2, voffA);
            PG8_WAIT_V(8); PG8_WAIT_L(0); PG8_BAR; PG8_MMA(1, 0, At, B0); PG8_MMA(1, 1, At, B1); PG8_BAR; PG8_SCHED;
            PG8_LDB(B0, 1, 0); PG8_LDB(B1, 1, 1); PG8_SCHED; PG8_LDA(At, 1, 0); PG8_STAGE(PG8_SA(0, 1), a2 + hstep, voffA);
            PG8_WAIT_V(8); PG8_WAIT_L(0); PG8_BAR; PG8_MMA(0, 0, At, B0); PG8_MMA(0, 1, At, B1); PG8_BAR; PG8_SCHED;
            PG8_LDA(At, 1, 1); PG8_STAGEB(PG8_SB(1, 0), b3, voffB); PG8_STAGEB(PG8_SB(1, 1), b3 + hstep, voffB); PG8_STAGE(PG8_SA(1, 0), a3, voffA);
            PG8_WAIT_V(8); PG8_WAIT_L(0); PG8_BAR; PG8_MMA(1, 0, At, B0); PG8_MMA(1, 1, At, B1); PG8_BAR; PG8_SCHED;
            } else {
            PG8_LDB(B0, 0, 0); PG8_SCHED; PG8_LDA(At, 0, 0); PG8_STAGE(PG8_SA(1, 1), a1 + hstep, voffA);
            PG8_WAIT_L(8); PG8_BAR; PG8_WAIT_L(0); PG8_MMA(0, 0, At, B0); PG8_BAR; PG8_SCHED;
            PG8_LDB(B1, 0, 1); PG8_STAGEB(PG8_SB(0, 0), b2, voffB);
            PG8_BAR; PG8_WAIT_L(0); PG8_MMA(0, 1, At, B1); PG8_BAR;
            PG8_LDA(At, 0, 1); PG8_STAGE(PG8_SA(0, 0), a2, voffA);
            PG8_BAR; PG8_WAIT_L(0); PG8_MMA(1, 0, At, B0); PG8_BAR; PG8_SCHED;
            PG8_STAGEB(PG8_SB(0, 1), b2 + hstep, voffB);
            PG8_WAIT_V(6); PG8_BAR; PG8_MMA(1, 1, At, B1); PG8_BAR;
            PG8_LDB(B0, 1, 0); PG8_SCHED; PG8_LDA(At, 1, 0); PG8_STAGE(PG8_SA(0, 1), a2 + hstep, voffA);
            PG8_WAIT_L(8); PG8_BAR; PG8_WAIT_L(0); PG8_MMA(0, 0, At, B0); PG8_BAR; PG8_SCHED;
            PG8_LDB(B1, 1, 1); PG8_STAGEB(PG8_SB(1, 0), b3, voffB);
            PG8_BAR; PG8_WAIT_L(0); PG8_MMA(0, 1, At, B1); PG8_BAR;
            PG8_LDA(At, 1, 1); PG8_STAGE(PG8_SA(1, 0), a3, voffA);
            PG8_BAR; PG8_WAIT_L(0); PG8_MMA(1, 0, At, B0); PG8_BAR; PG8_SCHED;
            PG8_STAGEB(PG8_SB(1, 1), b3 + hstep, voffB);
            PG8_WAIT_V(6); PG8_BAR; PG8_MMA(1, 1, At, B1); PG8_BAR;
            }
        }
        if constexpr (ALIGN_EPI) { if (wr == 0) PG8_BAR; }
        E(acc, cur, wr, wc, fr, fq, xlds); S.done(cur);
        if (!has_next) break;
#pragma unroll
        for (int a = 0; a < 2; ++a)
#pragma unroll
            for (int b = 0; b < 2; ++b)
#pragma unroll
                for (int m = 0; m < 4; ++m)
#pragma unroll
                    for (int n = 0; n < 2; ++n) acc[a][b][m][n] = (f32x4){0.f, 0.f, 0.f, 0.f};
        cur = nxt; cA = nA; cB = nB; ++ui;
        if constexpr (ALIGN_EPI) { if (wr == 1) PG8_BAR; }
    }
    PG8_WAIT_V(0);
    if constexpr (!ALIGN_EPI) { if (wr == 0) PG8_BAR; }
    PG8_BAR;
#undef PG8_SA
#undef PG8_SB
#undef PG8_STAGE
#undef PG8_STAGEB
#undef PG8_LDA
#undef PG8_LDB
#undef PG8_MMA
#undef PG8_WAIT_V
#undef PG8_WAIT_L
#undef PG8_BAR
#undef PG8_SCHED
}
}

namespace att {
constexpr int D = 128, NW = 8, QBLK = 32, KVBLK = 64;
constexpr float SCALE = 0.088388347648318440f;
constexpr float THR = 8.f;
constexpr int SHM_V = KVBLK * D * 2, SHM_K = KVBLK * D * 2, SHM_ATTN = 2 * SHM_V + 2 * SHM_K + NW * 64 * 4;
#define KSWZ(row, colB) ((row) * 256 + ((colB) ^ (((row) & 7) << 4)))
#define SBAR() __builtin_amdgcn_sched_barrier(0)
__device__ __forceinline__ int crow(int r, int hi) { return (r & 3) + 8 * (r >> 2) + 4 * hi; }
__device__ __forceinline__ unsigned cvtpk(float lo, float hi) { unsigned r; asm volatile("v_cvt_pk_bf16_f32 %0, %1, %2" : "=v"(r) : "v"(lo), "v"(hi)); return r; }

template <bool FIXM, bool NOEXP = false> __device__ __forceinline__ void partialSM(f32x16& p0, f32x16& p1, float& m_reg, float& mn, float& alpha, float mshC) {
  constexpr float C = SCALE * 1.4426950408889634f;
  if constexpr (FIXM) {
    alpha = 1.f; mn = 0.f; if constexpr (NOEXP) return;
#pragma unroll
    for (int r = 0; r < 16; ++r) p0[r] = __builtin_amdgcn_exp2f(p0[r]);
    return;
  }
  float pmax = p0[0];
#pragma unroll
  for (int r = 1; r < 16; ++r) pmax = fmaxf(pmax, p0[r]);
#pragma unroll
  for (int r = 0; r < 16; ++r) pmax = fmaxf(pmax, p1[r]);
  { auto rr = __builtin_amdgcn_permlane32_swap(__float_as_uint(pmax), __float_as_uint(pmax), false, false);
    pmax = fmaxf(__uint_as_float(rr[0]), __uint_as_float(rr[1])); }
  if (__builtin_expect(__all(pmax - m_reg <= THR / SCALE), 1)) { mn = m_reg; alpha = 1.f; }
  else { mn = fmaxf(m_reg, pmax); alpha = __builtin_amdgcn_exp2f((m_reg - mn) * C); m_reg = mn; }
  float mnC = -mn * C;
#pragma unroll
  for (int r = 0; r < 16; ++r) p0[r] = fmaf(p0[r], C, mnC);
#pragma unroll
  for (int r = 0; r < 16; ++r) p1[r] = fmaf(p1[r], C, mnC);
#pragma unroll
  for (int r = 0; r < 16; ++r) p0[r] = __builtin_amdgcn_exp2f(p0[r]);
}
__device__ __forceinline__ void finishSM(f32x16& p0, f32x16& p1, float alpha, float& l_reg, bf16x8& pa0, bf16x8& pa1, bf16x8& pa2, bf16x8& pa3) {
#pragma unroll
  for (int r = 0; r < 16; ++r) p1[r] = __builtin_amdgcn_exp2f(p1[r]);
  float ps = 0;
#pragma unroll
  for (int r = 0; r < 16; ++r) ps += p0[r];
#pragma unroll
  for (int r = 0; r < 16; ++r) ps += p1[r];
  { auto rr = __builtin_amdgcn_permlane32_swap(__float_as_uint(ps), __float_as_uint(ps), false, false);
    ps = __uint_as_float(rr[0]) + __uint_as_float(rr[1]); }
  l_reg = l_reg * alpha + ps;
#define PK4(P, BASE, OUT) do { unsigned a0 = cvtpk(P[BASE + 0], P[BASE + 1]), a1 = cvtpk(P[BASE + 2], P[BASE + 3]);   \
    unsigned b0 = cvtpk(P[BASE + 4], P[BASE + 5]), b1 = cvtpk(P[BASE + 6], P[BASE + 7]);                              \
    auto r0 = __builtin_amdgcn_permlane32_swap(a0, b0, false, false); auto r1 = __builtin_amdgcn_permlane32_swap(a1, b1, false, false); \
    u32x4 w = {r0[0], r1[0], r0[1], r1[1]}; OUT = *reinterpret_cast<bf16x8*>(&w); } while (0)
  PK4(p0, 0, pa0); PK4(p0, 8, pa1); PK4(p1, 0, pa2); PK4(p1, 8, pa3);
#undef PK4
}
__device__ __forceinline__ void qkt(f32x16& p0, f32x16& p1, const LAS unsigned char* Ks, const bf16x8* qr, int r32, int hi, float init = 0.f) {
#pragma unroll
  for (int r = 0; r < 16; ++r) { p0[r] = init; p1[r] = init; }
#pragma unroll
  for (int d0 = 0; d0 < 8; ++d0) { int cb = (d0 * 16 + hi * 8) * 2;
    bf16x8 b0 = *reinterpret_cast<const LAS bf16x8*>(Ks + KSWZ(r32, cb));
    bf16x8 b1 = *reinterpret_cast<const LAS bf16x8*>(Ks + KSWZ(32 + r32, cb));
    p0 = __builtin_amdgcn_mfma_f32_32x32x16_bf16(b0, qr[d0], p0, 0, 0, 0);
    p1 = __builtin_amdgcn_mfma_f32_32x32x16_bf16(b1, qr[d0], p1, 0, 0, 0); }
}
#define QF_PK4(P, BASE, OUT) do { unsigned a0 = cvtpk(P[BASE + 0], P[BASE + 1]), a1 = cvtpk(P[BASE + 2], P[BASE + 3]);   \
    unsigned b0 = cvtpk(P[BASE + 4], P[BASE + 5]), b1 = cvtpk(P[BASE + 6], P[BASE + 7]);                              \
    auto r0 = __builtin_amdgcn_permlane32_swap(a0, b0, false, false); auto r1 = __builtin_amdgcn_permlane32_swap(a1, b1, false, false); \
    u32x4 w = {r0[0], r1[0], r0[1], r1[1]}; OUT = *reinterpret_cast<bf16x8*>(&w); } while (0)
#define QF_KRD(D0, X0, X1) do { X0 = *reinterpret_cast<const LAS bf16x8*>(Ks + KSWZ(r32, ((D0) * 16 + hi * 8) * 2)); X1 = *reinterpret_cast<const LAS bf16x8*>(Ks + KSWZ(32 + r32, ((D0) * 16 + hi * 8) * 2)); } while (0)
#define QF_STEP(D0, X0, X1) do { SBAR(); q0 = __builtin_amdgcn_mfma_f32_32x32x16_bf16(X0, qr[D0], q0, 0, 0, 0); q1 = __builtin_amdgcn_mfma_f32_32x32x16_bf16(X1, qr[D0], q1, 0, 0, 0); \
    if ((D0) + 2 < 8) QF_KRD((D0) + 2, X0, X1);                                                                                                                       \
    p1[2 * (D0)] = __builtin_amdgcn_exp2f(p1[2 * (D0)]); p1[2 * (D0) + 1] = __builtin_amdgcn_exp2f(p1[2 * (D0) + 1]); psa += p0[2 * (D0)]; psb += p0[2 * (D0) + 1];     \
    if ((D0) >= 1) { psa += p1[2 * (D0) - 2]; psb += p1[2 * (D0) - 1]; }                                                                                              \
    if ((D0) == 0) QF_PK4(p0, 0, pa0); if ((D0) == 1) QF_PK4(p0, 8, pa1); if ((D0) == 5) QF_PK4(p1, 0, pa2); } while (0)
__device__ __forceinline__ void qk_fin(f32x16& q0, f32x16& q1, const LAS unsigned char* Ks, const bf16x8* qr, int r32, int hi,
                                       f32x16& p0, f32x16& p1, float& l_reg, bf16x8& pa0, bf16x8& pa1, bf16x8& pa2, bf16x8& pa3) {
#pragma unroll
  for (int r = 0; r < 16; ++r) { q0[r] = 0.f; q1[r] = 0.f; }
  bf16x8 ka0, ka1, kb0, kb1; float psa = 0.f, psb = 0.f;
  QF_KRD(0, ka0, ka1); QF_KRD(1, kb0, kb1);
  QF_STEP(0, ka0, ka1); QF_STEP(1, kb0, kb1); QF_STEP(2, ka0, ka1); QF_STEP(3, kb0, kb1); QF_STEP(4, ka0, ka1); QF_STEP(5, kb0, kb1); QF_STEP(6, ka0, ka1); QF_STEP(7, kb0, kb1);
  SBAR();
  psa += p1[14]; psb += p1[15]; QF_PK4(p1, 8, pa3);
  float ps = psa + psb;
  { auto rr = __builtin_amdgcn_permlane32_swap(__float_as_uint(ps), __float_as_uint(ps), false, false);
    ps = __uint_as_float(rr[0]) + __uint_as_float(rr[1]); }
  l_reg += ps;
}
#undef QF_PK4
#undef QF_KRD
#undef QF_STEP
__device__ __forceinline__ int v_st(int k, int c) { const int kk = (k & ~0xC) | ((k & 4) << 1) | ((k & 8) >> 1); return ((kk >> 3) * 4 + (c >> 5)) * 512 + ((kk & 7) * 32 + (c & 31)) * 2; }
__device__ __forceinline__ int v_rd_base(int lane) { return ((lane & 3) << 3) | (((lane >> 2) & 3) << 6) | (((lane >> 4) & 1) << 5) | (((lane >> 5) & 1) << 8); }
constexpr int v_rd_off(int d0, int ks, int half) { return d0 * 512 + ks * 4096 + half * 2048; }
template <int OFF> __device__ __forceinline__ s16x4 tr_read(int vb) {
  s16x4 r; asm volatile("ds_read_b64_tr_b16 %0, %1 offset:%2" : "=&v"(r) : "v"(vb), "i"(OFF) : "memory"); return r;
}
template <int D0> __device__ __forceinline__ void pv_one(f32x16& od, int vb, bf16x8 pa0, bf16x8 pa1, bf16x8 pa2, bf16x8 pa3) {
  const s16x4 l0 = tr_read<v_rd_off(D0, 0, 0)>(vb), h0 = tr_read<v_rd_off(D0, 0, 1)>(vb), l1 = tr_read<v_rd_off(D0, 1, 0)>(vb), h1 = tr_read<v_rd_off(D0, 1, 1)>(vb);
  const s16x4 l2 = tr_read<v_rd_off(D0, 2, 0)>(vb), h2 = tr_read<v_rd_off(D0, 2, 1)>(vb), l3 = tr_read<v_rd_off(D0, 3, 0)>(vb), h3 = tr_read<v_rd_off(D0, 3, 1)>(vb);
  asm volatile("s_waitcnt lgkmcnt(0)" ::: "memory"); SBAR();
#define PK(L, H) (bf16x8){L[0], L[1], L[2], L[3], H[0], H[1], H[2], H[3]}
  od = __builtin_amdgcn_mfma_f32_32x32x16_bf16(pa0, PK(l0, h0), od, 0, 0, 0);
  od = __builtin_amdgcn_mfma_f32_32x32x16_bf16(pa1, PK(l1, h1), od, 0, 0, 0);
  od = __builtin_amdgcn_mfma_f32_32x32x16_bf16(pa2, PK(l2, h2), od, 0, 0, 0);
  od = __builtin_amdgcn_mfma_f32_32x32x16_bf16(pa3, PK(l3, h3), od, 0, 0, 0);
#undef PK
}
__device__ __forceinline__ void pv_d0(f32x16* o, int vb, bf16x8 pa0, bf16x8 pa1, bf16x8 pa2, bf16x8 pa3) {
  pv_one<0>(o[0], vb, pa0, pa1, pa2, pa3); pv_one<1>(o[1], vb, pa0, pa1, pa2, pa3); pv_one<2>(o[2], vb, pa0, pa1, pa2, pa3); pv_one<3>(o[3], vb, pa0, pa1, pa2, pa3);
}
template <int OFF> __device__ __forceinline__ s16x4 tr_rd(const LAS unsigned char* vb) { return __builtin_amdgcn_ds_read_tr16_b64_v4i16((LAS s16x4*)(vb + OFF)); }
#define PV_READS(P, D0) P[0] = tr_rd<v_rd_off(D0, 0, 0)>(vb); P[1] = tr_rd<v_rd_off(D0, 0, 1)>(vb); P[2] = tr_rd<v_rd_off(D0, 1, 0)>(vb); P[3] = tr_rd<v_rd_off(D0, 1, 1)>(vb); \
                        P[4] = tr_rd<v_rd_off(D0, 2, 0)>(vb); P[5] = tr_rd<v_rd_off(D0, 2, 1)>(vb); P[6] = tr_rd<v_rd_off(D0, 3, 0)>(vb); P[7] = tr_rd<v_rd_off(D0, 3, 1)>(vb);
#define PV_PK(L, H) (bf16x8){L[0], L[1], L[2], L[3], H[0], H[1], H[2], H[3]}
#define PV_MMA(OD, P) OD = __builtin_amdgcn_mfma_f32_32x32x16_bf16(pa0, PV_PK(P[0], P[1]), OD, 0, 0, 0); OD = __builtin_amdgcn_mfma_f32_32x32x16_bf16(pa1, PV_PK(P[2], P[3]), OD, 0, 0, 0); \
                      OD = __builtin_amdgcn_mfma_f32_32x32x16_bf16(pa2, PV_PK(P[4], P[5]), OD, 0, 0, 0); OD = __builtin_amdgcn_mfma_f32_32x32x16_bf16(pa3, PV_PK(P[6], P[7]), OD, 0, 0, 0);
#define PV_EXP4(B) do { if constexpr (EXPS) { _Pragma("unroll") for (int r = (B); r < (B) + 4; ++r) pn[r] = __builtin_amdgcn_exp2f(pn[r]); } } while (0)
template <bool EXPS> __device__ __forceinline__ void pv_pipe(f32x16* o, const LAS unsigned char* vb, bf16x8 pa0, bf16x8 pa1, bf16x8 pa2, bf16x8 pa3, f32x16& pn) {
  s16x4 A[8], B[8];
  PV_READS(A, 0) PV_READS(B, 1)
  SBAR(); PV_MMA(o[0], A) PV_EXP4(0); SBAR();
  PV_READS(A, 2)
  SBAR(); PV_MMA(o[1], B) PV_EXP4(4); SBAR();
  PV_READS(B, 3)
  SBAR(); PV_MMA(o[2], A) PV_EXP4(8); SBAR();
  PV_MMA(o[3], B) PV_EXP4(12);
}
#undef PV_READS
#undef PV_PK
#undef PV_MMA
#undef PV_EXP4

template <int LDQ, int LDK, int LDO, bool FIXM = false>
__device__ __forceinline__ void attn_dense_body(const bf16_t* __restrict__ Qb, const bf16_t* __restrict__ Kh, const bf16_t* __restrict__ Vh,
                                                bf16_t* __restrict__ Ob, int seq, LAS unsigned char* lds, float mshC = 0.f) {
  int tid_ = threadIdx.x; asm volatile("" : "+v"(tid_)); const int tid = tid_, wid = tid >> 6, lane = tid & 63, r32 = lane & 31, hi = lane >> 5;
  LAS unsigned char* V_lds = lds; LAS unsigned char* K_lds = lds + 2 * SHM_V;
  LAS float* ws = (LAS float*)(lds + 2 * SHM_V + 2 * SHM_K) + wid * 64; LAS float* li_l = ws; LAS float* al_l = ws + 32;
  float m_reg = -1e30f, l_reg = 0; f32x16 o[4] = {}; bf16x8 qr[8];
  const bf16_t* Qw = Qb + (long)(wid * QBLK + r32) * LDQ + hi * 8;
#pragma unroll
  for (int d0 = 0; d0 < 8; ++d0) { qr[d0] = *reinterpret_cast<const bf16x8*>(Qw + d0 * 16);
    if constexpr (FIXM) { constexpr float C = SCALE * 1.4426950408889634f; const u32x4 q = __builtin_bit_cast(u32x4, qr[d0]); u32x4 s;
      s.x = cvt_pk_bf16(bf_lo(q.x) * C, bf_hi(q.x) * C); s.y = cvt_pk_bf16(bf_lo(q.y) * C, bf_hi(q.y) * C); s.z = cvt_pk_bf16(bf_lo(q.z) * C, bf_hi(q.z) * C); s.w = cvt_pk_bf16(bf_lo(q.w) * C, bf_hi(q.w) * C);
      qr[d0] = __builtin_bit_cast(bf16x8, s); } }
  const int sr = tid >> 4, sc = (tid & 15) * 8, vst0 = v_st(sr, sc), vst1 = v_st(32 + sr, sc), kc = sc * 2;
  const LAS unsigned char* vbp = V_lds + v_rd_base(lane); const int vb0 = (int)(uintptr_t)V_lds + v_rd_base(lane);
  bf16x8 kr0, kr1, vr0, vr1;
#define KLOAD(k0) do { kr0 = *reinterpret_cast<const bf16x8*>(&Kh[(long)((k0) + sr) * LDK + sc]); kr1 = *reinterpret_cast<const bf16x8*>(&Kh[(long)((k0) + 32 + sr) * LDK + sc]); } while (0)
#define VLOAD(k0) do { vr0 = *reinterpret_cast<const bf16x8*>(&Vh[(long)((k0) + sr) * LDK + sc]); vr1 = *reinterpret_cast<const bf16x8*>(&Vh[(long)((k0) + 32 + sr) * LDK + sc]); } while (0)
#define KWRITE(b) do { *(LAS bf16x8*)(K_lds + (b) * SHM_K + KSWZ(sr, kc)) = kr0; *(LAS bf16x8*)(K_lds + (b) * SHM_K + KSWZ(32 + sr, kc)) = kr1; } while (0)
#define VWRITE(b) do { *(LAS bf16x8*)(V_lds + (b) * SHM_V + vst0) = vr0; *(LAS bf16x8*)(V_lds + (b) * SHM_V + vst1) = vr1; } while (0)
#define RESC(a) do { if constexpr (!FIXM) if (__any((a) < 1.f)) { if (hi == 0) al_l[r32] = (a); asm volatile("s_waitcnt lgkmcnt(0)" ::: "memory"); \
    _Pragma("unroll") for (int d = 0; d < 4; ++d) _Pragma("unroll") for (int r = 0; r < 16; ++r) o[d][r] *= al_l[crow(r, hi)]; } } while (0)
  f32x16 pA0, pA1, pB0, pB1; float mnA, mnB, alA, alB; bf16x8 pa0, pa1, pa2, pa3; const int NT = seq / KVBLK;
  KLOAD(0); VLOAD(0); KWRITE(0); VWRITE(0); KLOAD(KVBLK); VLOAD(KVBLK); __syncthreads();
  qkt(pA0, pA1, K_lds, qr, r32, hi); partialSM<FIXM>(pA0, pA1, m_reg, mnA, alA, mshC);
  KWRITE(1); KLOAD(2 * KVBLK);
  if (tid >= 256) __builtin_amdgcn_s_setprio(1);
  for (int j = 0; j + 2 < NT; j += 2) {
    __syncthreads(); KWRITE(0); VWRITE(1); KLOAD((j + 3) * KVBLK); VLOAD((j + 2) * KVBLK);
    SBAR(); if constexpr (FIXM) qk_fin(pB0, pB1, K_lds + SHM_K, qr, r32, hi, pA0, pA1, l_reg, pa0, pa1, pa2, pa3);
    else { qkt(pB0, pB1, K_lds + SHM_K, qr, r32, hi); finishSM(pA0, pA1, alA, l_reg, pa0, pa1, pa2, pa3); } SBAR();
    pv_pipe<FIXM>(o, vbp, pa0, pa1, pa2, pa3, pB0); partialSM<FIXM, true>(pB0, pB1, m_reg, mnB, alB, mshC); RESC(alB);
    __syncthreads(); KWRITE(1); VWRITE(0); if (j + 4 < NT) KLOAD((j + 4) * KVBLK); VLOAD((j + 3) * KVBLK);
    SBAR(); if constexpr (FIXM) qk_fin(pA0, pA1, K_lds, qr, r32, hi, pB0, pB1, l_reg, pa0, pa1, pa2, pa3);
    else { qkt(pA0, pA1, K_lds, qr, r32, hi); finishSM(pB0, pB1, alB, l_reg, pa0, pa1, pa2, pa3); } SBAR();
    pv_pipe<FIXM>(o, vbp + SHM_V, pa0, pa1, pa2, pa3, pA0); partialSM<FIXM, true>(pA0, pA1, m_reg, mnA, alA, mshC); RESC(alA);
  }
  __builtin_amdgcn_s_setprio(0);
  __syncthreads(); VWRITE(1);
  SBAR(); qkt(pB0, pB1, K_lds + SHM_K, qr, r32, hi);
  finishSM(pA0, pA1, alA, l_reg, pa0, pa1, pa2, pa3); SBAR();
  pv_d0(o, vb0, pa0, pa1, pa2, pa3); partialSM<FIXM>(pB0, pB1, m_reg, mnB, alB, mshC); RESC(alB);
  __syncthreads();
  finishSM(pB0, pB1, alB, l_reg, pa0, pa1, pa2, pa3); SBAR();
  pv_d0(o, vb0 + (int)SHM_V, pa0, pa1, pa2, pa3);
  if (hi == 0) li_l[r32] = l_reg; asm volatile("s_waitcnt lgkmcnt(0)" ::: "memory");
  float rli[16];
#pragma unroll
  for (int r = 0; r < 16; ++r) rli[r] = __builtin_amdgcn_rcpf(li_l[crow(r, hi)]);
  bf16_t* Ow = Ob + (long)(wid * QBLK) * LDO;
#pragma unroll
  for (int r = 0; r < 16; ++r) { int orow = crow(r, hi);
#pragma unroll
    for (int d0 = 0; d0 < 4; ++d0) Ow[(long)orow * LDO + d0 * 32 + r32] = f2bf(o[d0][r] * rli[r]); }
#undef KLOAD
#undef VLOAD
#undef KWRITE
#undef VWRITE
#undef RESC
}
}


constexpr int NWAVES = 8, NTHREADS = 512;
constexpr int N_LAUNCHES = MK_N_LAUNCHES;
constexpr int NPHASES = 27;
constexpr size_t MiB = 1u << 20;
constexpr size_t WS_CTL = 0, CTL_ZERO_BYTES = 1 * MiB;
constexpr size_t WS_ROPE = 1 * MiB, WS_MEMSS = 1 * MiB + 65536;
constexpr size_t WS_WIN = 2 * MiB, WS_WOUT = 178 * MiB, WS_WCQ = 242 * MiB, WS_WCKV = 250 * MiB, WS_WCO = 266 * MiB, WS_WUP = 274 * MiB, WS_WDOWN = 618 * MiB;
constexpr size_t WS_XB = 790 * MiB, WS_PROJ = 918 * MiB, WS_MIX = 1270 * MiB, WS_CQ = 1398 * MiB, WS_CO = 1414 * MiB, WS_MEMB = 1430 * MiB, WS_MKV = 1440 * MiB;
constexpr size_t WS_GH = 1446 * MiB, WS_HB = 1790 * MiB, WS_U = 1812 * MiB, WS_SS = 2068 * MiB, WS_END = 2196 * MiB;
static_assert(WS_WIN + 2ull * NIN * DM * 2 <= WS_WOUT && WS_WUP + 2ull * NUP * DM * 2 <= WS_WDOWN && WS_WDOWN + 2ull * DM * DFF * 2 <= WS_XB, "ws map (weights)");
static_assert(WS_PROJ + (size_t)MROWS * NIN * 2 <= WS_MIX && WS_GH + (size_t)MROWS * DFF * 2 <= WS_HB && WS_HB + 64ull * 4 * NUP * 4 <= WS_U && WS_U + 2ull * 2048 * 16384 * 2 <= WS_SS, "ws map (activations)");
constexpr int CW_BAR = 4096;
constexpr size_t CTL_SSQ = 65536;
static_assert(CTL_SSQ + 7ull * 16384 * 8 <= CTL_ZERO_BYTES, "ssq inside the memset region");
constexpr int RING_BYTES = 131072, XL_OFF = 131072, MISC_OFF = 143360, LDS_BYTES = 147456;
constexpr int RS = 136, RSB = RS * 2, RTB = 128 * RSB;
static_assert(4 * RTB + 1024 <= MISC_OFF && XL_OFF + 8192 + 4096 <= MISC_OFF && MISC_OFF + 128 <= LDS_BYTES, "LDS map");

typedef GAS unsigned gu32;
#define RLX_AGENT __ATOMIC_RELAXED, __HIP_MEMORY_SCOPE_AGENT
#define LDS_WAIT() asm volatile("s_waitcnt lgkmcnt(0)" ::: "memory")
#define VM_WAIT() asm volatile("s_waitcnt vmcnt(0)" ::: "memory")

#define XB_TMO      128
#define XB_XCNT(j)  (256  + 64 * (j))
#define XB_XSUB(j)  (1280 + 64 * (j))
#define XB_XGEN(j)  (2304 + 64 * (j))
#define XB_TOP      3328
#define XB_TOPGEN   3392
#define XCD_BAR_WORDS 3456
#define XB_SPIN_CAP (1u << 18)
__device__ __forceinline__ unsigned xb_ld(unsigned* p)              { return __hip_atomic_load(p, __ATOMIC_RELAXED, __HIP_MEMORY_SCOPE_AGENT); }
__device__ __forceinline__ unsigned xb_add(unsigned* p, unsigned v) { return __hip_atomic_fetch_add(p, v, __ATOMIC_RELAXED, __HIP_MEMORY_SCOPE_AGENT); }
__device__ __forceinline__ unsigned xb_xcc_id() { return (unsigned)__builtin_amdgcn_s_getreg((3 << 11) | 20) & 0xFu; }
#define XB_SPIN(cond, bar) do { unsigned _sp = 0; while (cond) { __builtin_amdgcn_s_sleep(1); \
    if ((++_sp & 255u) == 0u) { if (xb_ld(&(bar)[XB_TMO])) break; if (_sp > XB_SPIN_CAP) { atomicAdd(&(bar)[XB_TMO], 1u); break; } } } } while (0)
struct XcdBarrier { unsigned* bar; unsigned x; volatile LAS unsigned* st; };
__device__ __forceinline__ XcdBarrier xcd_barrier_post(unsigned* bar, volatile LAS unsigned* st) {
    XcdBarrier b; b.bar = bar; b.x = xb_xcc_id(); b.st = st;
    if (threadIdx.x == 0) (void)xb_add(&bar[XB_XCNT(b.x)], 1u);
    return b;
}
__device__ __forceinline__ void xcd_barrier_complete(unsigned* bar, unsigned x, unsigned& nloc, unsigned& nx) {
    const unsigned G = gridDim.x * gridDim.y * gridDim.z;
    unsigned sum, cnt, mine, sp = 0u;
    for (;;) {
        sum = 0u; cnt = 0u; mine = 0u;
#pragma unroll
        for (unsigned j = 0; j < 16; ++j) { const unsigned c = xb_ld(&bar[XB_XCNT(j)]); sum += c; cnt += (c > 0u) ? 1u : 0u; mine = (j == x) ? c : mine; }
        if (sum == G) break;
        __builtin_amdgcn_s_sleep(1);
        if ((++sp & 255u) == 0u) { if (xb_ld(&bar[XB_TMO])) break; if (sp > XB_SPIN_CAP) { atomicAdd(&bar[XB_TMO], 1u); break; } }
    }
    nloc = mine > 0u ? mine : 1u; nx = cnt > 0u ? cnt : 1u;
}
__device__ __forceinline__ void xcd_barrier(const XcdBarrier& b) {
    asm volatile("s_waitcnt vmcnt(0)" ::: "memory");
    __syncthreads();
    if (threadIdx.x == 0) {
        unsigned* bar = b.bar;
        __builtin_amdgcn_s_waitcnt(0);
        unsigned nloc = b.st[0], nx = b.st[1];
        if (nloc == 0u) { xcd_barrier_complete(bar, b.x, nloc, nx); b.st[0] = nloc; b.st[1] = nx; }
        const unsigned old = xb_add(&bar[XB_XSUB(b.x)], 1u);
        const unsigned gen = old / nloc;
        if (old + 1u == (gen + 1u) * nloc) {
            __builtin_amdgcn_fence(__ATOMIC_RELEASE, "agent");
            asm volatile("s_waitcnt vmcnt(0)" ::: "memory");
            const unsigned og = xb_add(&bar[XB_TOP], 1u);
            const unsigned tg = og / nx;
            if (og + 1u == (tg + 1u) * nx) xb_add(&bar[XB_TOPGEN], 1u);
            else XB_SPIN(xb_ld(&bar[XB_TOPGEN]) == tg, bar);
            __builtin_amdgcn_fence(__ATOMIC_ACQUIRE, "agent");
            xb_add(&bar[XB_XGEN(b.x)], 1u);
            asm volatile("s_waitcnt vmcnt(0)" ::: "memory");
        } else {
            XB_SPIN(xb_ld(&bar[XB_XGEN(b.x)]) == gen, bar);
            __builtin_amdgcn_fence(__ATOMIC_ACQUIRE, "agent");
            asm volatile("s_waitcnt vmcnt(0)" ::: "memory");
        }
    }
    __syncthreads();
}

struct Args { const float* in[21]; float* out; unsigned char* ws; int ph_lo, ph_hi; };

template <bool UPMAP, bool ROPEPERM = false>
__device__ __forceinline__ void p0_transpose_item(const float* __restrict__ W, int K, int N, bf16_t* __restrict__ WT, const float* __restrict__ gain, int cs_lo, int cs_hi, float cs, LAS float* scr, int item, int lane) {
    const int nblk = N / 64, kb = item / nblk, nb = item % nblk, k0 = 64 * kb, n0 = 64 * nb;
    const float* src = W + (size_t)k0 * N + n0 + lane;
#pragma unroll 32
    for (int i = 0; i < 64; ++i) scr[i * 65 + lane] = __builtin_nontemporal_load(src + (size_t)i * N);
    LDS_WAIT(); asm volatile("" ::: "memory");
    const int c = lane & 7, rr = lane >> 3;
    float g8[8];
#pragma unroll
    for (int e = 0; e < 8; ++e) g8[e] = gain ? gain[k0 + 8 * c + e] : 1.0f;
    const float csv = (n0 >= cs_lo && n0 < cs_hi) ? cs : 1.0f;
    int orow0 = n0;
    if (UPMAP) { const int nn = n0 < DFF ? n0 : n0 - DFF; orow0 = (nn >> 7) * 256 + (n0 < DFF ? 0 : 128) + (nn & 127); }
    const bool hperm = ROPEPERM && (n0 < 4096 || (n0 >= 8192 && n0 < 10752));
#pragma unroll
    for (int jj = 0; jj < 8; ++jj) { const int n = rr + 8 * jj; const LAS float* s = scr + (8 * c) * 65 + n;
        const int nrow = hperm ? (8 * ((n & 31) >> 2) + (n & 3) + ((n >= 32) ? 4 : 0)) : n;
        u32x4 o;
        o.x = cvt_pk_bf16(s[0 * 65] * g8[0] * csv, s[1 * 65] * g8[1] * csv); o.y = cvt_pk_bf16(s[2 * 65] * g8[2] * csv, s[3 * 65] * g8[3] * csv);
        o.z = cvt_pk_bf16(s[4 * 65] * g8[4] * csv, s[5 * 65] * g8[5] * csv); o.w = cvt_pk_bf16(s[6 * 65] * g8[6] * csv, s[7 * 65] * g8[7] * csv);
        __builtin_nontemporal_store(o, (u32x4*)(WT + (size_t)(orow0 + nrow) * K + k0 + 8 * c)); }
    LDS_WAIT(); asm volatile("" ::: "memory");
}
__device__ __forceinline__ float wave_sum(float v) {
#pragma unroll
    for (int o = 1; o < 64; o <<= 1) v += __shfl_xor(v, o);
    return v;
}
template <class TS> __device__ __forceinline__ void row_to_bf16(const float* __restrict__ xrow, bf16_t* __restrict__ orow, TS* ssq_out, int lane) {
    const f32x4* xr = (const f32x4*)xrow + lane; float s = 0.f;
    u32x2* o8 = (u32x2*)orow + lane;
#pragma unroll
    for (int j = 0; j < 16; ++j) { const f32x4 v = __builtin_nontemporal_load(xr + 64 * j); s += (v[0] * v[0] + v[1] * v[1]) + (v[2] * v[2] + v[3] * v[3]);
        u32x2 w; w.x = cvt_pk_bf16(v[0], v[1]); w.y = cvt_pk_bf16(v[2], v[3]); o8[64 * j] = w; }
    s = wave_sum(s);
    if (lane == 0) { if constexpr (sizeof(TS) == 8) *ssq_out = (TS)(s * 1048576.0f + 0.5f); else *ssq_out = s; }
}

__device__ __forceinline__ void prep_row(bf16_t* __restrict__ prow, int t, const f32x2* __restrict__ rope, const float* __restrict__ qn, const float* __restrict__ kn, int lane) {
    const int hg = lane >> 3, j = lane & 7;
    const int off1 = 8 * j + ((j >= 4) ? 32 : 0);
    const int pos = (j < 4) ? (t >> 6) : (t & 63);
    const f32x2* rp = rope + pos * 32 + 8 * (j & 3);
    f32x2 cs[8];
#pragma unroll
    for (int e = 0; e < 8; ++e) cs[e] = rp[e];
#pragma unroll
    for (int g = 0; g < 7; ++g) {
        const int base = (g < 4) ? g * 1024 : (g < 6 ? 8192 + (g - 4) * 1024 : 10240);
        const bool active = (g < 6) || (hg < 4);
        const int hh = active ? hg : 0;
        bf16_t* p = prow + base + hh * 128 + off1;
        const u32x4 a = *(const u32x4*)p, b = *(const u32x4*)(p + 32);
        float x1[8] = {bf_lo(a.x), bf_hi(a.x), bf_lo(a.y), bf_hi(a.y), bf_lo(a.z), bf_hi(a.z), bf_lo(a.w), bf_hi(a.w)};
        float x2[8] = {bf_lo(b.x), bf_hi(b.x), bf_lo(b.y), bf_hi(b.y), bf_lo(b.z), bf_hi(b.z), bf_lo(b.w), bf_hi(b.w)};
        if (g >= 4) {
            float ss = 0.f;
#pragma unroll
            for (int e = 0; e < 8; ++e) ss += x1[e] * x1[e] + x2[e] * x2[e];
            ss += __shfl_xor(ss, 1); ss += __shfl_xor(ss, 2); ss += __shfl_xor(ss, 4);
            const float rs = __builtin_amdgcn_rsqf(ss * (1.0f / 128.0f) + EPS);
            const float* gn = (g < 6) ? qn : kn;
#pragma unroll
            for (int e = 0; e < 8; ++e) { x1[e] *= rs * gn[off1 + e]; x2[e] *= rs * gn[off1 + 32 + e]; }
        }
        float y1[8], y2[8];
#pragma unroll
        for (int e = 0; e < 8; ++e) { y1[e] = x1[e] * cs[e].x - x2[e] * cs[e].y; y2[e] = x2[e] * cs[e].x + x1[e] * cs[e].y; }
        if (active) {
            u32x4 oa, ob;
            oa.x = cvt_pk_bf16(y1[0], y1[1]); oa.y = cvt_pk_bf16(y1[2], y1[3]); oa.z = cvt_pk_bf16(y1[4], y1[5]); oa.w = cvt_pk_bf16(y1[6], y1[7]);
            ob.x = cvt_pk_bf16(y2[0], y2[1]); ob.y = cvt_pk_bf16(y2[2], y2[3]); ob.z = cvt_pk_bf16(y2[4], y2[5]); ob.w = cvt_pk_bf16(y2[6], y2[7]);
            *(u32x4*)p = oa; *(u32x4*)(p + 32) = ob;
        }
    }
}

__device__ __forceinline__ f32x4 mfma16(bf16x8 a, bf16x8 b, f32x4 c) { return __builtin_amdgcn_mfma_f32_16x16x32_bf16(a, b, c, 0, 0, 0); }
__device__ __forceinline__ bf16x8 tr_frag(int addr) {
    s16x4 lo, hi;
    asm volatile("ds_read_b64_tr_b16 %0, %2\n\tds_read_b64_tr_b16 %1, %2 offset:%3\n\ts_waitcnt lgkmcnt(0)" : "=&v"(lo), "=&v"(hi) : "v"(addr), "i"(4 * RSB) : "memory");
    return (bf16x8){lo[0], lo[1], lo[2], lo[3], hi[0], hi[1], hi[2], hi[3]};
}
__device__ __forceinline__ void tr_frag4(int addr, bf16x8 (&f)[4]) {
    s16x4 l0, h0, l1, h1, l2, h2, l3, h3;
    asm volatile("ds_read_b64_tr_b16 %0, %8\n\tds_read_b64_tr_b16 %1, %8 offset:%9\n\tds_read_b64_tr_b16 %2, %8 offset:32\n\tds_read_b64_tr_b16 %3, %8 offset:%10\n\t"
                 "ds_read_b64_tr_b16 %4, %8 offset:64\n\tds_read_b64_tr_b16 %5, %8 offset:%11\n\tds_read_b64_tr_b16 %6, %8 offset:96\n\tds_read_b64_tr_b16 %7, %8 offset:%12\n\ts_waitcnt lgkmcnt(0)"
                 : "=&v"(l0), "=&v"(h0), "=&v"(l1), "=&v"(h1), "=&v"(l2), "=&v"(h2), "=&v"(l3), "=&v"(h3)
                 : "v"(addr), "i"(4 * RSB), "i"(4 * RSB + 32), "i"(4 * RSB + 64), "i"(4 * RSB + 96) : "memory");
    f[0] = (bf16x8){l0[0], l0[1], l0[2], l0[3], h0[0], h0[1], h0[2], h0[3]}; f[1] = (bf16x8){l1[0], l1[1], l1[2], l1[3], h1[0], h1[1], h1[2], h1[3]};
    f[2] = (bf16x8){l2[0], l2[1], l2[2], l2[3], h2[0], h2[1], h2[2], h2[3]}; f[3] = (bf16x8){l3[0], l3[1], l3[2], l3[3], h3[0], h3[1], h3[2], h3[3]};
}
__device__ __forceinline__ void ret_state_item(LAS unsigned char* lds, const bf16_t* __restrict__ PROJ, bf16_t* __restrict__ U, int r0, int h, int item, float lf2, float lb2) {
    int tid_ = threadIdx.x; asm volatile("" : "+v"(tid_)); const int tid = tid_, lane = tid & 63, w = __builtin_amdgcn_readfirstlane(tid >> 6), g = lane >> 4, lr = lane & 15, q4 = (lane & 15) >> 2, p4 = lane & 3;
    const int wr4 = w >> 1, wc2 = w & 1;
    LAS bf16_t* Kf = (LAS bf16_t*)lds; LAS bf16_t* Kb = Kf + 128 * RS; LAS bf16_t* Vs = Kb + 128 * RS;
#pragma unroll
    for (int p = 0; p < 4; ++p) { const int idx = tid + 512 * p, j = idx >> 4, cc = (idx & 15) * 8;
        const bf16_t* src = PROJ + (size_t)(r0 + j) * NIN + 2048 + h * 128 + cc;
        const u32x4 k = *(const u32x4*)src, v = *(const u32x4*)(src + 2048);
        const float zf = __builtin_amdgcn_exp2f((float)(127 - j) * lf2), zb = __builtin_amdgcn_exp2f((float)j * lb2);
        u32x4 kf, kb;
        kf.x = cvt_pk_bf16(bf_lo(k.x) * zf, bf_hi(k.x) * zf); kf.y = cvt_pk_bf16(bf_lo(k.y) * zf, bf_hi(k.y) * zf); kf.z = cvt_pk_bf16(bf_lo(k.z) * zf, bf_hi(k.z) * zf); kf.w = cvt_pk_bf16(bf_lo(k.w) * zf, bf_hi(k.w) * zf);
        kb.x = cvt_pk_bf16(bf_lo(k.x) * zb, bf_hi(k.x) * zb); kb.y = cvt_pk_bf16(bf_lo(k.y) * zb, bf_hi(k.y) * zb); kb.z = cvt_pk_bf16(bf_lo(k.z) * zb, bf_hi(k.z) * zb); kb.w = cvt_pk_bf16(bf_lo(k.w) * zb, bf_hi(k.w) * zb);
        *(LAS u32x4*)(Kf + j * RS + cc) = kf; *(LAS u32x4*)(Kb + j * RS + cc) = kb; *(LAS u32x4*)(Vs + j * RS + cc) = v; }
    __syncthreads();
    f32x4 af[2][4], ab[2][4];
#pragma unroll
    for (int a = 0; a < 2; ++a)
#pragma unroll
        for (int b = 0; b < 4; ++b) { af[a][b] = (f32x4){0.f, 0.f, 0.f, 0.f}; ab[a][b] = (f32x4){0.f, 0.f, 0.f, 0.f}; }
    const int vbase = (int)(uintptr_t)Vs, fbase = (int)(uintptr_t)Kf, bbase = (int)(uintptr_t)Kb;
#pragma unroll
    for (int ks = 0; ks < 4; ++ks) {
        const int rowoff = (32 * ks + 8 * g + q4) * RSB;
        bf16x8 A4[4], Bf[4], Bb[4];
        tr_frag4(vbase + rowoff + (32 * wr4 + 4 * p4) * 2, A4);
        tr_frag4(fbase + rowoff + (64 * wc2 + 4 * p4) * 2, Bf);
        tr_frag4(bbase + rowoff + (64 * wc2 + 4 * p4) * 2, Bb);
#pragma unroll
        for (int b = 0; b < 4; ++b)
#pragma unroll
            for (int a = 0; a < 2; ++a) { af[a][b] = mfma16(A4[a], Bf[b], af[a][b]); ab[a][b] = mfma16(A4[a], Bb[b], ab[a][b]); }
    }
    LAS float* Ys = (LAS float*)lds;
#pragma unroll
    for (int dir = 0; dir < 2; ++dir) {
        __syncthreads();
#pragma unroll
        for (int a = 0; a < 2; ++a)
#pragma unroll
            for (int b = 0; b < 4; ++b)
#pragma unroll
                for (int r = 0; r < 4; ++r) Ys[(32 * wr4 + 16 * a + 4 * g + r) * 132 + 64 * wc2 + 16 * b + lr] = dir ? ab[a][b][r] : af[a][b][r];
        __syncthreads();
        bf16_t* Ud = U + (size_t)(dir * 2048 + item) * 16384;
#pragma unroll
        for (int p = 0; p < 4; ++p) { const int idx = tid + 512 * p, j = idx >> 4, cc = (idx & 15) * 8;
            const f32x4 y0 = *(const LAS f32x4*)(Ys + j * 132 + cc), y1 = *(const LAS f32x4*)(Ys + j * 132 + cc + 4);
            u32x4 wv; wv.x = cvt_pk_bf16(y0[0], y0[1]); wv.y = cvt_pk_bf16(y0[2], y0[3]); wv.z = cvt_pk_bf16(y1[0], y1[1]); wv.w = cvt_pk_bf16(y1[2], y1[3]);
            *(u32x4*)(Ud + j * 128 + cc) = wv; }
    }
    __syncthreads();
}
constexpr int YS = 132;
static_assert(128 * YS * 4 <= 2 * RTB, "y tile fits the K + V tiles");
__device__ __forceinline__ void ret_item_geom(int it, const float* __restrict__ dl  , int& r0, int& h, float& lf2, float& lb2) {
    if (it < 1024) { const int sh = it >> 4, c = it & 15; h = sh & 15; r0 = (sh >> 4) * 2048 + c * 128; }
    else { const int i2 = it - 1024; h = i2 >> 6; r0 = 8192 + (i2 & 63) * 128; }
    lf2 = dl[h]; lb2 = dl[16 + h];
}
__device__ __forceinline__ void ret_out_phase(LAS unsigned char* lds, const bf16_t* __restrict__ PROJ, const bf16_t* __restrict__ SS, bf16_t* __restrict__ MIX, const float* __restrict__ dl, int first, int step) {
#define RET_LANE_IDS int tid_ = threadIdx.x; asm volatile("" : "+v"(tid_)); const int tid = tid_, lane = tid & 63, w = __builtin_amdgcn_readfirstlane(tid >> 6), g = lane >> 4, lr = lane & 15, q4 = (lane & 15) >> 2, p4 = lane & 3, wr4 = w >> 1, wc2 = w & 1; (void)q4; (void)p4; (void)wc2;
    LAS bf16_t* Ks = (LAS bf16_t*)lds; LAS bf16_t* Vs = Ks + 128 * RS; LAS bf16_t* Fs = Vs + 128 * RS; LAS bf16_t* Bs = Fs + 128 * RS; LAS float* RSUM = (LAS float*)(lds + 4 * RTB);
    LAS bf16_t* Ps = Ks; LAS float* Ys = (LAS float*)lds;
    if (first >= 2048) return;
    bf16x8 AQ[2][4]; u32x4 kv[4];
#define RET_LOAD_QK(r0_, h_) do { \
    _Pragma("unroll") for (int a = 0; a < 2; ++a) _Pragma("unroll") for (int ks = 0; ks < 4; ++ks) AQ[a][ks] = *(const bf16x8*)(PROJ + ((size_t)(r0_) * NIN + (h_) * 128) + (unsigned)((32 * wr4 + 16 * a + lr) * NIN + 32 * ks + 8 * g)); \
    _Pragma("unroll") for (int p = 0; p < 4; ++p) { const int idx = tid + 512 * p, j = idx >> 4, cc = (idx & 15) * 8; kv[p] = *(const u32x4*)(PROJ + ((size_t)(r0_) * NIN + 2048 + (h_) * 128) + (unsigned)(j * NIN + cc)); } } while (0)
    { RET_LANE_IDS int r0, h; float lf2, lb2; ret_item_geom(first, dl, r0, h, lf2, lb2); RET_LOAD_QK(r0, h); }
    for (int item = first; item < 2048; item += step) {
        RET_LANE_IDS
        int r0, h; float lf2, lb2; ret_item_geom(item, dl, r0, h, lf2, lb2);
        const bf16_t* SfT = SS + (size_t)item * 16384; const bf16_t* SbT = SS + (size_t)(2048 + item) * 16384;
        u32x4 vv[4], fv[4], bv[4], gv[4];
#pragma unroll
        for (int p = 0; p < 4; ++p) { const int idx = tid + 512 * p, j = idx >> 4, cc = (idx & 15) * 8;
            const bf16_t* pb = PROJ + ((size_t)r0 * NIN + 4096 + h * 128); const unsigned po = (unsigned)(j * NIN + cc), so = (unsigned)(j * 128 + cc);
            vv[p] = *(const u32x4*)(pb + po); gv[p] = *(const u32x4*)(pb + 2048 + po);
            fv[p] = *(const u32x4*)(SfT + so); bv[p] = *(const u32x4*)(SbT + so); }
#pragma unroll
        for (int p = 0; p < 4; ++p) { const int idx = tid + 512 * p, j = idx >> 4, cc = (idx & 15) * 8; *(LAS u32x4*)(Ks + j * RS + cc) = kv[p]; }
        __syncthreads();
        f32x4 sc[2][4];
#pragma unroll
        for (int a = 0; a < 2; ++a)
#pragma unroll
            for (int b = 0; b < 4; ++b) sc[a][b] = (f32x4){0.f, 0.f, 0.f, 0.f};
#pragma unroll
        for (int ks = 0; ks < 4; ++ks) {
            bf16x8 B[4];
#pragma unroll
            for (int b = 0; b < 4; ++b) B[b] = *(const LAS bf16x8*)(Ks + (64 * wc2 + 16 * b + lr) * RS + 32 * ks + 8 * g);
#pragma unroll
            for (int a = 0; a < 2; ++a)
#pragma unroll
                for (int b = 0; b < 4; ++b) sc[a][b] = mfma16(AQ[a][ks], B[b], sc[a][b]);
        }
#pragma unroll
        for (int a = 0; a < 2; ++a)
#pragma unroll
            for (int b = 0; b < 4; ++b)
#pragma unroll
                for (int r = 0; r < 4; ++r) { const int i = 32 * wr4 + 16 * a + 4 * g + r, j = 64 * wc2 + 16 * b + lr, d = i - j;
                    sc[a][b][r] *= __builtin_amdgcn_exp2f(d >= 0 ? (float)d * lf2 : (float)(-d) * lb2); }
        __syncthreads();
#pragma unroll
        for (int a = 0; a < 2; ++a)
#pragma unroll
            for (int b = 0; b < 4; ++b)
#pragma unroll
                for (int r = 0; r < 4; ++r) Ps[(32 * wr4 + 16 * a + 4 * g + r) * RS + 64 * wc2 + 16 * b + lr] = f2bf(sc[a][b][r]);
#pragma unroll
        for (int p = 0; p < 4; ++p) { const int idx = tid + 512 * p, j = idx >> 4, cc = (idx & 15) * 8;
            *(LAS u32x4*)(Vs + j * RS + cc) = vv[p]; *(LAS u32x4*)(Fs + j * RS + cc) = fv[p]; *(LAS u32x4*)(Bs + j * RS + cc) = bv[p]; }
        __syncthreads();
        f32x4 y[2][4];
#pragma unroll
        for (int a = 0; a < 2; ++a)
#pragma unroll
            for (int b = 0; b < 4; ++b) y[a][b] = (f32x4){0.f, 0.f, 0.f, 0.f};
        float xfr[2], xbr[2];
#pragma unroll
        for (int a = 0; a < 2; ++a) { const int i = 32 * wr4 + 16 * a + lr; xfr[a] = __builtin_amdgcn_exp2f((float)(i + 1) * lf2); xbr[a] = __builtin_amdgcn_exp2f((float)(128 - i) * lb2); }
        const int vbase = (int)(uintptr_t)Vs;
#pragma unroll
        for (int ks = 0; ks < 4; ++ks) {
            bf16x8 AP[2], AF[2], AB[2], BV[4], BF[4], BB[4];
#pragma unroll
            for (int a = 0; a < 2; ++a) { AP[a] = *(const LAS bf16x8*)(Ps + (32 * wr4 + 16 * a + lr) * RS + 32 * ks + 8 * g);
                const u32x4 q = __builtin_bit_cast(u32x4, AQ[a][ks]); u32x4 f, bq;
                f.x = cvt_pk_bf16(bf_lo(q.x) * xfr[a], bf_hi(q.x) * xfr[a]); f.y = cvt_pk_bf16(bf_lo(q.y) * xfr[a], bf_hi(q.y) * xfr[a]); f.z = cvt_pk_bf16(bf_lo(q.z) * xfr[a], bf_hi(q.z) * xfr[a]); f.w = cvt_pk_bf16(bf_lo(q.w) * xfr[a], bf_hi(q.w) * xfr[a]);
                bq.x = cvt_pk_bf16(bf_lo(q.x) * xbr[a], bf_hi(q.x) * xbr[a]); bq.y = cvt_pk_bf16(bf_lo(q.y) * xbr[a], bf_hi(q.y) * xbr[a]); bq.z = cvt_pk_bf16(bf_lo(q.z) * xbr[a], bf_hi(q.z) * xbr[a]); bq.w = cvt_pk_bf16(bf_lo(q.w) * xbr[a], bf_hi(q.w) * xbr[a]);
                AF[a] = __builtin_bit_cast(bf16x8, f); AB[a] = __builtin_bit_cast(bf16x8, bq); }
#pragma unroll
            for (int b = 0; b < 4; ++b) { BF[b] = *(const LAS bf16x8*)(Fs + (64 * wc2 + 16 * b + lr) * RS + 32 * ks + 8 * g); BB[b] = *(const LAS bf16x8*)(Bs + (64 * wc2 + 16 * b + lr) * RS + 32 * ks + 8 * g); }
            tr_frag4(vbase + (32 * ks + 8 * g + q4) * RSB + (64 * wc2 + 4 * p4) * 2, BV);
#pragma unroll
            for (int a = 0; a < 2; ++a)
#pragma unroll
                for (int b = 0; b < 4; ++b) { y[a][b] = mfma16(AP[a], BV[b], y[a][b]); y[a][b] = mfma16(AF[a], BF[b], y[a][b]); y[a][b] = mfma16(AB[a], BB[b], y[a][b]); }
        }
#pragma unroll
        for (int a = 0; a < 2; ++a)
#pragma unroll
            for (int r = 0; r < 4; ++r) { const int i = 32 * wr4 + 16 * a + 4 * g + r;
                float s = 0.f;
#pragma unroll
                for (int b = 0; b < 4; ++b) { const float v = y[a][b][r]; s += v * v; }
                s += __shfl_xor(s, 1); s += __shfl_xor(s, 2); s += __shfl_xor(s, 4); s += __shfl_xor(s, 8);
                if (lr == 0) RSUM[i * 2 + wc2] = s; }
        { const int nx = item + step; if (nx < 2048) { int r0n, hn; float a_, b_; ret_item_geom(nx, dl, r0n, hn, a_, b_); RET_LOAD_QK(r0n, hn); } }
        __syncthreads();
#pragma unroll
        for (int a = 0; a < 2; ++a)
#pragma unroll
            for (int r = 0; r < 4; ++r) { const int i = 32 * wr4 + 16 * a + 4 * g + r;
                const float rs = __builtin_amdgcn_rsqf((RSUM[i * 2] + RSUM[i * 2 + 1]) * (1.0f / 128.0f) + EPS);
#pragma unroll
                for (int b = 0; b < 4; ++b) Ys[i * YS + 64 * wc2 + 16 * b + lr] = y[a][b][r] * rs; }
        __syncthreads();
#pragma unroll
        for (int p = 0; p < 4; ++p) { const int idx = tid + 512 * p, j = idx >> 4, cc = (idx & 15) * 8;
            const f32x4 y0 = *(const LAS f32x4*)(Ys + j * YS + cc), y1 = *(const LAS f32x4*)(Ys + j * YS + cc + 4);
            const u32x4 gg = gv[p];
            const float gt[8] = {bf_lo(gg.x), bf_hi(gg.x), bf_lo(gg.y), bf_hi(gg.y), bf_lo(gg.z), bf_hi(gg.z), bf_lo(gg.w), bf_hi(gg.w)};
            float o[8];
#pragma unroll
            for (int e = 0; e < 8; ++e) { const float sg = gt[e] * __builtin_amdgcn_rcpf(1.0f + __builtin_amdgcn_exp2f(-gt[e] * 1.4426950408889634f)); o[e] = sg * (e < 4 ? y0[e & 3] : y1[e & 3]); }
            u32x4 wv; wv.x = cvt_pk_bf16(o[0], o[1]); wv.y = cvt_pk_bf16(o[2], o[3]); wv.z = cvt_pk_bf16(o[4], o[5]); wv.w = cvt_pk_bf16(o[6], o[7]);
            *(u32x4*)(MIX + ((size_t)r0 * DM + h * 128) + (unsigned)(j * DM + cc)) = wv; }
        __syncthreads();
    }
#undef RET_LOAD_QK
#undef RET_LANE_IDS
}

#ifndef PROBE
#define PROBE 0
#endif
constexpr int REP_P0 = PROBE == 1 ? 2 : 1, REP_R1 = PROBE == 2 ? 2 : 1, REP_R2 = PROBE == 7 ? 2 : 1, REP_R3 = PROBE == 8 ? 2 : 1, REP_G5 = PROBE == 3 ? 2 : 1, REP_ATT = PROBE == 4 ? 3 : 1, REP_G1 = PROBE == 5 ? 2 : 1, REP_PREP0 = PROBE == 6 ? 2 : 1, XTRA_G6 = PROBE == 9, XTRA_G2 = PROBE == 10, XTRA_G4 = PROBE == 11, XTRA_G5P = PROBE == 12; constexpr int XTRA_BARS = PROBE == 13 ? 20 : 0; constexpr int REP_SMALL = PROBE == 14 ? 2 : 1; constexpr bool XTRA_HOTG2 = PROBE == 15, XTRA_G5NULL = PROBE == 16, XTRA_G2NULL = PROBE == 17;
constexpr int CW_FIN = 245760;
static_assert((size_t)CW_FIN * 4 >= CTL_SSQ + 7ull * 16384 * 8 && (size_t)CW_FIN * 4 + 64 * 64 <= CTL_ZERO_BYTES, "panel counters inside the memset region");
constexpr bool FUSE_FINAL = false && (MK_N_LAUNCHES == 1);
constexpr int CW_SPLIT = 8192;
template <class T> __device__ __forceinline__ T* opq(T* p) { GAS T* q = (GAS T*)p; asm volatile("" : "+s"(q)); return (T*)q; }
__global__ void __launch_bounds__(NTHREADS, 2) trunk_fwd(Args args) {
    extern __shared__ __attribute__((aligned(16))) unsigned char lds_raw[];
    LAS unsigned char* lds = (LAS unsigned char*)lds_raw;
    volatile LAS unsigned* MISC = (volatile LAS unsigned*)(lds + MISC_OFF);
    const int G = gridDim.x; const int bx = blockIdx.x; const int vcu = (G % 8 == 0) ? (bx % 8) * (G / 8) + bx / 8 : bx;
#define WSP(T, off) ((T*)(wsp + (off)))
#define ctl WSP(unsigned, WS_CTL)
#define SSQ WSP(unsigned long long, WS_CTL + CTL_SSQ)
#define ROPE WSP(f32x2, WS_ROPE)
#define MEMSS WSP(float, WS_MEMSS)
#define LG2 WSP(float, WS_MEMSS + 8192)
#define WIN WSP(bf16_t, WS_WIN)
#define WOUT WSP(bf16_t, WS_WOUT)
#define WCQ WSP(bf16_t, WS_WCQ)
#define WCKV WSP(bf16_t, WS_WCKV)
#define WCO WSP(bf16_t, WS_WCO)
#define WUP WSP(bf16_t, WS_WUP)
#define WDOWN WSP(bf16_t, WS_WDOWN)
#define XB WSP(bf16_t, WS_XB)
#define PROJ WSP(bf16_t, WS_PROJ)
#define MIX WSP(bf16_t, WS_MIX)
#define CQ WSP(bf16_t, WS_CQ)
#define CO WSP(bf16_t, WS_CO)
#define MEMB WSP(bf16_t, WS_MEMB)
#define MKV WSP(bf16_t, WS_MKV)
#define GH WSP(bf16_t, WS_GH)
#define HB WSP(float, WS_HB)
#define UU WSP(bf16_t, WS_U)
#define SS WSP(bf16_t, WS_U)
#define XRES (args.out)
#define x_prompt (args.in[0])
#define x_sample (args.in[1])
#define mem_prompt (args.in[2])
#define mem_sample (args.in[3])
#define w_in (args.in[4])
#define w_out (args.in[5])
#define decay_logit (args.in[6])
#define q_norm (args.in[7])
#define k_norm (args.in[8])
#define norm_mix (args.in[9])
#define norm_cross (args.in[10])
#define norm_mem (args.in[11])
#define w_cq (args.in[12])
#define w_ckv (args.in[13])
#define w_co (args.in[14])
#define norm_ffn (args.in[15])
#define w_up (args.in[16])
#define conv_w (args.in[17])
#define conv_b (args.in[18])
#define w_down (args.in[19])
#define norm_final (args.in[20])
    if (threadIdx.x < 32) MISC[threadIdx.x] = 0u;
    __syncthreads();
    XcdBarrier bar; bar.bar = (unsigned*)(args.ws + WS_CTL) + CW_BAR; bar.x = 0; bar.st = nullptr;
    if (N_LAUNCHES == 1) bar = xcd_barrier_post((unsigned*)(args.ws + WS_CTL) + CW_BAR, MISC + 8);
    const int lo = args.ph_lo, hi = args.ph_hi;
#ifndef ONLY_SLOT
#define ONLY_SLOT -1
#endif
#define SLOT_ON(s) (ONLY_SLOT < 0 || ONLY_SLOT == (s))
#define INR(k) (lo <= (k) && (k) < hi)
#define IN0 (SLOT_ON(0) && INR(0))
#define INL(s) (SLOT_ON(1 + (s)) && INR(pb + (s)))
#define INF (SLOT_ON(13) && INR(26))
#define INM (SLOT_ON(14) && INR(1))
#ifndef PT_MASK
#define PT_MASK 0
#endif
#ifndef PT_LAYERS
#define PT_LAYERS 3
#endif
    constexpr int PT_K = 4;
    unsigned long long pt_prev = PT_MASK ? wall_clock64() : 0ull, pt_acc = 0ull;
#define PT_MARK(slot, lay) do { if (PT_MASK) { const unsigned long long now_ = wall_clock64(); if (((PT_MASK >> (slot)) & 1) && ((PT_LAYERS >> (lay)) & 1)) pt_acc += now_ - pt_prev; pt_prev = now_; } } while (0)
#define SEAM(k) do { if (N_LAUNCHES == 1 && INR(k) && INR((k) + 1)) xcd_barrier(bar); PT_MARK((k) == 0 ? 0 : 1 + ((k) - 2) % 12, (k) < 2 ? 0 : ((k) - 2) / 12); } while (0)
    const int NGW = G * NWAVES;
#define PHASE_LOCALS GAS unsigned char* wsg = (GAS unsigned char*)args.ws; asm volatile("" : "+s"(wsg)); unsigned char* wsp = (unsigned char*)wsg; int tid = threadIdx.x; asm volatile("" : "+v"(tid)); const int lane = tid & 63, wave = __builtin_amdgcn_readfirstlane(tid >> 6), gw = vcu * NWAVES + wave; (void)lane; (void)gw; (void)wave;

    if (IN0) {
        PHASE_LOCALS
        LAS float* scr = (LAS float*)(lds + wave * 16640);
        constexpr int I_IN = 64 * 176, I_OUT = 64 * 64, I_CQ = 64 * 8, I_CKV = 64 * 16, I_CO = 8 * 64, I_UP = 64 * 344, I_DN = 172 * 64;
        constexpr int I_LAYER = I_IN + I_OUT + I_CQ + I_CKV + I_CO + I_UP + I_DN;
        for (int rep = 0; rep < REP_P0; ++rep)
        for (int itr = gw; itr < 2 * I_LAYER; itr += NGW) {
            const int it = 2 * I_LAYER - 1 - itr; const int l = it / I_LAYER; int r = it % I_LAYER;
            if (r < I_IN) { p0_transpose_item<false, true>(w_in + (size_t)l * DM * NIN, DM, NIN, WIN + (size_t)l * NIN * DM, norm_mix + l * DM, 2048, 4096, 0.088388347648318440f, scr, r, lane); continue; } r -= I_IN;
            if (r < I_OUT) { p0_transpose_item<false>(w_out + (size_t)l * DM * DM, DM, DM, WOUT + (size_t)l * DM * DM, nullptr, 0, 0, 1.f, scr, r, lane); continue; } r -= I_OUT;
            if (r < I_CQ) { p0_transpose_item<false>(w_cq + (size_t)l * DM * MEMW, DM, MEMW, WCQ + (size_t)l * MEMW * DM, norm_cross + l * DM, 0, 0, 1.f, scr, r, lane); continue; } r -= I_CQ;
            if (r < I_CKV) { p0_transpose_item<false>(w_ckv + (size_t)l * DM * 1024, DM, 1024, WCKV + (size_t)l * 1024 * DM, norm_mem + l * DM, 0, 0, 1.f, scr, r, lane); continue; } r -= I_CKV;
            if (r < I_CO) { p0_transpose_item<false>(w_co + (size_t)l * MEMW * DM, MEMW, DM, WCO + (size_t)l * DM * MEMW, nullptr, 0, 0, 1.f, scr, r, lane); continue; } r -= I_CO;
            if (r < I_UP) { p0_transpose_item<true>(w_up + (size_t)l * DM * NUP, DM, NUP, WUP + (size_t)l * NUP * DM, norm_ffn + l * DM, 0, 0, 1.f, scr, r, lane); continue; } r -= I_UP;
            p0_transpose_item<false>(w_down + (size_t)l * DFF * DM, DFF, DM, WDOWN + (size_t)l * DM * DFF, nullptr, 0, 0, 1.f, scr, r, lane);
        }
        for (int rep = 0; rep < REP_SMALL; ++rep)
        for (int m = gw; m < MROWS; m += NGW) row_to_bf16(m < 8192 ? x_prompt + (size_t)m * DM : x_sample + (size_t)(m - 8192) * DM, XB + (size_t)m * DM, SSQ + m, lane);
        for (int m = gw; m < MEMROWS; m += NGW) row_to_bf16(m < 1024 ? mem_prompt + (size_t)m * DM : mem_sample + (size_t)(m - 1024) * DM, MEMB + (size_t)m * DM, MEMSS + m, lane);
        if (PROBE == 21) { u32x4* zp = (u32x4*)(wsp + WS_GH); const size_t n16 = (WS_U - WS_GH) / 16; const u32x4 z = {0u, 0u, 0u, 0u};
            for (size_t i = (size_t)bx * NTHREADS + tid; i < n16; i += (size_t)G * NTHREADS) zp[i] = z; }
        if (bx == 0 && tid < 64) LG2[tid] = -log1pf(__expf(-decay_logit[tid])) * 1.4426950408889634f;
        if (bx == 0 && tid >= 64 && tid < 66) {
            const int ll = tid - 64; float gq = 0.f, gk = 0.f;
            for (int d = 0; d < 128; ++d) { gq = fmaxf(gq, fabsf(q_norm[ll * 128 + d])); gk = fmaxf(gk, fabsf(k_norm[ll * 128 + d])); }
            LG2[64 + ll] = fmaxf(0.f, 1.02f * 128.0f * gq * gk * (0.088388347648318440f * 1.4426950408889634f) - 64.0f); }
        for (int e = bx * NTHREADS + tid; e < 128 * 32; e += G * NTHREADS) { const int pos = e >> 5, i = e & 31;
            const float freq = __builtin_amdgcn_exp2f(-(float)i * (13.287712379549449f / 32.0f));
            const float rev = (float)pos * freq * 0.15915494309189535f, fr = rev - __builtin_floorf(rev);
            ROPE[e] = (f32x2){__builtin_amdgcn_cosf(fr), __builtin_amdgcn_sinf(fr)}; }
    }
    SEAM(0);
    for (int l = 0; l < 2; ++l) {
        const int pb = 2 + 12 * l;
        if (INL(0)) {
            PHASE_LOCALS
            pg8::Gemm g{opq(XB), opq(WIN + (size_t)l * NIN * DM), MROWS, NIN, DM}; pg8::StaticOrder S; S.init(MROWS, NIN, G, bx); pg8::EpiProjRope E{PROJ, SSQ + (3 * l) * MROWS, ROPE, q_norm + l * 128, k_norm + l * 128};
            for (int rep = 0; rep < REP_G1; ++rep) pg8::gemm_phase<pg8::EpiProjRope, pg8::StaticOrder, true, true>(lds, lds + XL_OFF, g, S, E);
        }
        SEAM(pb + 0);
        if (INL(2)) {
            PHASE_LOCALS
#define ATT_UNITS(FIXM_) \
            for (int rep = 0; rep < REP_ATT; ++rep) \
            for (int pass = 0; pass < 2; ++pass) \
                for (int u = vcu; u < 512; u += G) { \
                    int rowbase, h, qb, keys; \
                    if (pass == 0) { const int seq = u >> 7, rem = u & 127; h = rem >> 3; qb = rem & 7; rowbase = seq * 2048; keys = 2048; } \
                    else { h = u >> 5; qb = u & 31; rowbase = 8192; keys = 8192; } \
                    const bf16_t* Qb = PROJ + (size_t)(rowbase + qb * 256) * NIN + 8192 + h * 128; \
                    const bf16_t* Kh = PROJ + (size_t)rowbase * NIN + 10240 + (h >> 2) * 128; \
                    bf16_t* Ob = MIX + (size_t)(rowbase + qb * 256) * DM + 2048 + h * 128; \
                    att::attn_dense_body<NIN, NIN, DM, FIXM_>(Qb, Kh, Kh + 512, Ob, keys, lds); \
                    __syncthreads(); \
                }
            if (LG2[64 + l] == 0.f) { ATT_UNITS(true) }
            else { ATT_UNITS(false) }
#undef ATT_UNITS
            for (int rep = 0; rep < REP_R1; ++rep)
            for (int it = vcu; it < 2048; it += G) {
                int r0, h;
                if (it < 1024) { const int sh = it >> 4, c = it & 15; h = sh & 15; r0 = (sh >> 4) * 2048 + c * 128; }
                else { const int i2 = it - 1024; h = i2 >> 6; r0 = 8192 + (i2 & 63) * 128; }
                const float lf2 = LG2[(l * 2 + 0) * 16 + h], lb2 = LG2[(l * 2 + 1) * 16 + h];
                ret_state_item(lds, PROJ, UU, r0, h, it, lf2, lb2);
            }
        }
        SEAM(pb + 2);
        if (INL(3)) {
            PHASE_LOCALS
            for (int rep = 0; rep < REP_R2; ++rep)
            for (int task = bx * NTHREADS + tid; task < 80 * 2 * 2048; task += G * NTHREADS) {
                const int e8 = task & 2047, dir = (task >> 11) & 1, sh = task >> 12;
                const int h = sh & 15, nc = sh < 64 ? 16 : 64, ibase = sh < 64 ? sh * 16 : 1024 + (sh - 64) * 64;
                const float dC = __builtin_amdgcn_exp2f(LG2[(l * 2 + dir) * 16 + h] * 128.0f);
                bf16_t* sp = SS + ((size_t)dir * 2048 + ibase) * 16384 + e8 * 8;
                f32x4 s0 = {0.f, 0.f, 0.f, 0.f}, s1 = s0;
                for (int cb = 0; cb < nc; cb += 8) {
                    u32x4 uv[8];
#pragma unroll
                    for (int k = 0; k < 8; ++k) { const int c = dir ? nc - 1 - (cb + k) : cb + k; uv[k] = *(const u32x4*)(sp + (size_t)c * 16384); }
#pragma unroll
                    for (int k = 0; k < 8; ++k) { const int c = dir ? nc - 1 - (cb + k) : cb + k;
                        u32x4 w; w.x = cvt_pk_bf16(s0[0], s0[1]); w.y = cvt_pk_bf16(s0[2], s0[3]); w.z = cvt_pk_bf16(s1[0], s1[1]); w.w = cvt_pk_bf16(s1[2], s1[3]); *(u32x4*)(sp + (size_t)c * 16384) = w;
                        s0 = s0 * dC + (f32x4){bf_lo(uv[k].x), bf_hi(uv[k].x), bf_lo(uv[k].y), bf_hi(uv[k].y)}; s1 = s1 * dC + (f32x4){bf_lo(uv[k].z), bf_hi(uv[k].z), bf_lo(uv[k].w), bf_hi(uv[k].w)}; }
                }
            }
        }
        SEAM(pb + 3);
        if (INL(4)) {
            PHASE_LOCALS
            for (int rep = 0; rep < REP_R3; ++rep) ret_out_phase(lds, PROJ, SS, MIX, LG2 + l * 32, vcu, G);
        }
        SEAM(pb + 4);
        if (INL(5)) {
            PHASE_LOCALS
            pg8::Gemm g{opq(MIX), opq(WOUT + (size_t)l * DM * DM), MROWS, DM, DM}; pg8::StaticOrder S; S.init(MROWS, DM, G, bx);
            pg8::EpiRes E{XB, SSQ + (3 * l + 1) * MROWS};
            if (XTRA_G2NULL) { pg8::EpiNull E0{(float*)UU}; pg8::gemm_phase<pg8::EpiNull, pg8::StaticOrder, true, true>(lds, lds + XL_OFF, g, S, E0); }
            if (XTRA_G2) { pg8::EpiRes E2{(bf16_t*)UU, (unsigned long long*)HB}; pg8::gemm_phase<pg8::EpiRes, pg8::StaticOrder, true, true>(lds, lds + XL_OFF, g, S, E2); }
            pg8::gemm_phase<pg8::EpiRes, pg8::StaticOrder, true, true>(lds, lds + XL_OFF, g, S, E);
        }
        SEAM(pb + 5);
        if (INL(6)) {
            PHASE_LOCALS
            if (l == 0) {
                if (bx >= 128) { pg8::Gemm g{opq(MEMB), opq(WCKV), MEMROWS, 2048, DM}; pg8::StaticOrder S; S.init(MEMROWS, 2048, G - 128, bx - 128); pg8::EpiProj E{MKV, 2048, nullptr, MEMSS, nullptr, nullptr, 0};
                    pg8::gemm_phase<pg8::EpiProj, pg8::StaticOrder, true, true>(lds, lds + XL_OFF, g, S, E); }
                else { pg8::Gemm g{opq(XB), opq(WCQ + (size_t)l * MEMW * DM), MROWS, MEMW, DM}; pg8::StaticOrder S; S.init(MROWS, MEMW, G, bx); pg8::EpiProj E{CQ, MEMW, SSQ + (3 * l + 1) * MROWS, nullptr, nullptr, nullptr, 0};
                    pg8::gemm_phase<pg8::EpiProj, pg8::StaticOrder, true, true>(lds, lds + XL_OFF, g, S, E); }
            } else {
                pg8::Gemm g{opq(XB), opq(WCQ + (size_t)l * MEMW * DM), MROWS, MEMW, DM}; pg8::SplitLastOrder S; S.init(MROWS, MEMW, G, bx); S.full = (G == 256) ? 0 : 1000000; S.ntl = DM / 64;
                pg8::EpiProj E{CQ, MEMW, SSQ + (3 * l + 1) * MROWS, nullptr, (unsigned long long*)UU, ctl + CW_SPLIT + (2 + l) * 128 * 16, bx & 127};
                pg8::gemm_phase<pg8::EpiProj, pg8::SplitLastOrder, true, true>(lds, lds + XL_OFF, g, S, E);
            }
        }
        SEAM(pb + 6);
        if (INL(7)) {
            PHASE_LOCALS
            for (int rep = 0; rep < REP_SMALL; ++rep)
            for (int u = vcu; u < 256; u += G) { const int rb = u >> 2, h = u & 3, b = rb < 32 ? (rb >> 3) : 4;
                const bf16_t* Kh = MKV + (size_t)(b * 256) * 2048 + l * 1024 + h * 128;
                att::attn_dense_body<MEMW, 2048, MEMW>(CQ + (size_t)(rb * 256) * MEMW + h * 128, Kh, Kh + 512, CO + (size_t)(rb * 256) * MEMW + h * 128, 256, lds);
                __syncthreads(); }
        }
        SEAM(pb + 7);
        if (INL(8)) {
            PHASE_LOCALS
            pg8::Gemm g{opq(CO), opq(WCO + (size_t)l * DM * MEMW), MROWS, DM, MEMW}; pg8::StaticOrder S; S.init(MROWS, DM, G, bx);
            pg8::EpiRes E{XB, SSQ + (3 * l + 2) * MROWS};
            if (XTRA_G4) { pg8::EpiRes E2{(bf16_t*)UU, (unsigned long long*)HB}; pg8::gemm_phase<pg8::EpiRes, pg8::StaticOrder, true, true>(lds, lds + XL_OFF, g, S, E2); }
            pg8::gemm_phase<pg8::EpiRes, pg8::StaticOrder, true, true>(lds, lds + XL_OFF, g, S, E);
        }
        SEAM(pb + 8);
        if (INL(9)) {
            PHASE_LOCALS
            pg8::Gemm g{opq(XB), opq(WUP + (size_t)l * NUP * DM), MROWS, NUP, DM}; pg8::SplitLastOrder S; S.init(MROWS, NUP, G, bx); S.full = (G == 256) ? 21 : 1000000; S.ntl = DM / 64;
            pg8::EpiConv E{wsp, WS_GH, WS_HB, WS_CTL + CTL_SSQ + (size_t)(3 * l + 2) * MROWS * 8, conv_w + (size_t)l * 3 * NUP, conv_b + (size_t)l * NUP, (unsigned long long*)UU, ctl + CW_SPLIT + l * 128 * 16, bx & 127};
            if (PROBE == 19 || PROBE == 20) { pg8::AliasOrder SA; SA.init(MROWS, NUP, G, bx); SA.am = PROBE == 20 ? 7 : ~0; SA.an = PROBE == 19 ? 3 : ~0; pg8::EpiNull E0{(float*)UU}; pg8::gemm_phase<pg8::EpiNull, pg8::AliasOrder, true, true>(lds, lds + XL_OFF, g, SA, E0); }
            if (XTRA_G5NULL) { pg8::EpiNull E0{(float*)UU}; pg8::gemm_phase<pg8::EpiNull, pg8::StaticOrder, true, true>(lds, lds + XL_OFF, g, S, E0); }
            if (XTRA_G5P) { pg8::EpiProj E2{PROJ, NIN, SSQ + (3 * l + 2) * MROWS, nullptr, nullptr, nullptr, 0}; pg8::gemm_phase<pg8::EpiProj, pg8::StaticOrder, true, true>(lds, lds + XL_OFF, g, S, E2); }
            for (int rep = 0; rep < REP_G5; ++rep) pg8::gemm_phase<pg8::EpiConv, pg8::SplitLastOrder, true, true>(lds, lds + XL_OFF, g, S, E);
            if (XTRA_HOTG2) { pg8::Gemm g2{opq(MIX), opq(WOUT + (size_t)l * DM * DM), MROWS, DM, DM}; pg8::StaticOrder S2; S2.init(MROWS, DM, G, bx);
                pg8::EpiRes E2{(bf16_t*)UU, (unsigned long long*)(UU + (size_t)MROWS * DM)}; pg8::gemm_phase<pg8::EpiRes, pg8::StaticOrder, true, true>(lds, lds + XL_OFF, g2, S2, E2); }
        }
        SEAM(pb + 9);
        if (INL(10)) {
            PHASE_LOCALS
            const float* cw = conv_w + (size_t)l * 3 * NUP; const float* cbp = conv_b + (size_t)l * NUP;
            for (int rep = 0; rep < REP_SMALL; ++rep)
            for (int task = bx * NTHREADS + tid; task < 128 * (DFF / 4); task += G * NTHREADS) {
                const int cq = task % (DFF / 4), rt = task / (DFF / 4), pm = rt >> 1, which = rt & 1, c = cq * 4;
                const bool is_start = (pm % 8 == 0) && (pm <= 32), is_end = ((pm % 8 == 7) && (pm < 32)) || (pm == 63);
                const float* hp; const float* hc; const float* hn; bool zp = false, zn = false;
                if (which == 0) { hp = HB + (size_t)((pm > 0 ? pm - 1 : 0) * 4 + 3) * NUP; zp = is_start; hc = HB + (size_t)(pm * 4 + 0) * NUP; hn = HB + (size_t)(pm * 4 + 1) * NUP; }
                else { hp = HB + (size_t)(pm * 4 + 2) * NUP; hc = HB + (size_t)(pm * 4 + 3) * NUP; hn = HB + (size_t)((pm < 63 ? pm + 1 : 63) * 4 + 0) * NUP; zn = is_end; }
                const f32x4 z4 = {0.f, 0.f, 0.f, 0.f};
                const f32x4 pa = zp ? z4 : *(const f32x4*)(hp + c), pu = zp ? z4 : *(const f32x4*)(hp + DFF + c);
                const f32x4 ca = *(const f32x4*)(hc + c), cu = *(const f32x4*)(hc + DFF + c);
                const f32x4 na = zn ? z4 : *(const f32x4*)(hn + c), nu = zn ? z4 : *(const f32x4*)(hn + DFF + c);
                const f32x4 va = *(const f32x4*)(cw + c) * pa + *(const f32x4*)(cw + NUP + c) * ca + *(const f32x4*)(cw + 2 * NUP + c) * na + *(const f32x4*)(cbp + c);
                const f32x4 vu = *(const f32x4*)(cw + DFF + c) * pu + *(const f32x4*)(cw + NUP + DFF + c) * cu + *(const f32x4*)(cw + 2 * NUP + DFF + c) * nu + *(const f32x4*)(cbp + DFF + c);
                const f32x2 g0 = pg8::gelu_pk((f32x2){va[0], va[1]}), g1 = pg8::gelu_pk((f32x2){va[2], va[3]});
                u32x2 w; w.x = cvt_pk_bf16(g0.x * vu[0], g0.y * vu[1]); w.y = cvt_pk_bf16(g1.x * vu[2], g1.y * vu[3]);
                *(u32x2*)(GH + (size_t)(pm * 256 + (which ? 255 : 0)) * DFF + c) = w;
            }
        }
        SEAM(pb + 10);
        if (INL(11)) {
            PHASE_LOCALS
            pg8::Gemm g{opq(GH), opq(WDOWN + (size_t)l * DM * DFF), MROWS, DM, DFF}; pg8::StaticOrder S; S.init(MROWS, DM, G, bx, 1);
            if (XTRA_G6) { pg8::EpiRes E2{(bf16_t*)UU, (unsigned long long*)HB}; pg8::gemm_phase<pg8::EpiRes, pg8::StaticOrder, true, true>(lds, lds + XL_OFF, g, S, E2); }
            if (FUSE_FINAL && l == 1) { pg8::EpiResFinal E{XB, SSQ + (3 * l + 3) * MROWS, ctl + CW_FIN, norm_final, XRES}; pg8::gemm_phase<pg8::EpiResFinal, pg8::StaticOrder, true, true>(lds, lds + XL_OFF, g, S, E); }
            else { pg8::EpiRes E{XB, SSQ + (3 * l + 3) * MROWS}; pg8::gemm_phase<pg8::EpiRes, pg8::StaticOrder, true, true>(lds, lds + XL_OFF, g, S, E); }
        }
        if (!(FUSE_FINAL && l == 1)) SEAM(pb + 11);
    }
    if (N_LAUNCHES == 1) for (int i = 0; i < XTRA_BARS; ++i) xcd_barrier(bar);
    if (INF && !FUSE_FINAL) {
        PHASE_LOCALS
        for (int rep = 0; rep < REP_SMALL; ++rep)
        for (int m = gw; m < MROWS; m += NGW) { const float rs = __builtin_amdgcn_rsqf((float)SSQ[6 * MROWS + m] * (1.0f / 1048576.0f / 4096.0f) + EPS);
            const u32x4* xr = (const u32x4*)(XB + (size_t)m * DM) + lane; f32x4* orow = (f32x4*)(XRES + (size_t)m * DM); const f32x4* gp = (const f32x4*)norm_final;
#pragma unroll
            for (int j = 0; j < 8; ++j) { const u32x4 x = __builtin_nontemporal_load(xr + 64 * j); const int c4 = (64 * j + lane) * 2;
                const f32x4 g0 = gp[c4], g1 = gp[c4 + 1];
                __builtin_nontemporal_store((f32x4){bf_lo(x.x), bf_hi(x.x), bf_lo(x.y), bf_hi(x.y)} * rs * g0, orow + c4);
                __builtin_nontemporal_store((f32x4){bf_lo(x.z), bf_hi(x.z), bf_lo(x.w), bf_hi(x.w)} * rs * g1, orow + c4 + 1); } }
    }
    if (PT_MASK) { PT_MARK(13, 0); if (bx == 0) { const unsigned long long until_ = wall_clock64() + (unsigned long long)PT_K * pt_acc; while (wall_clock64() < until_) __builtin_amdgcn_s_sleep(8); } }
#undef INR
#undef SEAM
}

extern "C" void kernel_launch(void* const* d_in, const int* in_sizes, int n_in, void* d_out, int out_size, void* d_ws, size_t ws_size, hipStream_t stream) {
    static int grid = 0;
    if (grid == 0) {
        if (n_in != 21 || out_size != MROWS * DM || ws_size < WS_END) { fprintf(stderr, "kernel_launch: unexpected shapes: n_in %d out %d ws %zu (need %zu)\n", n_in, out_size, ws_size, (size_t)WS_END); grid = -1; return; }
        int dev = 0, cus = 0, per_cu = 0;
        if (hipGetDevice(&dev) != hipSuccess || hipDeviceGetAttribute(&cus, hipDeviceAttributeMultiprocessorCount, dev) != hipSuccess) { grid = -1; return; }
        if (hipFuncSetAttribute((const void*)trunk_fwd, hipFuncAttributeMaxDynamicSharedMemorySize, LDS_BYTES) != hipSuccess) { fprintf(stderr, "kernel_launch: hipFuncSetAttribute failed\n"); grid = -1; return; }
        if (hipOccupancyMaxActiveBlocksPerMultiprocessor(&per_cu, (const void*)trunk_fwd, NTHREADS, LDS_BYTES) != hipSuccess || per_cu < 1) fprintf(stderr, "kernel_launch: occupancy query reports %d blocks per CU\n", per_cu);
        (void)hipGetLastError();
        grid = cus;
    }
    if (grid < 0) return;
    if (hipMemsetAsync((char*)d_ws + WS_CTL, 0, CTL_ZERO_BYTES, stream) != hipSuccess) { fprintf(stderr, "kernel_launch: memset failed\n"); return; }
    Args a{};
    for (int i = 0; i < 21; ++i) a.in[i] = (const float*)d_in[i];
    a.out = (float*)d_out; a.ws = (unsigned char*)d_ws;
    if (N_LAUNCHES == 1) { a.ph_lo = 0; a.ph_hi = NPHASES; hipLaunchKernelGGL(trunk_fwd, dim3(grid), dim3(NTHREADS), LDS_BYTES, stream, a); }
    else for (int p = 0; p < NPHASES; ++p) { a.ph_lo = p; a.ph_hi = p + 1; hipLaunchKernelGGL(trunk_fwd, dim3(grid), dim3(NTHREADS), LDS_BYTES, stream, a); }
    const hipError_t le = hipPeekAtLastError();
    if (le != hipSuccess) fprintf(stderr, "kernel_launch: launch failed: %s\n", hipGetErrorName(le));
}
```

```cpp
#include <hip/hip_runtime.h>
#include <cstdio>
#include <cstdint>

#define GAS __attribute__((address_space(1)))
#define LAS __attribute__((address_space(3)))
typedef unsigned short bf16_t;
typedef short bf16x8 __attribute__((ext_vector_type(8)));
typedef short s16x4 __attribute__((ext_vector_type(4)));
typedef float f32x4 __attribute__((ext_vector_type(4)));
typedef float f32x2 __attribute__((ext_vector_type(2)));
typedef float f32x16 __attribute__((ext_vector_type(16)));
typedef unsigned u32x4 __attribute__((ext_vector_type(4)));
typedef unsigned u32x2 __attribute__((ext_vector_type(2)));

constexpr int DM = 4096, MROWS = 16384, NIN = 11264, DFF = 11008, NUP = 22016, MEMROWS = 1280, MEMW = 512;
constexpr float EPS = 1e-6f;
#ifndef MK_N_LAUNCHES
#define MK_N_LAUNCHES 1
#endif

__device__ __forceinline__ unsigned cvt_pk_bf16(float lo, float hi) { unsigned r; asm volatile("v_cvt_pk_bf16_f32 %0, %1, %2" : "=v"(r) : "v"(lo), "v"(hi)); return r; }
__device__ __forceinline__ float bf_lo(unsigned w) { return __uint_as_float(w << 16); }
__device__ __forceinline__ float bf_hi(unsigned w) { return __uint_as_float(w & 0xffff0000u); }
__device__ __forceinline__ float bf2f(bf16_t b) { return __uint_as_float(((unsigned)b) << 16); }
__device__ __forceinline__ bf16_t f2bf(float f) { return (bf16_t)(cvt_pk_bf16(f, 0.f) & 0xffffu); }

#ifndef PT_EPI
#define PT_EPI 0
#endif
namespace pg8 {
#define PG8_LAS __attribute__((address_space(3)))
constexpr int BM = 256, BK = 64, HALF = 128, HTB = HALF * BK * 2  , STAGE_BYTES = 8 * HTB, NXCD = 8, WGM = 8;

__host__ __device__ __forceinline__ int lds_byte(int r, int c) { const int st = (r >> 4) * 2 + (c >> 5), rr = r & 15, cc = c & 31, ob = rr * 64 + cc * 2; return st * 1024 + (ob ^ (((ob >> 9) & 1) << 5)); }
__host__ __device__ __forceinline__ void stage_rc(int b, int& R, int& C) { const int st = b / 1024, sb = b % 1024, swz = sb ^ (((sb >> 9) & 1) << 5); R = (st >> 1) * 16 + swz / 64; C = (st & 1) * 32 + (swz % 64) / 2; }
__host__ __device__ __forceinline__ int perm32(int rho) { const int n = rho >> 4, i = rho & 15; return 8 * (i >> 2) + 4 * n + (i & 3); }

struct Unit { int pm, pn, kt0, nkt, fin; };
struct Gemm { const bf16_t* A; const bf16_t* Bt; int M, N, K; };

struct StaticOrder {
    int nM, nN, nwg, G, c, pn_inner;
    __host__ __device__ void init(int M, int N, int G_, int c_, int pn_inner_ = 0) { nM = M / BM; nN = N / BM; nwg = nM * nN; G = G_; c = c_; pn_inner = pn_inner_; }
    __host__ __device__ bool next(int i, Unit& u) const { return map((long)i * G + c, u); }
    __host__ __device__ bool map(long L, Unit& u) const {
        if (L >= nwg) return false;
        int wgid = (int)L; { const int q = nwg / NXCD, r = nwg % NXCD, xcd = wgid % NXCD, off = wgid / NXCD; wgid = (xcd < r ? xcd * (q + 1) : r * (q + 1) + (xcd - r) * q) + off; }
        const int nig = WGM * nN, gid = wgid / nig, fm = gid * WGM, gsz = (nM - fm) < WGM ? (nM - fm) : WGM;
        if (pn_inner) { u.pm = fm + ((wgid % nig) / nN); u.pn = (wgid % nig) % nN; } else { u.pm = fm + ((wgid % nig) % gsz); u.pn = (wgid % nig) / gsz; }
        u.kt0 = 0; u.nkt = 0; u.fin = 1; return true;
    }
    __device__ __forceinline__ void a_ready(const Unit&) const {}
    __device__ __forceinline__ void done(const Unit&) const {}
};

struct AliasOrder : StaticOrder {
    int am, an;
    __device__ bool next(int i, Unit& u) const { const bool r = StaticOrder::next(i, u); u.pm &= am; u.pn &= an; return r; }
};
struct SplitLastOrder : StaticOrder {
    int full, ntl;
    __device__ bool next(int i, Unit& u) const {
        if (i < full) return StaticOrder::next(i, u);
        if (i > full) return false;
        const int half = G / 2, cc = c < half ? c : c - half;
        if (!map((long)full * G + cc, u)) return false;
        u.nkt = ntl / 2; u.kt0 = c < half ? 0 : ntl / 2; u.fin = c < half ? 2 : 3; return true;
    }
};

#define SPLITK_HANDOFF() \
    if (u.fin == 3) { \
            f32x4* dst = (f32x4*)scr + ((size_t)slot * 32) * 512 + (((wr * 4 + wc) * 4 + fq) * 16 + fr); \
_Pragma("unroll") \
            for (int ai = 0; ai < 2; ++ai) \
_Pragma("unroll") \
                for (int bj = 0; bj < 2; ++bj) \
_Pragma("unroll") \
                    for (int m = 0; m < 4; ++m) \
_Pragma("unroll") \
                        for (int n = 0; n < 2; ++n) { const int k = ((ai * 2 + bj) * 4 + m) * 2 + n; f32x4* p = dst + (size_t)k * 512; \
                            asm volatile("global_store_dwordx4 %0, %1, off sc1" :: "v"(p), "v"(acc[ai][bj][m][n]) : "memory"); } \
            asm volatile("s_waitcnt vmcnt(0)" ::: "memory"); __builtin_amdgcn_s_barrier(); asm volatile("" ::: "memory"); \
            if (wr == 0 && wc == 0 && fq == 0 && fr == 0) __hip_atomic_store(flag + slot * 16, 1u, __ATOMIC_RELAXED, __HIP_MEMORY_SCOPE_AGENT); \
            return; \
        } \
    if (u.fin == 2) { \
            if (wr == 0 && wc == 0) { unsigned sp = 0; \
                while ((unsigned)__builtin_amdgcn_readfirstlane(__hip_atomic_load(flag + slot * 16, __ATOMIC_RELAXED, __HIP_MEMORY_SCOPE_AGENT)) == 0u) { __builtin_amdgcn_s_sleep(2); if (++sp > (1u << 20)) break; } \
                __builtin_amdgcn_fence(__ATOMIC_ACQUIRE, "agent"); asm volatile("s_waitcnt vmcnt(0)" ::: "memory"); } \
            asm volatile("" ::: "memory"); __builtin_amdgcn_s_barrier(); asm volatile("" ::: "memory"); \
            const f32x4* src = (const f32x4*)scr + ((size_t)slot * 32) * 512 + (((wr * 4 + wc) * 4 + fq) * 16 + fr); \
_Pragma("unroll") \
            for (int ai = 0; ai < 2; ++ai) \
_Pragma("unroll") \
                for (int bj = 0; bj < 2; ++bj) \
_Pragma("unroll") \
                    for (int m = 0; m < 4; ++m) \
_Pragma("unroll") \
                        for (int n = 0; n < 2; ++n) { const int k = ((ai * 2 + bj) * 4 + m) * 2 + n; acc[ai][bj][m][n] += src[(size_t)k * 512]; } \
        }

__device__ __forceinline__ f32x2 gelu_pk(f32x2 v) {
    const f32x2 av = __builtin_elementwise_abs(v), d = av * 0.2316418882f + 1.0f;
    f32x2 t; t.x = __builtin_amdgcn_rcpf(d.x); t.y = __builtin_amdgcn_rcpf(d.y);
    f32x2 q = t * 0.5307027145f + (-0.7265760135f); q = q * t + 0.7107068705f; q = q * t + (-0.142248368f); q = q * t + 0.127414796f; q = q * t;
    const f32x2 s = (v * v) * (-0.72134752044f);
    f32x2 e; e.x = __builtin_amdgcn_exp2f(s.x); e.y = __builtin_amdgcn_exp2f(s.y);
    const f32x2 m = v * (q * e), r = v - m;
    f32x2 o; o.x = v.x < 0.f ? m.x : r.x; o.y = v.y < 0.f ? m.y : r.y; return o;
}

struct EpiProj {
    static constexpr bool PERM = true, AFTER_DRAIN = false;
    bf16_t* O; int ldc; const unsigned long long* ssq; const float* ssqf;
    unsigned long long* scr; unsigned* flag; int slot;
    __device__ __forceinline__ void operator()(f32x4 (&acc)[2][2][4][2], const Unit& u, int wr, int wc, int fr_, int fq_, PG8_LAS unsigned char*) const {
        int fr = fr_, fq = fq_; asm volatile("" : "+v"(fr), "+v"(fq));
        SPLITK_HANDOFF()
        const int row0 = u.pm * BM + wr * 64 + fr, col0 = u.pn * BM + wc * 32 + 8 * fq;
        float rsv[8];
        if (ssq) { unsigned long long q[8];
#pragma unroll
            for (int k = 0; k < 8; ++k) q[k] = ssq[row0 + (k >> 2) * HALF + (k & 3) * 16];
            asm volatile("" : "+v"(q[0]), "+v"(q[1]), "+v"(q[2]), "+v"(q[3]), "+v"(q[4]), "+v"(q[5]), "+v"(q[6]), "+v"(q[7]));
#pragma unroll
            for (int k = 0; k < 8; ++k) rsv[k] = __builtin_amdgcn_rsqf((float)q[k] * (1.0f / 1048576.0f / 4096.0f) + EPS);
        } else { float q[8];
#pragma unroll
            for (int k = 0; k < 8; ++k) q[k] = ssqf[row0 + (k >> 2) * HALF + (k & 3) * 16];
            asm volatile("" : "+v"(q[0]), "+v"(q[1]), "+v"(q[2]), "+v"(q[3]), "+v"(q[4]), "+v"(q[5]), "+v"(q[6]), "+v"(q[7]));
#pragma unroll
            for (int k = 0; k < 8; ++k) rsv[k] = __builtin_amdgcn_rsqf(q[k] * (1.0f / 4096.0f) + EPS);
        }
#pragma unroll
        for (int ai = 0; ai < 2; ++ai)
#pragma unroll
            for (int m = 0; m < 4; ++m) { const int row = row0 + ai * HALF + m * 16; const float rs = rsv[ai * 4 + m];
                bf16_t* rowp = O + (size_t)row * ldc + col0;
#pragma unroll
                for (int bj = 0; bj < 2; ++bj) { const f32x4 v0 = acc[ai][bj][m][0] * rs, v1 = acc[ai][bj][m][1] * rs;
                    u32x4 w; w.x = cvt_pk_bf16(v0[0], v0[1]); w.y = cvt_pk_bf16(v0[2], v0[3]); w.z = cvt_pk_bf16(v1[0], v1[1]); w.w = cvt_pk_bf16(v1[2], v1[3]);
                    *(u32x4*)(rowp + bj * HALF) = w; } }
    }
};
struct EpiNull {
    static constexpr bool PERM = true, AFTER_DRAIN = false;
    float* sink;
    __device__ __forceinline__ void operator()(f32x4 (&acc)[2][2][4][2], const Unit& u, int wr, int wc, int fr, int fq, PG8_LAS unsigned char*) const {
        float s = 0.f;
#pragma unroll
        for (int ai = 0; ai < 2; ++ai)
#pragma unroll
            for (int bj = 0; bj < 2; ++bj)
#pragma unroll
                for (int m = 0; m < 4; ++m)
#pragma unroll
                    for (int n = 0; n < 2; ++n) s += acc[ai][bj][m][n][0] + acc[ai][bj][m][n][1] + acc[ai][bj][m][n][2] + acc[ai][bj][m][n][3];
        if (s == 123456.789f) sink[u.pm + wr + wc + fr + fq] = s;
    }
};
struct EpiProjRope {
    static constexpr bool PERM = true, AFTER_DRAIN = false;
    bf16_t* O; const unsigned long long* ssq; const f32x2* rope; const float* qn; const float* kn;
    __device__ __forceinline__ void operator()(f32x4 (&acc)[2][2][4][2], const Unit& u, int wr, int wc, int fr_, int fq_, PG8_LAS unsigned char* xl) const {
        int fr = fr_, fq = fq_; asm volatile("" : "+v"(fr), "+v"(fq));
        const int row0 = u.pm * BM + wr * 64 + fr, col0 = u.pn * BM + wc * 32 + 8 * fq;
        const int kind = u.pn < 16 ? 1 : (u.pn >= 32 && u.pn < 42 ? 2 : 0);
        const int qp = 4 * wc + fq, hf = qp >> 3, fi = 4 * (qp & 7);
        float rsv[8];
        { unsigned long long q[8];
#pragma unroll
            for (int k = 0; k < 8; ++k) q[k] = ssq[row0 + (k >> 2) * HALF + (k & 3) * 16];
            asm volatile("" : "+v"(q[0]), "+v"(q[1]), "+v"(q[2]), "+v"(q[3]), "+v"(q[4]), "+v"(q[5]), "+v"(q[6]), "+v"(q[7]));
#pragma unroll
            for (int k = 0; k < 8; ++k) rsv[k] = __builtin_amdgcn_rsqf((float)q[k] * (1.0f / 1048576.0f / 4096.0f) + EPS); }
#pragma unroll
        for (int ai = 0; ai < 2; ++ai)
#pragma unroll
            for (int m = 0; m < 4; ++m) { const float rs = rsv[ai * 4 + m];
#pragma unroll
                for (int bj = 0; bj < 2; ++bj) { acc[ai][bj][m][0] *= rs; acc[ai][bj][m][1] *= rs; } }
        if (kind == 2) {
            PG8_LAS float* PART = (PG8_LAS float*)xl;
#pragma unroll
            for (int ai = 0; ai < 2; ++ai)
#pragma unroll
                for (int m = 0; m < 4; ++m)
#pragma unroll
                    for (int bj = 0; bj < 2; ++bj) { const f32x4 a = acc[ai][bj][m][0], b = acc[ai][bj][m][1];
                        float s = ((a[0] * a[0] + a[1] * a[1]) + (a[2] * a[2] + a[3] * a[3])) + ((b[0] * b[0] + b[1] * b[1]) + (b[2] * b[2] + b[3] * b[3]));
                        s += __shfl_xor(s, 16); s += __shfl_xor(s, 32);
                        if (fq == 0) PART[((ai * HALF + wr * 64 + m * 16 + fr) * 2 + bj) * 4 + wc] = s; }
            asm volatile("s_waitcnt lgkmcnt(0)" ::: "memory"); __builtin_amdgcn_s_barrier(); asm volatile("" ::: "memory");
            const float* gn = (u.pn < 40) ? qn : kn;
            const f32x4 g0 = *(const f32x4*)(gn + 64 * hf + fi), g1 = *(const f32x4*)(gn + 64 * hf + fi + 32);
#pragma unroll
            for (int ai = 0; ai < 2; ++ai)
#pragma unroll
                for (int m = 0; m < 4; ++m)
#pragma unroll
                    for (int bj = 0; bj < 2; ++bj) { const f32x4 ps = *(const PG8_LAS f32x4*)(PART + ((ai * HALF + wr * 64 + m * 16 + fr) * 2 + bj) * 4);
                        const float rh = __builtin_amdgcn_rsqf(((ps[0] + ps[1]) + (ps[2] + ps[3])) * (1.0f / 128.0f) + EPS);
                        acc[ai][bj][m][0] *= g0 * rh; acc[ai][bj][m][1] *= g1 * rh; }
        }
        f32x4 csa[8][2];
        if (kind != 0) {
#pragma unroll
            for (int k = 0; k < 8; ++k) { const int row = row0 + (k >> 2) * HALF + (k & 3) * 16; const int t = row < 8192 ? (row & 2047) : (row - 8192); const int pos = hf ? (t & 63) : (t >> 6);
                const f32x4* rp = (const f32x4*)(rope + pos * 32 + fi); csa[k][0] = rp[0]; csa[k][1] = rp[1]; }
            asm volatile("" : "+v"(csa[0][0]), "+v"(csa[0][1]), "+v"(csa[1][0]), "+v"(csa[1][1]), "+v"(csa[2][0]), "+v"(csa[2][1]), "+v"(csa[3][0]), "+v"(csa[3][1]));
            asm volatile("" : "+v"(csa[4][0]), "+v"(csa[4][1]), "+v"(csa[5][0]), "+v"(csa[5][1]), "+v"(csa[6][0]), "+v"(csa[6][1]), "+v"(csa[7][0]), "+v"(csa[7][1]));
        }
#pragma unroll
        for (int ai = 0; ai < 2; ++ai)
#pragma unroll
            for (int m = 0; m < 4; ++m) { const int row = row0 + ai * HALF + m * 16;
                bf16_t* rowp = O + (size_t)row * NIN + col0;
                f32x4 cs0 = {1.f, 0.f, 1.f, 0.f}, cs1 = cs0;
                if (kind != 0) { cs0 = csa[ai * 4 + m][0]; cs1 = csa[ai * 4 + m][1]; }
#pragma unroll
                for (int bj = 0; bj < 2; ++bj) { f32x4 v0 = acc[ai][bj][m][0], v1 = acc[ai][bj][m][1];
                    if (kind != 0) { const f32x4 c = {cs0[0], cs0[2], cs1[0], cs1[2]}, s = {cs0[1], cs0[3], cs1[1], cs1[3]};
                        const f32x4 y0 = v0 * c - v1 * s, y1 = v1 * c + v0 * s; v0 = y0; v1 = y1; }
                    u32x4 w; w.x = cvt_pk_bf16(v0[0], v0[1]); w.y = cvt_pk_bf16(v0[2], v0[3]); w.z = cvt_pk_bf16(v1[0], v1[1]); w.w = cvt_pk_bf16(v1[2], v1[3]);
                    __builtin_nontemporal_store(w, (u32x4*)(rowp + bj * HALF)); } }
    }
};
struct EpiRes {
    static constexpr bool PERM = true, AFTER_DRAIN = false;
    bf16_t* xb; unsigned long long* ssq_out;
    __device__ __forceinline__ void operator()(f32x4 (&acc)[2][2][4][2], const Unit& u, int wr, int wc, int fr_, int fq_, PG8_LAS unsigned char*) const {
        int fr = fr_, fq = fq_; asm volatile("" : "+v"(fr), "+v"(fq));
        const int row0 = u.pm * BM + wr * 64 + fr, col0 = u.pn * BM + wc * 32 + 8 * fq;
        u32x4 xv[2][4][2];
#pragma unroll
        for (int ai = 0; ai < 2; ++ai)
#pragma unroll
            for (int m = 0; m < 4; ++m)
#pragma unroll
                for (int bj = 0; bj < 2; ++bj) xv[ai][m][bj] = *(const u32x4*)(xb + (size_t)(row0 + ai * HALF + m * 16) * DM + col0 + bj * HALF);
        asm volatile("" : "+v"(xv[0][0][0]), "+v"(xv[0][0][1]), "+v"(xv[0][1][0]), "+v"(xv[0][1][1]), "+v"(xv[0][2][0]), "+v"(xv[0][2][1]), "+v"(xv[0][3][0]), "+v"(xv[0][3][1]));
        asm volatile("" : "+v"(xv[1][0][0]), "+v"(xv[1][0][1]), "+v"(xv[1][1][0]), "+v"(xv[1][1][1]), "+v"(xv[1][2][0]), "+v"(xv[1][2][1]), "+v"(xv[1][3][0]), "+v"(xv[1][3][1]));
#pragma unroll
        for (int ai = 0; ai < 2; ++ai) {
#pragma unroll
            for (int m = 0; m < 4; ++m) { const int row = row0 + ai * HALF + m * 16; bf16_t* rowp = xb + (size_t)row * DM + col0; float s = 0.f;
#pragma unroll
                for (int bj = 0; bj < 2; ++bj) { const u32x4 x = xv[ai][m][bj];
                    const f32x4 v0 = (f32x4){bf_lo(x.x), bf_hi(x.x), bf_lo(x.y), bf_hi(x.y)} + acc[ai][bj][m][0], v1 = (f32x4){bf_lo(x.z), bf_hi(x.z), bf_lo(x.w), bf_hi(x.w)} + acc[ai][bj][m][1];
                    u32x4 w; w.x = cvt_pk_bf16(v0[0], v0[1]); w.y = cvt_pk_bf16(v0[2], v0[3]); w.z = cvt_pk_bf16(v1[0], v1[1]); w.w = cvt_pk_bf16(v1[2], v1[3]);
                    *(u32x4*)(rowp + bj * HALF) = w;
                    s += ((v0[0] * v0[0] + v0[1] * v0[1]) + (v0[2] * v0[2] + v0[3] * v0[3])) + ((v1[0] * v1[0] + v1[1] * v1[1]) + (v1[2] * v1[2] + v1[3] * v1[3])); }
                s += __shfl_xor(s, 16); s += __shfl_xor(s, 32);
                if (fq == 0) __hip_atomic_fetch_add(ssq_out + row, (unsigned long long)(s * 1048576.0f + 0.5f), __ATOMIC_RELAXED, __HIP_MEMORY_SCOPE_AGENT); }
            asm volatile("" ::: "memory");
        }
    }
};
struct EpiResFinal {
    static constexpr bool PERM = true, AFTER_DRAIN = false;
    const bf16_t* xb; unsigned long long* ssq; unsigned* cnt; const float* gain; float* out;
    __device__ __forceinline__ void operator()(f32x4 (&acc)[2][2][4][2], const Unit& u, int wr, int wc, int fr_, int fq_, PG8_LAS unsigned char* xl) const {
        int fr = fr_, fq = fq_; asm volatile("" : "+v"(fr), "+v"(fq));
        const int row0 = u.pm * BM + wr * 64 + fr, col0 = u.pn * BM + wc * 32 + 8 * fq;
#pragma unroll
        for (int ai = 0; ai < 2; ++ai) {
            u32x4 xv[4][2];
#pragma unroll
            for (int m = 0; m < 4; ++m)
#pragma unroll
                for (int bj = 0; bj < 2; ++bj) xv[m][bj] = *(const u32x4*)(xb + (size_t)(row0 + ai * HALF + m * 16) * DM + col0 + bj * HALF);
#pragma unroll
            for (int m = 0; m < 4; ++m) { const int row = row0 + ai * HALF + m * 16; float s = 0.f;
#pragma unroll
                for (int bj = 0; bj < 2; ++bj) { const u32x4 x = xv[m][bj];
                    const f32x4 v0 = (f32x4){bf_lo(x.x), bf_hi(x.x), bf_lo(x.y), bf_hi(x.y)} + acc[ai][bj][m][0], v1 = (f32x4){bf_lo(x.z), bf_hi(x.z), bf_lo(x.w), bf_hi(x.w)} + acc[ai][bj][m][1];
                    acc[ai][bj][m][0] = v0; acc[ai][bj][m][1] = v1;
                    s += ((v0[0] * v0[0] + v0[1] * v0[1]) + (v0[2] * v0[2] + v0[3] * v0[3])) + ((v1[0] * v1[0] + v1[1] * v1[1]) + (v1[2] * v1[2] + v1[3] * v1[3])); }
                s += __shfl_xor(s, 16); s += __shfl_xor(s, 32);
                if (fq == 0) __hip_atomic_fetch_add(ssq + row, (unsigned long long)(s * 1048576.0f + 0.5f), __ATOMIC_RELAXED, __HIP_MEMORY_SCOPE_AGENT); }
            asm volatile("" ::: "memory");
        }
        f32x4 g[2][2];
#pragma unroll
        for (int bj = 0; bj < 2; ++bj) { g[bj][0] = *(const f32x4*)(gain + col0 + bj * HALF); g[bj][1] = *(const f32x4*)(gain + col0 + bj * HALF + 4); }
        asm volatile("s_waitcnt vmcnt(0)" ::: "memory"); __builtin_amdgcn_s_barrier(); asm volatile("" ::: "memory");
        PG8_LAS float* RS = (PG8_LAS float*)xl;
        if (wr == 0 && wc == 0) {
            unsigned* c = cnt + u.pm * 16;
            if (fq == 0 && fr == 0) __hip_atomic_fetch_add(c, 1u, __ATOMIC_RELAXED, __HIP_MEMORY_SCOPE_AGENT);
            unsigned sp = 0;
            while ((unsigned)__builtin_amdgcn_readfirstlane(__hip_atomic_load(c, __ATOMIC_RELAXED, __HIP_MEMORY_SCOPE_AGENT)) < 16u) { __builtin_amdgcn_s_sleep(2); if (++sp > (1u << 20)) break; }
            __builtin_amdgcn_fence(__ATOMIC_ACQUIRE, "agent");
            const unsigned long long* p = ssq + u.pm * BM + (fq * 16 + fr); unsigned long long s0, s1, s2, s3;
            asm volatile("global_load_dwordx2 %0, %4, off sc1\n\tglobal_load_dwordx2 %1, %4, off offset:512 sc1\n\tglobal_load_dwordx2 %2, %4, off offset:1024 sc1\n\tglobal_load_dwordx2 %3, %4, off offset:1536 sc1\n\ts_waitcnt vmcnt(0)"
                         : "=&v"(s0), "=&v"(s1), "=&v"(s2), "=&v"(s3) : "v"(p) : "memory");
            const int l64 = fq * 16 + fr;
            RS[l64] = __builtin_amdgcn_rsqf((float)s0 * (1.0f / 1048576.0f / 4096.0f) + EPS); RS[64 + l64] = __builtin_amdgcn_rsqf((float)s1 * (1.0f / 1048576.0f / 4096.0f) + EPS);
            RS[128 + l64] = __builtin_amdgcn_rsqf((float)s2 * (1.0f / 1048576.0f / 4096.0f) + EPS); RS[192 + l64] = __builtin_amdgcn_rsqf((float)s3 * (1.0f / 1048576.0f / 4096.0f) + EPS);
        }
        __syncthreads();
#pragma unroll
        for (int ai = 0; ai < 2; ++ai)
#pragma unroll
            for (int m = 0; m < 4; ++m) { const int rt = wr * 64 + fr + ai * HALF + m * 16; const float rs = RS[rt]; float* rowp = out + (size_t)(u.pm * BM + rt) * DM + col0;
#pragma unroll
                for (int bj = 0; bj < 2; ++bj) { __builtin_nontemporal_store(acc[ai][bj][m][0] * rs * g[bj][0], (f32x4*)(rowp + bj * HALF)); __builtin_nontemporal_store(acc[ai][bj][m][1] * rs * g[bj][1], (f32x4*)(rowp + bj * HALF + 4)); } }
    }
};
struct EpiConv {
    static constexpr bool PERM = true, AFTER_DRAIN = false;
    unsigned char* ws; size_t gh_off, hb_off, ssq_off; const float* cw; const float* cb; unsigned long long* scr; unsigned* flag; int slot;
    __device__ __forceinline__ void operator()(f32x4 (&acc)[2][2][4][2], const Unit& u, int wr, int wc, int fr_, int fq_, PG8_LAS unsigned char* xl) const {
        int fr = fr_, fq = fq_; asm volatile("" : "+v"(fr), "+v"(fq));
        PG8_LAS float* BND = (PG8_LAS float*)xl;
        bf16_t* GH = (bf16_t*)(ws + gh_off); float* HB = (float*)(ws + hb_off); const unsigned long long* ssq = (const unsigned long long*)(ws + ssq_off);
        const int colw = wc * 32 + 8 * fq;
        SPLITK_HANDOFF()
        PG8_LAS float* CW = (PG8_LAS float*)(xl + 8192);
        const int cwi = (((wr * 4 + wc) * 4 + fq) * 16 + fr) * 2, cwa = cwi >> 8, cwh = (cwi >> 7) & 1, cwc = cwi & 127;
        const f32x2 cwreg = *(const f32x2*)((cwa < 3 ? cw + cwa * NUP : cb) + cwh * DFF + u.pn * 128 + cwc);
        float rsv[8];
        { unsigned long long q[8]; const int row0 = u.pm * BM + wr * 64 + fr;
#pragma unroll
            for (int k = 0; k < 8; ++k) q[k] = ssq[row0 + (k >> 2) * HALF + (k & 3) * 16];
            asm volatile("" : "+v"(q[0]), "+v"(q[1]), "+v"(q[2]), "+v"(q[3]), "+v"(q[4]), "+v"(q[5]), "+v"(q[6]), "+v"(q[7]));
#pragma unroll
            for (int k = 0; k < 8; ++k) rsv[k] = __builtin_amdgcn_rsqf((float)q[k] * (1.0f / 1048576.0f / 4096.0f) + EPS); }
#pragma unroll
        for (int ai = 0; ai < 2; ++ai)
#pragma unroll
            for (int m = 0; m < 4; ++m) { const float rs = rsv[ai * 4 + m];
#pragma unroll
                for (int bj = 0; bj < 2; ++bj)
#pragma unroll
                    for (int n = 0; n < 2; ++n) acc[ai][bj][m][n] *= rs;
                asm volatile("" : "+v"(acc[ai][0][m][0]), "+v"(acc[ai][0][m][1]), "+v"(acc[ai][1][m][0]), "+v"(acc[ai][1][m][1])); }
#pragma unroll
        for (int ai = 0; ai < 2; ++ai)
#pragma unroll
            for (int bj = 0; bj < 2; ++bj)
#pragma unroll
                for (int n = 0; n < 2; ++n) {
                    if (fr == 0)  *(PG8_LAS f32x4*)(BND + ((((ai * 2 + wr) * 2 + 0) * 2 + bj) * 128) + colw + 4 * n) = acc[ai][bj][0][n];
                    if (fr == 15) *(PG8_LAS f32x4*)(BND + ((((ai * 2 + wr) * 2 + 1) * 2 + bj) * 128) + colw + 4 * n) = acc[ai][bj][3][n];
                }
        if (wr == 0 && fr < 2) {
#pragma unroll
            for (int bj = 0; bj < 2; ++bj)
#pragma unroll
                for (int n = 0; n < 2; ++n) *(f32x4*)(HB + (size_t)(u.pm * 4 + fr) * NUP + bj * DFF + u.pn * 128 + colw + 4 * n) = acc[0][bj][0][n];
        }
        if (wr == 1 && fr >= 14) {
#pragma unroll
            for (int bj = 0; bj < 2; ++bj)
#pragma unroll
                for (int n = 0; n < 2; ++n) *(f32x4*)(HB + (size_t)(u.pm * 4 + 2 + (fr - 14)) * NUP + bj * DFF + u.pn * 128 + colw + 4 * n) = acc[1][bj][3][n];
        }
        *(PG8_LAS f32x2*)(CW + cwi) = cwreg;
        asm volatile("s_waitcnt lgkmcnt(0)" ::: "memory"); __builtin_amdgcn_s_barrier(); asm volatile("" ::: "memory");
#define DPPF(oldv, srcv, ctrl) __builtin_bit_cast(float, __builtin_amdgcn_update_dpp(__builtin_bit_cast(int, (float)(oldv)), __builtin_bit_cast(int, (float)(srcv)), (ctrl), 0xf, 0xf, false))
#pragma unroll
        for (int bj = 0; bj < 2; ++bj)
#pragma unroll
            for (int n = 0; n < 2; ++n) {
                const f32x4 w0 = *(const PG8_LAS f32x4*)(CW + (0 * 2 + bj) * 128 + colw + 4 * n), w1 = *(const PG8_LAS f32x4*)(CW + (1 * 2 + bj) * 128 + colw + 4 * n), w2 = *(const PG8_LAS f32x4*)(CW + (2 * 2 + bj) * 128 + colw + 4 * n), bb = *(const PG8_LAS f32x4*)(CW + (3 * 2 + bj) * 128 + colw + 4 * n);
#pragma unroll
                for (int ai = 0; ai < 2; ++ai) {
                    f32x4 pv = {0.f, 0.f, 0.f, 0.f}, nv = pv;
                    if (wr == 1) pv = *(PG8_LAS f32x4*)(BND + ((((ai * 2 + 0) * 2 + 1) * 2 + bj) * 128) + colw + 4 * n);
                    else if (ai == 1) pv = *(PG8_LAS f32x4*)(BND + ((((0 * 2 + 1) * 2 + 1) * 2 + bj) * 128) + colw + 4 * n);
                    if (wr == 0) nv = *(PG8_LAS f32x4*)(BND + ((((ai * 2 + 1) * 2 + 0) * 2 + bj) * 128) + colw + 4 * n);
                    else if (ai == 0) nv = *(PG8_LAS f32x4*)(BND + ((((1 * 2 + 0) * 2 + 0) * 2 + bj) * 128) + colw + 4 * n);
#pragma unroll
                    for (int j = 0; j < 4; ++j) {
                        const float c0 = acc[ai][bj][0][n][j], c1 = acc[ai][bj][1][n][j], c2 = acc[ai][bj][2][n][j], c3 = acc[ai][bj][3][n][j];
                        const float u0 = DPPF(pv[j], c0, 0x111), u1 = DPPF(DPPF(0.f, c0, 0x121), c1, 0x111), u2 = DPPF(DPPF(0.f, c1, 0x121), c2, 0x111), u3 = DPPF(DPPF(0.f, c2, 0x121), c3, 0x111);
                        const float d0 = DPPF(DPPF(0.f, c1, 0x12f), c0, 0x101), d1 = DPPF(DPPF(0.f, c2, 0x12f), c1, 0x101), d2 = DPPF(DPPF(0.f, c3, 0x12f), c2, 0x101), d3 = DPPF(nv[j], c3, 0x101);
                        acc[ai][bj][0][n][j] = w0[j] * u0 + w1[j] * c0 + w2[j] * d0 + bb[j];
                        acc[ai][bj][1][n][j] = w0[j] * u1 + w1[j] * c1 + w2[j] * d1 + bb[j];
                        acc[ai][bj][2][n][j] = w0[j] * u2 + w1[j] * c2 + w2[j] * d2 + bb[j];
                        acc[ai][bj][3][n][j] = w0[j] * u3 + w1[j] * c3 + w2[j] * d3 + bb[j];
                    }
                    asm volatile("" : "+v"(acc[ai][bj][0][n]), "+v"(acc[ai][bj][1][n]), "+v"(acc[ai][bj][2][n]), "+v"(acc[ai][bj][3][n]));
                }
            }
#undef DPPF
#pragma unroll
        for (int ai = 0; ai < 2; ++ai)
#pragma unroll
            for (int m = 0; m < 4; ++m) {
                const int row = u.pm * BM + ai * HALF + wr * 64 + m * 16 + fr;
                const f32x4 a0 = acc[ai][0][m][0], a1 = acc[ai][0][m][1], u0 = acc[ai][1][m][0], u1 = acc[ai][1][m][1];
                const f32x2 g0 = gelu_pk((f32x2){a0[0], a0[1]}), g1 = gelu_pk((f32x2){a0[2], a0[3]}), g2 = gelu_pk((f32x2){a1[0], a1[1]}), g3 = gelu_pk((f32x2){a1[2], a1[3]});
                u32x4 w; w.x = cvt_pk_bf16(g0.x * u0[0], g0.y * u0[1]); w.y = cvt_pk_bf16(g1.x * u0[2], g1.y * u0[3]); w.z = cvt_pk_bf16(g2.x * u1[0], g2.y * u1[1]); w.w = cvt_pk_bf16(g3.x * u1[2], g3.y * u1[3]);
                __builtin_nontemporal_store(w, (u32x4*)(GH + (size_t)row * DFF + u.pn * 128 + colw));
            }
    }
};
template <class Epi, class Sched, bool ALIGN_EPI = false, bool SP2 = false, int BAUX = 0  >
__device__ __forceinline__ void gemm_phase(PG8_LAS unsigned char* lds, PG8_LAS unsigned char* xlds, const Gemm g, const Sched& S, const Epi& E) {
    int tid_ = threadIdx.x; asm volatile("" : "+v"(tid_)); const int tid = tid_, wid = __builtin_amdgcn_readfirstlane(tid >> 6), lane = tid & 63, wr = wid >> 2, wc = wid & 3, fr = lane & 15, fq = lane >> 4;
    const int K = g.K, nt = K / BK;
    unsigned voffA[2], voffB[2];
#pragma unroll
    for (int i = 0; i < 2; ++i) { int R, C; stage_rc(tid * 16 + i * 8192, R, C); const int Rb = Epi::PERM ? ((R & ~31) + perm32(R & 31)) : R;
        voffA[i] = (unsigned)(R * K + C) * 2u; voffB[i] = (unsigned)(Rb * K + C) * 2u; }
    const size_t kstep = (size_t)(BK * 2);
    const size_t hstep = (size_t)HALF * K * 2;
    const size_t tstep = 2 * hstep;
    const unsigned ldsw = (unsigned)wid * 1024u;
    const int aoff = lds_byte(wr * 64 + fr, fq * 8), boff = lds_byte(wc * 32 + fr, fq * 8);
#define PG8_SA(b, h) (((b) * 2 + (h)) * HTB)
#define PG8_SB(b, h) ((4 + (b) * 2 + (h)) * HTB)
#define PG8_STAGE(bufoff, gbase, voff) do { _Pragma("unroll") for (int _i = 0; _i < 2; ++_i) \
        __builtin_amdgcn_global_load_lds((const unsigned*)((const char*)(gbase) + (voff)[_i]), (PG8_LAS unsigned*)(lds + (bufoff) + ldsw + _i * 8192), 16, 0, 0); } while (0)
#define PG8_STAGEB(bufoff, gbase, voff) do { _Pragma("unroll") for (int _i = 0; _i < 2; ++_i) \
        __builtin_amdgcn_global_load_lds((const unsigned*)((const char*)(gbase) + (voff)[_i]), (PG8_LAS unsigned*)(lds + (bufoff) + ldsw + _i * 8192), 16, 0, BAUX); } while (0)
#define PG8_LDA(dst, b, h) do { _Pragma("unroll") for (int m = 0; m < 4; ++m) _Pragma("unroll") for (int k = 0; k < 2; ++k) dst[m][k] = *(const PG8_LAS bf16x8*)(lds + PG8_SA(b, h) + aoff + m * 2048 + k * 1024); } while (0)
#define PG8_LDB(dst, b, h) do { _Pragma("unroll") for (int n = 0; n < 2; ++n) _Pragma("unroll") for (int k = 0; k < 2; ++k) dst[n][k] = *(const PG8_LAS bf16x8*)(lds + PG8_SB(b, h) + boff + n * 2048 + k * 1024); } while (0)
#define PG8_MMA(ai, bj, At, Bt) do { __builtin_amdgcn_s_setprio(1); _Pragma("unroll") for (int m = 0; m < 4; ++m) _Pragma("unroll") for (int n = 0; n < 2; ++n) _Pragma("unroll") for (int k = 0; k < 2; ++k) \
        acc[ai][bj][m][n] = __builtin_amdgcn_mfma_f32_16x16x32_bf16(Bt[n][k], At[m][k], acc[ai][bj][m][n], 0, 0, 0); __builtin_amdgcn_s_setprio(0); } while (0)
#define PG8_WAIT_V(n) asm volatile("s_waitcnt vmcnt(" #n ")" ::: "memory")
#define PG8_WAIT_L(n) asm volatile("s_waitcnt lgkmcnt(" #n ")" ::: "memory")
#define PG8_BAR __builtin_amdgcn_s_barrier()
#define PG8_SCHED __builtin_amdgcn_sched_barrier(0)
    Unit cur, nxt; int ui = 0;
    if (!S.next(0, cur)) return;
    f32x4 acc[2][2][4][2];
#pragma unroll
    for (int a = 0; a < 2; ++a)
#pragma unroll
        for (int b = 0; b < 2; ++b)
#pragma unroll
            for (int m = 0; m < 4; ++m)
#pragma unroll
                for (int n = 0; n < 2; ++n) acc[a][b][m][n] = (f32x4){0.f, 0.f, 0.f, 0.f};
    bf16x8 At[4][2], B0[2][2], B1[2][2];
    const char* cA = (const char*)g.A + (size_t)cur.pm * tstep + (size_t)cur.kt0 * kstep; const char* cB = (const char*)g.Bt + (size_t)cur.pn * tstep + (size_t)cur.kt0 * kstep;
    S.a_ready(cur);
    if constexpr (SP2) {
        PG8_STAGEB(PG8_SB(0, 0), cB, voffB); PG8_STAGEB(PG8_SB(0, 1), cB + hstep, voffB); PG8_STAGE(PG8_SA(0, 0), cA, voffA); PG8_STAGE(PG8_SA(0, 1), cA + hstep, voffA);
        if (wr == 1) PG8_BAR;
        PG8_WAIT_V(2); PG8_BAR;
        PG8_STAGEB(PG8_SB(1, 0), cB + kstep, voffB); PG8_STAGE(PG8_SA(1, 0), cA + kstep, voffA); PG8_STAGEB(PG8_SB(1, 1), cB + hstep + kstep, voffB);
        PG8_WAIT_V(6); PG8_BAR;
    } else {
        PG8_STAGEB(PG8_SB(0, 0), cB, voffB); PG8_STAGE(PG8_SA(0, 0), cA, voffA); PG8_STAGEB(PG8_SB(0, 1), cB + hstep, voffB); PG8_STAGE(PG8_SA(0, 1), cA + hstep, voffA);
        if (wr == 1) PG8_BAR;
        PG8_WAIT_V(4); PG8_BAR;
        PG8_STAGEB(PG8_SB(1, 0), cB + kstep, voffB); PG8_STAGE(PG8_SA(1, 0), cA + kstep, voffA); PG8_STAGEB(PG8_SB(1, 1), cB + hstep + kstep, voffB);
        PG8_WAIT_V(6); PG8_BAR;
    }
    for (;;) {
        const bool has_next = S.next(ui + 1, nxt);
        const char* nA = has_next ? (const char*)g.A + (size_t)nxt.pm * tstep + (size_t)nxt.kt0 * kstep : cA; const char* nB = has_next ? (const char*)g.Bt + (size_t)nxt.pn * tstep + (size_t)nxt.kt0 * kstep : cB;
        const int ntu = cur.nkt ? cur.nkt : nt;
        for (int t = 0; t < ntu; t += 2) {
            const bool last = (t == ntu - 2);
            const char* a1 = cA + (size_t)(t + 1) * kstep;
            const char* a2 = last ? nA : cA + (size_t)(t + 2) * kstep; const char* b2 = last ? nB : cB + (size_t)(t + 2) * kstep;
            const char* a3 = a2 + kstep; const char* b3 = b2 + kstep;
            if (last && has_next) S.a_ready(nxt);
            if constexpr (SP2) {
            PG8_LDB(B0, 0, 0); PG8_LDB(B1, 0, 1); PG8_SCHED; PG8_LDA(At, 0, 0); PG8_STAGE(PG8_SA(1, 1), a1 + hstep, voffA);
            PG8_WAIT_V(8); PG8_WAIT_L(0); PG8_BAR; PG8_MMA(0, 0, At, B0); PG8_MMA(0, 1, At, B1); PG8_BAR; PG8_SCHED;
            PG8_LDA(At, 0, 1); PG8_STAGEB(PG8_SB(0, 0), b2, voffB); PG8_STAGEB(PG8_SB(0, 1), b2 + hstep, voffB); PG8_STAGE(PG8_SA(0, 0), a2, voffA);
            PG8_WAIT_V(8); PG8_WAIT_L(0); PG8_BAR; PG8_MMA(1, 0, At, B0); PG8_MMA(1, 1, At, B1); PG8_BAR; PG8_SCHED;
            PG8_LDB(B0, 1, 0); PG8_LDB(B1, 1, 1); PG8_SCHED; PG8_LDA(At, 1, 0); PG8_STAGE(PG8_SA(0, 1), a2 + hstep, voffA);
            PG8_WAIT_V(8); PG8_WAIT_L(0); PG8_BAR; PG8_MMA(0, 0, At, B0); PG8_MMA(0, 1, At, B1); PG8_BAR; PG8_SCHED;
            PG8_LDA(At, 1, 1); PG8_STAGEB(PG8_SB(1, 0), b3, voffB); PG8_STAGEB(PG8_SB(1, 1), b3 + hstep, voffB); PG8_STAGE(PG8_SA(1, 0), a3, voffA);
            PG8_WAIT_V(8); PG8_WAIT_L(0); PG8_BAR; PG8_MMA(1, 0, At, B0); PG8_MMA(1, 1, At, B1); PG8_BAR; PG8_SCHED;
            } else {
            PG8_LDB(B0, 0, 0); PG8_SCHED; PG8_LDA(At, 0, 0); PG8_STAGE(PG8_SA(1, 1), a1 + hstep, voffA);
            PG8_WAIT_L(8); PG8_BAR; PG8_WAIT_L(0); PG8_MMA(0, 0, At, B0); PG8_BAR; PG8_SCHED;
            PG8_LDB(B1, 0, 1); PG8_STAGEB(PG8_SB(0, 0), b2, voffB);
            PG8_BAR; PG8_WAIT_L(0); PG8_MMA(0, 1, At, B1); PG8_BAR;
            PG8_LDA(At, 0, 1); PG8_STAGE(PG8_SA(0, 0), a2, voffA);
            PG8_BAR; PG8_WAIT_L(0); PG8_MMA(1, 0, At, B0); PG8_BAR; PG8_SCHED;
            PG8_STAGEB(PG8_SB(0, 1), b2 + hstep, voffB);
            PG8_WAIT_V(6); PG8_BAR; PG8_MMA(1, 1, At, B1); PG8_BAR;
            PG8_LDB(B0, 1, 0); PG8_SCHED; PG8_LDA(At, 1, 0); PG8_STAGE(PG8_SA(0, 1), a2 + hstep, voffA);
            PG8_WAIT_L(8); PG8_BAR; PG8_WAIT_L(0); PG8_MMA(0, 0, At, B0); PG8_BAR; PG8_SCHED;
            PG8_LDB(B1, 1, 1); PG8_STAGEB(PG8_SB(1, 0), b3, voffB);
            PG8_BAR; PG8_WAIT_L(0); PG8_MMA(0, 1, At, B1); PG8_BAR;
            PG8_LDA(At, 1, 1); PG8_STAGE(PG8_SA(1, 0), a3, voffA);
            PG8_BAR; PG8_WAIT_L(0); PG8_MMA(1, 0, At, B0); PG8_BAR; PG8_SCHED;
            PG8_STAGEB(PG8_SB(1, 1), b3 + hstep, voffB);
            PG8_WAIT_V(6); PG8_BAR; PG8_MMA(1, 1, At, B1); PG8_BAR;
            }
        }
        if constexpr (ALIGN_EPI) { if (wr == 0) PG8_BAR; }
#if PT_EPI
        { const unsigned long long t0_ = wall_clock64(); E(acc, cur, wr, wc, fr, fq, xlds); const unsigned long long t1_ = wall_clock64();
          if (tid == 0) *(PG8_LAS unsigned long long*)(lds + 143360 + 64) += t1_ - t0_; } S.done(cur);
#else
        E(acc, cur, wr, wc, fr, fq, xlds); S.done(cur);
#endif
        if (!has_next) break;
#pragma unroll
        for (int a = 0; a < 2; ++a)
#pragma unroll
            for (int b = 0; b < 2; ++b)
#pragma unroll
                for (int m = 0; m < 4; ++m)
#pragma unroll
                    for (int n = 0; n < 2; ++n) acc[a][b][m][n] = (f32x4){0.f, 0.f, 0.f, 0.f};
        cur = nxt; cA = nA; cB = nB; ++ui;
        if constexpr (ALIGN_EPI) { if (wr == 1) PG8_BAR; }
    }
    PG8_WAIT_V(0);
    if constexpr (!ALIGN_EPI) { if (wr == 0) PG8_BAR; }
    PG8_BAR;
#undef PG8_SA
#undef PG8_SB
#undef PG8_STAGE
#undef PG8_STAGEB
#undef PG8_LDA
#undef PG8_LDB
#undef PG8_MMA
#undef PG8_WAIT_V
#undef PG8_WAIT_L
#undef PG8_BAR
#undef PG8_SCHED
}
}

namespace att {
constexpr int D = 128, NW = 8, QBLK = 32, KVBLK = 64;
constexpr float SCALE = 0.088388347648318440f;
constexpr float THR = 8.f;
constexpr int SHM_V = KVBLK * D * 2, SHM_K = KVBLK * D * 2, SHM_ATTN = 2 * SHM_V + 2 * SHM_K + NW * 64 * 4;
#define KSWZ(row, colB) ((row) * 256 + ((colB) ^ (((row) & 7) << 4)))
#define SBAR() __builtin_amdgcn_sched_barrier(0)
__device__ __forceinline__ int crow(int r, int hi) { return (r & 3) + 8 * (r >> 2) + 4 * hi; }
__device__ __forceinline__ unsigned cvtpk(float lo, float hi) { unsigned r; asm volatile("v_cvt_pk_bf16_f32 %0, %1, %2" : "=v"(r) : "v"(lo), "v"(hi)); return r; }

template <bool FIXM, bool NOEXP = false> __device__ __forceinline__ void partialSM(f32x16& p0, f32x16& p1, float& m_reg, float& mn, float& alpha, float mshC) {
  constexpr float C = SCALE * 1.4426950408889634f;
  if constexpr (FIXM) {
    alpha = 1.f; mn = 0.f; if constexpr (NOEXP) return;
#pragma unroll
    for (int r = 0; r < 16; ++r) p0[r] = __builtin_amdgcn_exp2f(p0[r]);
    return;
  }
  float pmax = p0[0];
#pragma unroll
  for (int r = 1; r < 16; ++r) pmax = fmaxf(pmax, p0[r]);
#pragma unroll
  for (int r = 0; r < 16; ++r) pmax = fmaxf(pmax, p1[r]);
  { auto rr = __builtin_amdgcn_permlane32_swap(__float_as_uint(pmax), __float_as_uint(pmax), false, false);
    pmax = fmaxf(__uint_as_float(rr[0]), __uint_as_float(rr[1])); }
  if (__builtin_expect(__all(pmax - m_reg <= THR / SCALE), 1)) { mn = m_reg; alpha = 1.f; }
  else { mn = fmaxf(m_reg, pmax); alpha = __builtin_amdgcn_exp2f((m_reg - mn) * C); m_reg = mn; }
  float mnC = -mn * C;
#pragma unroll
  for (int r = 0; r < 16; ++r) p0[r] = fmaf(p0[r], C, mnC);
#pragma unroll
  for (int r = 0; r < 16; ++r) p1[r] = fmaf(p1[r], C, mnC);
#pragma unroll
  for (int r = 0; r < 16; ++r) p0[r] = __builtin_amdgcn_exp2f(p0[r]);
}
__device__ __forceinline__ void finishSM(f32x16& p0, f32x16& p1, float alpha, float& l_reg, bf16x8& pa0, bf16x8& pa1, bf16x8& pa2, bf16x8& pa3) {
#pragma unroll
  for (int r = 0; r < 16; ++r) p1[r] = __builtin_amdgcn_exp2f(p1[r]);
  float ps = 0;
#pragma unroll
  for (int r = 0; r < 16; ++r) ps += p0[r];
#pragma unroll
  for (int r = 0; r < 16; ++r) ps += p1[r];
  { auto rr = __builtin_amdgcn_permlane32_swap(__float_as_uint(ps), __float_as_uint(ps), false, false);
    ps = __uint_as_float(rr[0]) + __uint_as_float(rr[1]); }
  l_reg = l_reg * alpha + ps;
#define PK4(P, BASE, OUT) do { unsigned a0 = cvtpk(P[BASE + 0], P[BASE + 1]), a1 = cvtpk(P[BASE + 2], P[BASE + 3]);   \
    unsigned b0 = cvtpk(P[BASE + 4], P[BASE + 5]), b1 = cvtpk(P[BASE + 6], P[BASE + 7]);                              \
    auto r0 = __builtin_amdgcn_permlane32_swap(a0, b0, false, false); auto r1 = __builtin_amdgcn_permlane32_swap(a1, b1, false, false); \
    u32x4 w = {r0[0], r1[0], r0[1], r1[1]}; OUT = *reinterpret_cast<bf16x8*>(&w); } while (0)
  PK4(p0, 0, pa0); PK4(p0, 8, pa1); PK4(p1, 0, pa2); PK4(p1, 8, pa3);
#undef PK4
}
__device__ __forceinline__ void qkt(f32x16& p0, f32x16& p1, const LAS unsigned char* Ks, const bf16x8* qr, int r32, int hi, float init = 0.f) {
#pragma unroll
  for (int r = 0; r < 16; ++r) { p0[r] = init; p1[r] = init; }
#pragma unroll
  for (int d0 = 0; d0 < 8; ++d0) { int cb = (d0 * 16 + hi * 8) * 2;
    bf16x8 b0 = *reinterpret_cast<const LAS bf16x8*>(Ks + KSWZ(r32, cb));
    bf16x8 b1 = *reinterpret_cast<const LAS bf16x8*>(Ks + KSWZ(32 + r32, cb));
    p0 = __builtin_amdgcn_mfma_f32_32x32x16_bf16(b0, qr[d0], p0, 0, 0, 0);
    p1 = __builtin_amdgcn_mfma_f32_32x32x16_bf16(b1, qr[d0], p1, 0, 0, 0); }
}
#define QF_PK4(P, BASE, OUT) do { unsigned a0 = cvtpk(P[BASE + 0], P[BASE + 1]), a1 = cvtpk(P[BASE + 2], P[BASE + 3]);   \
    unsigned b0 = cvtpk(P[BASE + 4], P[BASE + 5]), b1 = cvtpk(P[BASE + 6], P[BASE + 7]);                              \
    auto r0 = __builtin_amdgcn_permlane32_swap(a0, b0, false, false); auto r1 = __builtin_amdgcn_permlane32_swap(a1, b1, false, false); \
    u32x4 w = {r0[0], r1[0], r0[1], r1[1]}; OUT = *reinterpret_cast<bf16x8*>(&w); } while (0)
#define QF_KRD(D0, X0, X1) do { X0 = *reinterpret_cast<const LAS bf16x8*>(Ks + KSWZ(r32, ((D0) * 16 + hi * 8) * 2)); X1 = *reinterpret_cast<const LAS bf16x8*>(Ks + KSWZ(32 + r32, ((D0) * 16 + hi * 8) * 2)); } while (0)
#define QF_STEP(D0, X0, X1) do { SBAR(); q0 = __builtin_amdgcn_mfma_f32_32x32x16_bf16(X0, qr[D0], q0, 0, 0, 0); q1 = __builtin_amdgcn_mfma_f32_32x32x16_bf16(X1, qr[D0], q1, 0, 0, 0); \
    if ((D0) + 2 < 8) QF_KRD((D0) + 2, X0, X1);                                                                                                                       \
    p1[2 * (D0)] = __builtin_amdgcn_exp2f(p1[2 * (D0)]); p1[2 * (D0) + 1] = __builtin_amdgcn_exp2f(p1[2 * (D0) + 1]); psa += p0[2 * (D0)]; psb += p0[2 * (D0) + 1];     \
    if ((D0) >= 1) { psa += p1[2 * (D0) - 2]; psb += p1[2 * (D0) - 1]; }                                                                                              \
    if ((D0) == 0) QF_PK4(p0, 0, pa0); if ((D0) == 1) QF_PK4(p0, 8, pa1); if ((D0) == 5) QF_PK4(p1, 0, pa2); } while (0)
__device__ __forceinline__ void qk_fin(f32x16& q0, f32x16& q1, const LAS unsigned char* Ks, const bf16x8* qr, int r32, int hi,
                                       f32x16& p0, f32x16& p1, float& l_reg, bf16x8& pa0, bf16x8& pa1, bf16x8& pa2, bf16x8& pa3) {
#pragma unroll
  for (int r = 0; r < 16; ++r) { q0[r] = 0.f; q1[r] = 0.f; }
  bf16x8 ka0, ka1, kb0, kb1; float psa = 0.f, psb = 0.f;
  QF_KRD(0, ka0, ka1); QF_KRD(1, kb0, kb1);
  QF_STEP(0, ka0, ka1); QF_STEP(1, kb0, kb1); QF_STEP(2, ka0, ka1); QF_STEP(3, kb0, kb1); QF_STEP(4, ka0, ka1); QF_STEP(5, kb0, kb1); QF_STEP(6, ka0, ka1); QF_STEP(7, kb0, kb1);
  SBAR();
  psa += p1[14]; psb += p1[15]; QF_PK4(p1, 8, pa3);
  float ps = psa + psb;
  { auto rr = __builtin_amdgcn_permlane32_swap(__float_as_uint(ps), __float_as_uint(ps), false, false);
    ps = __uint_as_float(rr[0]) + __uint_as_float(rr[1]); }
  l_reg += ps;
}
#undef QF_PK4
#undef QF_KRD
#undef QF_STEP
__device__ __forceinline__ int v_st(int k, int c) { const int kk = (k & ~0xC) | ((k & 4) << 1) | ((k & 8) >> 1); return ((kk >> 3) * 4 + (c >> 5)) * 512 + ((kk & 7) * 32 + (c & 31)) * 2; }
__device__ __forceinline__ int v_rd_base(int lane) { return ((lane & 3) << 3) | (((lane >> 2) & 3) << 6) | (((lane >> 4) & 1) << 5) | (((lane >> 5) & 1) << 8); }
constexpr int v_rd_off(int d0, int ks, int half) { return d0 * 512 + ks * 4096 + half * 2048; }
template <int OFF> __device__ __forceinline__ s16x4 tr_read(int vb) {
  s16x4 r; asm volatile("ds_read_b64_tr_b16 %0, %1 offset:%2" : "=&v"(r) : "v"(vb), "i"(OFF) : "memory"); return r;
}
template <int D0> __device__ __forceinline__ void pv_one(f32x16& od, int vb, bf16x8 pa0, bf16x8 pa1, bf16x8 pa2, bf16x8 pa3) {
  const s16x4 l0 = tr_read<v_rd_off(D0, 0, 0)>(vb), h0 = tr_read<v_rd_off(D0, 0, 1)>(vb), l1 = tr_read<v_rd_off(D0, 1, 0)>(vb), h1 = tr_read<v_rd_off(D0, 1, 1)>(vb);
  const s16x4 l2 = tr_read<v_rd_off(D0, 2, 0)>(vb), h2 = tr_read<v_rd_off(D0, 2, 1)>(vb), l3 = tr_read<v_rd_off(D0, 3, 0)>(vb), h3 = tr_read<v_rd_off(D0, 3, 1)>(vb);
  asm volatile("s_waitcnt lgkmcnt(0)" ::: "memory"); SBAR();
#define PK(L, H) (bf16x8){L[0], L[1], L[2], L[3], H[0], H[1], H[2], H[3]}
  od = __builtin_amdgcn_mfma_f32_32x32x16_bf16(pa0, PK(l0, h0), od, 0, 0, 0);
  od = __builtin_amdgcn_mfma_f32_32x32x16_bf16(pa1, PK(l1, h1), od, 0, 0, 0);
  od = __builtin_amdgcn_mfma_f32_32x32x16_bf16(pa2, PK(l2, h2), od, 0, 0, 0);
  od = __builtin_amdgcn_mfma_f32_32x32x16_bf16(pa3, PK(l3, h3), od, 0, 0, 0);
#undef PK
}
__device__ __forceinline__ void pv_d0(f32x16* o, int vb, bf16x8 pa0, bf16x8 pa1, bf16x8 pa2, bf16x8 pa3) {
  pv_one<0>(o[0], vb, pa0, pa1, pa2, pa3); pv_one<1>(o[1], vb, pa0, pa1, pa2, pa3); pv_one<2>(o[2], vb, pa0, pa1, pa2, pa3); pv_one<3>(o[3], vb, pa0, pa1, pa2, pa3);
}
template <int OFF> __device__ __forceinline__ s16x4 tr_rd(const LAS unsigned char* vb) { return __builtin_amdgcn_ds_read_tr16_b64_v4i16((LAS s16x4*)(vb + OFF)); }
#define PV_READS(P, D0) P[0] = tr_rd<v_rd_off(D0, 0, 0)>(vb); P[1] = tr_rd<v_rd_off(D0, 0, 1)>(vb); P[2] = tr_rd<v_rd_off(D0, 1, 0)>(vb); P[3] = tr_rd<v_rd_off(D0, 1, 1)>(vb); \
                        P[4] = tr_rd<v_rd_off(D0, 2, 0)>(vb); P[5] = tr_rd<v_rd_off(D0, 2, 1)>(vb); P[6] = tr_rd<v_rd_off(D0, 3, 0)>(vb); P[7] = tr_rd<v_rd_off(D0, 3, 1)>(vb);
#define PV_PK(L, H) (bf16x8){L[0], L[1], L[2], L[3], H[0], H[1], H[2], H[3]}
#define PV_MMA(OD, P) OD = __builtin_amdgcn_mfma_f32_32x32x16_bf16(pa0, PV_PK(P[0], P[1]), OD, 0, 0, 0); OD = __builtin_amdgcn_mfma_f32_32x32x16_bf16(pa1, PV_PK(P[2], P[3]), OD, 0, 0, 0); \
                      OD = __builtin_amdgcn_mfma_f32_32x32x16_bf16(pa2, PV_PK(P[4], P[5]), OD, 0, 0, 0); OD = __builtin_amdgcn_mfma_f32_32x32x16_bf16(pa3, PV_PK(P[6], P[7]), OD, 0, 0, 0);
#define PV_EXP4(B) do { if constexpr (EXPS) { _Pragma("unroll") for (int r = (B); r < (B) + 4; ++r) pn[r] = __builtin_amdgcn_exp2f(pn[r]); } } while (0)
template <bool EXPS> __device__ __forceinline__ void pv_pipe(f32x16* o, const LAS unsigned char* vb, bf16x8 pa0, bf16x8 pa1, bf16x8 pa2, bf16x8 pa3, f32x16& pn) {
  s16x4 A[8], B[8];
  PV_READS(A, 0) PV_READS(B, 1)
  SBAR(); PV_MMA(o[0], A) PV_EXP4(0); SBAR();
  PV_READS(A, 2)
  SBAR(); PV_MMA(o[1], B) PV_EXP4(4); SBAR();
  PV_READS(B, 3)
  SBAR(); PV_MMA(o[2], A) PV_EXP4(8); SBAR();
  PV_MMA(o[3], B) PV_EXP4(12);
}
#undef PV_READS
#undef PV_PK
#undef PV_MMA
#undef PV_EXP4

template <int LDQ, int LDK, int LDO, bool FIXM = false>
__device__ __forceinline__ void attn_dense_body(const bf16_t* __restrict__ Qb, const bf16_t* __restrict__ Kh, const bf16_t* __restrict__ Vh,
                                                bf16_t* __restrict__ Ob, int seq, LAS unsigned char* lds, float mshC = 0.f) {
  int tid_ = threadIdx.x; asm volatile("" : "+v"(tid_)); const int tid = tid_, wid = tid >> 6, lane = tid & 63, r32 = lane & 31, hi = lane >> 5;
  LAS unsigned char* V_lds = lds; LAS unsigned char* K_lds = lds + 2 * SHM_V;
  LAS float* ws = (LAS float*)(lds + 2 * SHM_V + 2 * SHM_K) + wid * 64; LAS float* li_l = ws; LAS float* al_l = ws + 32;
  float m_reg = -1e30f, l_reg = 0; f32x16 o[4] = {}; bf16x8 qr[8];
  const bf16_t* Qw = Qb + (long)(wid * QBLK + r32) * LDQ + hi * 8;
#pragma unroll
  for (int d0 = 0; d0 < 8; ++d0) { qr[d0] = *reinterpret_cast<const bf16x8*>(Qw + d0 * 16);
    if constexpr (FIXM) { constexpr float C = SCALE * 1.4426950408889634f; const u32x4 q = __builtin_bit_cast(u32x4, qr[d0]); u32x4 s;
      s.x = cvt_pk_bf16(bf_lo(q.x) * C, bf_hi(q.x) * C); s.y = cvt_pk_bf16(bf_lo(q.y) * C, bf_hi(q.y) * C); s.z = cvt_pk_bf16(bf_lo(q.z) * C, bf_hi(q.z) * C); s.w = cvt_pk_bf16(bf_lo(q.w) * C, bf_hi(q.w) * C);
      qr[d0] = __builtin_bit_cast(bf16x8, s); } }
  const int sr = tid >> 4, sc = (tid & 15) * 8, vst0 = v_st(sr, sc), vst1 = v_st(32 + sr, sc), kc = sc * 2;
  const LAS unsigned char* vbp = V_lds + v_rd_base(lane); const int vb0 = (int)(uintptr_t)V_lds + v_rd_base(lane);
  bf16x8 kr0, kr1, vr0, vr1;
#define KLOAD(k0) do { kr0 = *reinterpret_cast<const bf16x8*>(&Kh[(long)((k0) + sr) * LDK + sc]); kr1 = *reinterpret_cast<const bf16x8*>(&Kh[(long)((k0) + 32 + sr) * LDK + sc]); } while (0)
#define VLOAD(k0) do { vr0 = *reinterpret_cast<const bf16x8*>(&Vh[(long)((k0) + sr) * LDK + sc]); vr1 = *reinterpret_cast<const bf16x8*>(&Vh[(long)((k0) + 32 + sr) * LDK + sc]); } while (0)
#define KWRITE(b) do { *(LAS bf16x8*)(K_lds + (b) * SHM_K + KSWZ(sr, kc)) = kr0; *(LAS bf16x8*)(K_lds + (b) * SHM_K + KSWZ(32 + sr, kc)) = kr1; } while (0)
#define VWRITE(b) do { *(LAS bf16x8*)(V_lds + (b) * SHM_V + vst0) = vr0; *(LAS bf16x8*)(V_lds + (b) * SHM_V + vst1) = vr1; } while (0)
#define RESC(a) do { if constexpr (!FIXM) if (__any((a) < 1.f)) { if (hi == 0) al_l[r32] = (a); asm volatile("s_waitcnt lgkmcnt(0)" ::: "memory"); \
    _Pragma("unroll") for (int d = 0; d < 4; ++d) _Pragma("unroll") for (int r = 0; r < 16; ++r) o[d][r] *= al_l[crow(r, hi)]; } } while (0)
  f32x16 pA0, pA1, pB0, pB1; float mnA, mnB, alA, alB; bf16x8 pa0, pa1, pa2, pa3; const int NT = seq / KVBLK;
  KLOAD(0); VLOAD(0); KWRITE(0); VWRITE(0); KLOAD(KVBLK); VLOAD(KVBLK); __syncthreads();
  qkt(pA0, pA1, K_lds, qr, r32, hi); partialSM<FIXM>(pA0, pA1, m_reg, mnA, alA, mshC);
  KWRITE(1); KLOAD(2 * KVBLK);
  if (tid >= 256) __builtin_amdgcn_s_setprio(1);
  for (int j = 0; j + 2 < NT; j += 2) {
    __syncthreads(); KWRITE(0); VWRITE(1); KLOAD((j + 3) * KVBLK); VLOAD((j + 2) * KVBLK);
    SBAR(); if constexpr (FIXM) qk_fin(pB0, pB1, K_lds + SHM_K, qr, r32, hi, pA0, pA1, l_reg, pa0, pa1, pa2, pa3);
    else { qkt(pB0, pB1, K_lds + SHM_K, qr, r32, hi); finishSM(pA0, pA1, alA, l_reg, pa0, pa1, pa2, pa3); } SBAR();
    pv_pipe<FIXM>(o, vbp, pa0, pa1, pa2, pa3, pB0); partialSM<FIXM, true>(pB0, pB1, m_reg, mnB, alB, mshC); RESC(alB);
    __syncthreads(); KWRITE(1); VWRITE(0); if (j + 4 < NT) KLOAD((j + 4) * KVBLK); VLOAD((j + 3) * KVBLK);
    SBAR(); if constexpr (FIXM) qk_fin(pA0, pA1, K_lds, qr, r32, hi, pB0, pB1, l_reg, pa0, pa1, pa2, pa3);
    else { qkt(pA0, pA1, K_lds, qr, r32, hi); finishSM(pB0, pB1, alB, l_reg, pa0, pa1, pa2, pa3); } SBAR();
    pv_pipe<FIXM>(o, vbp + SHM_V, pa0, pa1, pa2, pa3, pA0); partialSM<FIXM, true>(pA0, pA1, m_reg, mnA, alA, mshC); RESC(alA);
  }
  __builtin_amdgcn_s_setprio(0);
  __syncthreads(); VWRITE(1);
  SBAR(); qkt(pB0, pB1, K_lds + SHM_K, qr, r32, hi);
  finishSM(pA0, pA1, alA, l_reg, pa0, pa1, pa2, pa3); SBAR();
  pv_d0(o, vb0, pa0, pa1, pa2, pa3); partialSM<FIXM>(pB0, pB1, m_reg, mnB, alB, mshC); RESC(alB);
  __syncthreads();
  finishSM(pB0, pB1, alB, l_reg, pa0, pa1, pa2, pa3); SBAR();
  pv_d0(o, vb0 + (int)SHM_V, pa0, pa1, pa2, pa3);
  if (hi == 0) li_l[r32] = l_reg; asm volatile("s_waitcnt lgkmcnt(0)" ::: "memory");
  float rli[16];
#pragma unroll
  for (int r = 0; r < 16; ++r) rli[r] = __builtin_amdgcn_rcpf(li_l[crow(r, hi)]);
  bf16_t* Ow = Ob + (long)(wid * QBLK) * LDO;
#pragma unroll
  for (int r = 0; r < 16; ++r) { int orow = crow(r, hi);
#pragma unroll
    for (int d0 = 0; d0 < 4; ++d0) Ow[(long)orow * LDO + d0 * 32 + r32] = f2bf(o[d0][r] * rli[r]); }
#undef KLOAD
#undef VLOAD
#undef KWRITE
#undef VWRITE
#undef RESC
}
}


constexpr int NWAVES = 8, NTHREADS = 512;
constexpr int N_LAUNCHES = MK_N_LAUNCHES;
constexpr int NPHASES = 27;
constexpr size_t MiB = 1u << 20;
constexpr size_t WS_CTL = 0, CTL_ZERO_BYTES = 1 * MiB;
constexpr size_t WS_ROPE = 1 * MiB, WS_MEMSS = 1 * MiB + 65536;
constexpr size_t WS_WIN = 2 * MiB, WS_WOUT = 178 * MiB, WS_WCQ = 242 * MiB, WS_WCKV = 250 * MiB, WS_WCO = 266 * MiB, WS_WUP = 274 * MiB, WS_WDOWN = 618 * MiB;
constexpr size_t WS_XB = 790 * MiB, WS_PROJ = 918 * MiB, WS_MIX = 1270 * MiB, WS_CQ = 1398 * MiB, WS_CO = 1414 * MiB, WS_MEMB = 1430 * MiB, WS_MKV = 1440 * MiB;
constexpr size_t WS_GH = 1446 * MiB, WS_HB = 1790 * MiB, WS_U = 1812 * MiB, WS_SS = 2068 * MiB, WS_END = 2196 * MiB;
static_assert(WS_WIN + 2ull * NIN * DM * 2 <= WS_WOUT && WS_WUP + 2ull * NUP * DM * 2 <= WS_WDOWN && WS_WDOWN + 2ull * DM * DFF * 2 <= WS_XB, "ws map (weights)");
static_assert(WS_PROJ + (size_t)MROWS * NIN * 2 <= WS_MIX && WS_GH + (size_t)MROWS * DFF * 2 <= WS_HB && WS_HB + 64ull * 4 * NUP * 4 <= WS_U && WS_U + 2ull * 2048 * 16384 * 2 <= WS_SS, "ws map (activations)");
constexpr int CW_BAR = 4096;
constexpr size_t CTL_SSQ = 65536;
static_assert(CTL_SSQ + 7ull * 16384 * 8 <= CTL_ZERO_BYTES, "ssq inside the memset region");
constexpr int RING_BYTES = 131072, XL_OFF = 131072, MISC_OFF = 143360, LDS_BYTES = 147456;
constexpr int RS = 136, RSB = RS * 2, RTB = 128 * RSB;
static_assert(4 * RTB + 1024 <= MISC_OFF && XL_OFF + 8192 + 4096 <= MISC_OFF && MISC_OFF + 128 <= LDS_BYTES, "LDS map");

typedef GAS unsigned gu32;
#define RLX_AGENT __ATOMIC_RELAXED, __HIP_MEMORY_SCOPE_AGENT
#define LDS_WAIT() asm volatile("s_waitcnt lgkmcnt(0)" ::: "memory")
#define VM_WAIT() asm volatile("s_waitcnt vmcnt(0)" ::: "memory")

#define XB_TMO      128
#define XB_XCNT(j)  (256  + 64 * (j))
#define XB_XSUB(j)  (1280 + 64 * (j))
#define XB_XGEN(j)  (2304 + 64 * (j))
#define XB_TOP      3328
#define XB_TOPGEN   3392
#define XCD_BAR_WORDS 3456
#define XB_SPIN_CAP (1u << 18)
__device__ __forceinline__ unsigned xb_ld(unsigned* p)              { return __hip_atomic_load(p, __ATOMIC_RELAXED, __HIP_MEMORY_SCOPE_AGENT); }
__device__ __forceinline__ unsigned xb_add(unsigned* p, unsigned v) { return __hip_atomic_fetch_add(p, v, __ATOMIC_RELAXED, __HIP_MEMORY_SCOPE_AGENT); }
__device__ __forceinline__ unsigned xb_xcc_id() { return (unsigned)__builtin_amdgcn_s_getreg((3 << 11) | 20) & 0xFu; }
#define XB_SPIN(cond, bar) do { unsigned _sp = 0; while (cond) { __builtin_amdgcn_s_sleep(1); \
    if ((++_sp & 255u) == 0u) { if (xb_ld(&(bar)[XB_TMO])) break; if (_sp > XB_SPIN_CAP) { atomicAdd(&(bar)[XB_TMO], 1u); break; } } } } while (0)
struct XcdBarrier { unsigned* bar; unsigned x; volatile LAS unsigned* st; };
__device__ __forceinline__ XcdBarrier xcd_barrier_post(unsigned* bar, volatile LAS unsigned* st) {
    XcdBarrier b; b.bar = bar; b.x = xb_xcc_id(); b.st = st;
    if (threadIdx.x == 0) (void)xb_add(&bar[XB_XCNT(b.x)], 1u);
    return b;
}
__device__ __forceinline__ void xcd_barrier_complete(unsigned* bar, unsigned x, unsigned& nloc, unsigned& nx) {
    const unsigned G = gridDim.x * gridDim.y * gridDim.z;
    unsigned sum, cnt, mine, sp = 0u;
    for (;;) {
        sum = 0u; cnt = 0u; mine = 0u;
#pragma unroll
        for (unsigned j = 0; j < 16; ++j) { const unsigned c = xb_ld(&bar[XB_XCNT(j)]); sum += c; cnt += (c > 0u) ? 1u : 0u; mine = (j == x) ? c : mine; }
        if (sum == G) break;
        __builtin_amdgcn_s_sleep(1);
        if ((++sp & 255u) == 0u) { if (xb_ld(&bar[XB_TMO])) break; if (sp > XB_SPIN_CAP) { atomicAdd(&bar[XB_TMO], 1u); break; } }
    }
    nloc = mine > 0u ? mine : 1u; nx = cnt > 0u ? cnt : 1u;
}
__device__ __forceinline__ void xcd_barrier(const XcdBarrier& b) {
    asm volatile("s_waitcnt vmcnt(0)" ::: "memory");
    __syncthreads();
    if (threadIdx.x == 0) {
        unsigned* bar = b.bar;
        __builtin_amdgcn_s_waitcnt(0);
        unsigned nloc = b.st[0], nx = b.st[1];
        if (nloc == 0u) { xcd_barrier_complete(bar, b.x, nloc, nx); b.st[0] = nloc; b.st[1] = nx; }
        const unsigned old = xb_add(&bar[XB_XSUB(b.x)], 1u);
        const unsigned gen = old / nloc;
        if (old + 1u == (gen + 1u) * nloc) {
            __builtin_amdgcn_fence(__ATOMIC_RELEASE, "agent");
            asm volatile("s_waitcnt vmcnt(0)" ::: "memory");
            const unsigned og = xb_add(&bar[XB_TOP], 1u);
            const unsigned tg = og / nx;
            if (og + 1u == (tg + 1u) * nx) xb_add(&bar[XB_TOPGEN], 1u);
            else XB_SPIN(xb_ld(&bar[XB_TOPGEN]) == tg, bar);
            __builtin_amdgcn_fence(__ATOMIC_ACQUIRE, "agent");
            xb_add(&bar[XB_XGEN(b.x)], 1u);
            asm volatile("s_waitcnt vmcnt(0)" ::: "memory");
        } else {
            XB_SPIN(xb_ld(&bar[XB_XGEN(b.x)]) == gen, bar);
            __builtin_amdgcn_fence(__ATOMIC_ACQUIRE, "agent");
            asm volatile("s_waitcnt vmcnt(0)" ::: "memory");
        }
    }
    __syncthreads();
}

struct Args { const float* in[21]; float* out; unsigned char* ws; int ph_lo, ph_hi; };

template <bool UPMAP, bool ROPEPERM = false>
__device__ __forceinline__ void p0_transpose_item(const float* __restrict__ W, int K, int N, bf16_t* __restrict__ WT, const float* __restrict__ gain, int cs_lo, int cs_hi, float cs, LAS float* scr, int item, int lane) {
    const int nblk = N / 64, kb = item / nblk, nb = item % nblk, k0 = 64 * kb, n0 = 64 * nb;
    const float* src = W + (size_t)k0 * N + n0 + lane;
#pragma unroll 32
    for (int i = 0; i < 64; ++i) scr[i * 65 + lane] = __builtin_nontemporal_load(src + (size_t)i * N);
    LDS_WAIT(); asm volatile("" ::: "memory");
    const int c = lane & 7, rr = lane >> 3;
    float g8[8];
#pragma unroll
    for (int e = 0; e < 8; ++e) g8[e] = gain ? gain[k0 + 8 * c + e] : 1.0f;
    const float csv = (n0 >= cs_lo && n0 < cs_hi) ? cs : 1.0f;
    int orow0 = n0;
    if (UPMAP) { const int nn = n0 < DFF ? n0 : n0 - DFF; orow0 = (nn >> 7) * 256 + (n0 < DFF ? 0 : 128) + (nn & 127); }
    const bool hperm = ROPEPERM && (n0 < 4096 || (n0 >= 8192 && n0 < 10752));
#pragma unroll
    for (int jj = 0; jj < 8; ++jj) { const int n = rr + 8 * jj; const LAS float* s = scr + (8 * c) * 65 + n;
        const int nrow = hperm ? (8 * ((n & 31) >> 2) + (n & 3) + ((n >= 32) ? 4 : 0)) : n;
        u32x4 o;
        o.x = cvt_pk_bf16(s[0 * 65] * g8[0] * csv, s[1 * 65] * g8[1] * csv); o.y = cvt_pk_bf16(s[2 * 65] * g8[2] * csv, s[3 * 65] * g8[3] * csv);
        o.z = cvt_pk_bf16(s[4 * 65] * g8[4] * csv, s[5 * 65] * g8[5] * csv); o.w = cvt_pk_bf16(s[6 * 65] * g8[6] * csv, s[7 * 65] * g8[7] * csv);
        __builtin_nontemporal_store(o, (u32x4*)(WT + (size_t)(orow0 + nrow) * K + k0 + 8 * c)); }
    LDS_WAIT(); asm volatile("" ::: "memory");
}
__device__ __forceinline__ float wave_sum(float v) {
#pragma unroll
    for (int o = 1; o < 64; o <<= 1) v += __shfl_xor(v, o);
    return v;
}
template <class TS> __device__ __forceinline__ void row_to_bf16(const float* __restrict__ xrow, bf16_t* __restrict__ orow, TS* ssq_out, int lane) {
    const f32x4* xr = (const f32x4*)xrow + lane; float s = 0.f;
    u32x2* o8 = (u32x2*)orow + lane;
#pragma unroll
    for (int j = 0; j < 16; ++j) { const f32x4 v = __builtin_nontemporal_load(xr + 64 * j); s += (v[0] * v[0] + v[1] * v[1]) + (v[2] * v[2] + v[3] * v[3]);
        u32x2 w; w.x = cvt_pk_bf16(v[0], v[1]); w.y = cvt_pk_bf16(v[2], v[3]); o8[64 * j] = w; }
    s = wave_sum(s);
    if (lane == 0) { if constexpr (sizeof(TS) == 8) *ssq_out = (TS)(s * 1048576.0f + 0.5f); else *ssq_out = s; }
}

__device__ __forceinline__ void prep_row(bf16_t* __restrict__ prow, int t, const f32x2* __restrict__ rope, const float* __restrict__ qn, const float* __restrict__ kn, int lane) {
    const int hg = lane >> 3, j = lane & 7;
    const int off1 = 8 * j + ((j >= 4) ? 32 : 0);
    const int pos = (j < 4) ? (t >> 6) : (t & 63);
    const f32x2* rp = rope + pos * 32 + 8 * (j & 3);
    f32x2 cs[8];
#pragma unroll
    for (int e = 0; e < 8; ++e) cs[e] = rp[e];
#pragma unroll
    for (int g = 0; g < 7; ++g) {
        const int base = (g < 4) ? g * 1024 : (g < 6 ? 8192 + (g - 4) * 1024 : 10240);
        const bool active = (g < 6) || (hg < 4);
        const int hh = active ? hg : 0;
        bf16_t* p = prow + base + hh * 128 + off1;
        const u32x4 a = *(const u32x4*)p, b = *(const u32x4*)(p + 32);
        float x1[8] = {bf_lo(a.x), bf_hi(a.x), bf_lo(a.y), bf_hi(a.y), bf_lo(a.z), bf_hi(a.z), bf_lo(a.w), bf_hi(a.w)};
        float x2[8] = {bf_lo(b.x), bf_hi(b.x), bf_lo(b.y), bf_hi(b.y), bf_lo(b.z), bf_hi(b.z), bf_lo(b.w), bf_hi(b.w)};
        if (g >= 4) {
            float ss = 0.f;
#pragma unroll
            for (int e = 0; e < 8; ++e) ss += x1[e] * x1[e] + x2[e] * x2[e];
            ss += __shfl_xor(ss, 1); ss += __shfl_xor(ss, 2); ss += __shfl_xor(ss, 4);
            const float rs = __builtin_amdgcn_rsqf(ss * (1.0f / 128.0f) + EPS);
            const float* gn = (g < 6) ? qn : kn;
#pragma unroll
            for (int e = 0; e < 8; ++e) { x1[e] *= rs * gn[off1 + e]; x2[e] *= rs * gn[off1 + 32 + e]; }
        }
        float y1[8], y2[8];
#pragma unroll
        for (int e = 0; e < 8; ++e) { y1[e] = x1[e] * cs[e].x - x2[e] * cs[e].y; y2[e] = x2[e] * cs[e].x + x1[e] * cs[e].y; }
        if (active) {
            u32x4 oa, ob;
            oa.x = cvt_pk_bf16(y1[0], y1[1]); oa.y = cvt_pk_bf16(y1[2], y1[3]); oa.z = cvt_pk_bf16(y1[4], y1[5]); oa.w = cvt_pk_bf16(y1[6], y1[7]);
            ob.x = cvt_pk_bf16(y2[0], y2[1]); ob.y = cvt_pk_bf16(y2[2], y2[3]); ob.z = cvt_pk_bf16(y2[4], y2[5]); ob.w = cvt_pk_bf16(y2[6], y2[7]);
            *(u32x4*)p = oa; *(u32x4*)(p + 32) = ob;
        }
    }
}

__device__ __forceinline__ f32x4 mfma16(bf16x8 a, bf16x8 b, f32x4 c) { return __builtin_amdgcn_mfma_f32_16x16x32_bf16(a, b, c, 0, 0, 0); }
__device__ __forceinline__ bf16x8 tr_frag(int addr) {
    s16x4 lo, hi;
    asm volatile("ds_read_b64_tr_b16 %0, %2\n\tds_read_b64_tr_b16 %1, %2 offset:%3\n\ts_waitcnt lgkmcnt(0)" : "=&v"(lo), "=&v"(hi) : "v"(addr), "i"(4 * RSB) : "memory");
    return (bf16x8){lo[0], lo[1], lo[2], lo[3], hi[0], hi[1], hi[2], hi[3]};
}
__device__ __forceinline__ void tr_frag4(int addr, bf16x8 (&f)[4]) {
    s16x4 l0, h0, l1, h1, l2, h2, l3, h3;
    asm volatile("ds_read_b64_tr_b16 %0, %8\n\tds_read_b64_tr_b16 %1, %8 offset:%9\n\tds_read_b64_tr_b16 %2, %8 offset:32\n\tds_read_b64_tr_b16 %3, %8 offset:%10\n\t"
                 "ds_read_b64_tr_b16 %4, %8 offset:64\n\tds_read_b64_tr_b16 %5, %8 offset:%11\n\tds_read_b64_tr_b16 %6, %8 offset:96\n\tds_read_b64_tr_b16 %7, %8 offset:%12\n\ts_waitcnt lgkmcnt(0)"
                 : "=&v"(l0), "=&v"(h0), "=&v"(l1), "=&v"(h1), "=&v"(l2), "=&v"(h2), "=&v"(l3), "=&v"(h3)
                 : "v"(addr), "i"(4 * RSB), "i"(4 * RSB + 32), "i"(4 * RSB + 64), "i"(4 * RSB + 96) : "memory");
    f[0] = (bf16x8){l0[0], l0[1], l0[2], l0[3], h0[0], h0[1], h0[2], h0[3]}; f[1] = (bf16x8){l1[0], l1[1], l1[2], l1[3], h1[0], h1[1], h1[2], h1[3]};
    f[2] = (bf16x8){l2[0], l2[1], l2[2], l2[3], h2[0], h2[1], h2[2], h2[3]}; f[3] = (bf16x8){l3[0], l3[1], l3[2], l3[3], h3[0], h3[1], h3[2], h3[3]};
}
__device__ __forceinline__ void ret_state_item(LAS unsigned char* lds, const bf16_t* __restrict__ PROJ, bf16_t* __restrict__ U, int r0, int h, int item, float lf2, float lb2) {
    int tid_ = threadIdx.x; asm volatile("" : "+v"(tid_)); const int tid = tid_, lane = tid & 63, w = __builtin_amdgcn_readfirstlane(tid >> 6), g = lane >> 4, lr = lane & 15, q4 = (lane & 15) >> 2, p4 = lane & 3;
    const int wr4 = w >> 1, wc2 = w & 1;
    LAS bf16_t* Kf = (LAS bf16_t*)lds; LAS bf16_t* Kb = Kf + 128 * RS; LAS bf16_t* Vs = Kb + 128 * RS;
#pragma unroll
    for (int p = 0; p < 4; ++p) { const int idx = tid + 512 * p, j = idx >> 4, cc = (idx & 15) * 8;
        const bf16_t* src = PROJ + (size_t)(r0 + j) * NIN + 2048 + h * 128 + cc;
        const u32x4 k = *(const u32x4*)src, v = *(const u32x4*)(src + 2048);
        const float zf = __builtin_amdgcn_exp2f((float)(127 - j) * lf2), zb = __builtin_amdgcn_exp2f((float)j * lb2);
        u32x4 kf, kb;
        kf.x = cvt_pk_bf16(bf_lo(k.x) * zf, bf_hi(k.x) * zf); kf.y = cvt_pk_bf16(bf_lo(k.y) * zf, bf_hi(k.y) * zf); kf.z = cvt_pk_bf16(bf_lo(k.z) * zf, bf_hi(k.z) * zf); kf.w = cvt_pk_bf16(bf_lo(k.w) * zf, bf_hi(k.w) * zf);
        kb.x = cvt_pk_bf16(bf_lo(k.x) * zb, bf_hi(k.x) * zb); kb.y = cvt_pk_bf16(bf_lo(k.y) * zb, bf_hi(k.y) * zb); kb.z = cvt_pk_bf16(bf_lo(k.z) * zb, bf_hi(k.z) * zb); kb.w = cvt_pk_bf16(bf_lo(k.w) * zb, bf_hi(k.w) * zb);
        *(LAS u32x4*)(Kf + j * RS + cc) = kf; *(LAS u32x4*)(Kb + j * RS + cc) = kb; *(LAS u32x4*)(Vs + j * RS + cc) = v; }
    __syncthreads();
    f32x4 af[2][4], ab[2][4];
#pragma unroll
    for (int a = 0; a < 2; ++a)
#pragma unroll
        for (int b = 0; b < 4; ++b) { af[a][b] = (f32x4){0.f, 0.f, 0.f, 0.f}; ab[a][b] = (f32x4){0.f, 0.f, 0.f, 0.f}; }
    const int vbase = (int)(uintptr_t)Vs, fbase = (int)(uintptr_t)Kf, bbase = (int)(uintptr_t)Kb;
#pragma unroll
    for (int ks = 0; ks < 4; ++ks) {
        const int rowoff = (32 * ks + 8 * g + q4) * RSB;
        bf16x8 A4[4], Bf[4], Bb[4];
        tr_frag4(vbase + rowoff + (32 * wr4 + 4 * p4) * 2, A4);
        tr_frag4(fbase + rowoff + (64 * wc2 + 4 * p4) * 2, Bf);
        tr_frag4(bbase + rowoff + (64 * wc2 + 4 * p4) * 2, Bb);
#pragma unroll
        for (int b = 0; b < 4; ++b)
#pragma unroll
            for (int a = 0; a < 2; ++a) { af[a][b] = mfma16(A4[a], Bf[b], af[a][b]); ab[a][b] = mfma16(A4[a], Bb[b], ab[a][b]); }
    }
    LAS float* Ys = (LAS float*)lds;
#pragma unroll
    for (int dir = 0; dir < 2; ++dir) {
        __syncthreads();
#pragma unroll
        for (int a = 0; a < 2; ++a)
#pragma unroll
            for (int b = 0; b < 4; ++b)
#pragma unroll
                for (int r = 0; r < 4; ++r) Ys[(32 * wr4 + 16 * a + 4 * g + r) * 132 + 64 * wc2 + 16 * b + lr] = dir ? ab[a][b][r] : af[a][b][r];
        __syncthreads();
        bf16_t* Ud = U + (size_t)(dir * 2048 + item) * 16384;
#pragma unroll
        for (int p = 0; p < 4; ++p) { const int idx = tid + 512 * p, j = idx >> 4, cc = (idx & 15) * 8;
            const f32x4 y0 = *(const LAS f32x4*)(Ys + j * 132 + cc), y1 = *(const LAS f32x4*)(Ys + j * 132 + cc + 4);
            u32x4 wv; wv.x = cvt_pk_bf16(y0[0], y0[1]); wv.y = cvt_pk_bf16(y0[2], y0[3]); wv.z = cvt_pk_bf16(y1[0], y1[1]); wv.w = cvt_pk_bf16(y1[2], y1[3]);
            *(u32x4*)(Ud + j * 128 + cc) = wv; }
    }
    __syncthreads();
}
constexpr int YS = 132;
static_assert(128 * YS * 4 <= 2 * RTB, "y tile fits the K + V tiles");
__device__ __forceinline__ void ret_item_geom(int it, const float* __restrict__ dl  , int& r0, int& h, float& lf2, float& lb2) {
    if (it < 1024) { const int sh = it >> 4, c = it & 15; h = sh & 15; r0 = (sh >> 4) * 2048 + c * 128; }
    else { const int i2 = it - 1024; h = i2 >> 6; r0 = 8192 + (i2 & 63) * 128; }
    lf2 = dl[h]; lb2 = dl[16 + h];
}
__device__ __forceinline__ void ret_out_phase(LAS unsigned char* lds, const bf16_t* __restrict__ PROJ, const bf16_t* __restrict__ SS, bf16_t* __restrict__ MIX, const float* __restrict__ dl, int first, int step) {
#define RET_LANE_IDS int tid_ = threadIdx.x; asm volatile("" : "+v"(tid_)); const int tid = tid_, lane = tid & 63, w = __builtin_amdgcn_readfirstlane(tid >> 6), g = lane >> 4, lr = lane & 15, q4 = (lane & 15) >> 2, p4 = lane & 3, wr4 = w >> 1, wc2 = w & 1; (void)q4; (void)p4; (void)wc2;
    LAS bf16_t* Ks = (LAS bf16_t*)lds; LAS bf16_t* Vs = Ks + 128 * RS; LAS bf16_t* Fs = Vs + 128 * RS; LAS bf16_t* Bs = Fs + 128 * RS; LAS float* RSUM = (LAS float*)(lds + 4 * RTB);
    LAS bf16_t* Ps = Ks; LAS float* Ys = (LAS float*)lds;
    if (first >= 2048) return;
    bf16x8 AQ[2][4]; u32x4 kv[4];
#define RET_LOAD_QK(r0_, h_) do { \
    _Pragma("unroll") for (int a = 0; a < 2; ++a) _Pragma("unroll") for (int ks = 0; ks < 4; ++ks) AQ[a][ks] = *(const bf16x8*)(PROJ + ((size_t)(r0_) * NIN + (h_) * 128) + (unsigned)((32 * wr4 + 16 * a + lr) * NIN + 32 * ks + 8 * g)); \
    _Pragma("unroll") for (int p = 0; p < 4; ++p) { const int idx = tid + 512 * p, j = idx >> 4, cc = (idx & 15) * 8; kv[p] = *(const u32x4*)(PROJ + ((size_t)(r0_) * NIN + 2048 + (h_) * 128) + (unsigned)(j * NIN + cc)); } } while (0)
    { RET_LANE_IDS int r0, h; float lf2, lb2; ret_item_geom(first, dl, r0, h, lf2, lb2); RET_LOAD_QK(r0, h); }
    for (int item = first; item < 2048; item += step) {
        RET_LANE_IDS
        int r0, h; float lf2, lb2; ret_item_geom(item, dl, r0, h, lf2, lb2);
        const bf16_t* SfT = SS + (size_t)item * 16384; const bf16_t* SbT = SS + (size_t)(2048 + item) * 16384;
        u32x4 vv[4], fv[4], bv[4], gv[4];
#pragma unroll
        for (int p = 0; p < 4; ++p) { const int idx = tid + 512 * p, j = idx >> 4, cc = (idx & 15) * 8;
            const bf16_t* pb = PROJ + ((size_t)r0 * NIN + 4096 + h * 128); const unsigned po = (unsigned)(j * NIN + cc), so = (unsigned)(j * 128 + cc);
            vv[p] = *(const u32x4*)(pb + po); gv[p] = *(const u32x4*)(pb + 2048 + po);
            fv[p] = *(const u32x4*)(SfT + so); bv[p] = *(const u32x4*)(SbT + so); }
#pragma unroll
        for (int p = 0; p < 4; ++p) { const int idx = tid + 512 * p, j = idx >> 4, cc = (idx & 15) * 8; *(LAS u32x4*)(Ks + j * RS + cc) = kv[p]; }
        __syncthreads();
        f32x4 sc[2][4];
#pragma unroll
        for (int a = 0; a < 2; ++a)
#pragma unroll
            for (int b = 0; b < 4; ++b) sc[a][b] = (f32x4){0.f, 0.f, 0.f, 0.f};
#pragma unroll
        for (int ks = 0; ks < 4; ++ks) {
            bf16x8 B[4];
#pragma unroll
            for (int b = 0; b < 4; ++b) B[b] = *(const LAS bf16x8*)(Ks + (64 * wc2 + 16 * b + lr) * RS + 32 * ks + 8 * g);
#pragma unroll
            for (int a = 0; a < 2; ++a)
#pragma unroll
                for (int b = 0; b < 4; ++b) sc[a][b] = mfma16(AQ[a][ks], B[b], sc[a][b]);
        }
#pragma unroll
        for (int a = 0; a < 2; ++a)
#pragma unroll
            for (int b = 0; b < 4; ++b)
#pragma unroll
                for (int r = 0; r < 4; ++r) { const int i = 32 * wr4 + 16 * a + 4 * g + r, j = 64 * wc2 + 16 * b + lr, d = i - j;
                    sc[a][b][r] *= __builtin_amdgcn_exp2f(d >= 0 ? (float)d * lf2 : (float)(-d) * lb2); }
        __syncthreads();
#pragma unroll
        for (int a = 0; a < 2; ++a)
#pragma unroll
            for (int b = 0; b < 4; ++b)
#pragma unroll
                for (int r = 0; r < 4; ++r) Ps[(32 * wr4 + 16 * a + 4 * g + r) * RS + 64 * wc2 + 16 * b + lr] = f2bf(sc[a][b][r]);
#pragma unroll
        for (int p = 0; p < 4; ++p) { const int idx = tid + 512 * p, j = idx >> 4, cc = (idx & 15) * 8;
            *(LAS u32x4*)(Vs + j * RS + cc) = vv[p]; *(LAS u32x4*)(Fs + j * RS + cc) = fv[p]; *(LAS u32x4*)(Bs + j * RS + cc) = bv[p]; }
        __syncthreads();
        f32x4 y[2][4];
#pragma unroll
        for (int a = 0; a < 2; ++a)
#pragma unroll
            for (int b = 0; b < 4; ++b) y[a][b] = (f32x4){0.f, 0.f, 0.f, 0.f};
        float xfr[2], xbr[2];
#pragma unroll
        for (int a = 0; a < 2; ++a) { const int i = 32 * wr4 + 16 * a + lr; xfr[a] = __builtin_amdgcn_exp2f((float)(i + 1) * lf2); xbr[a] = __builtin_amdgcn_exp2f((float)(128 - i) * lb2); }
        const int vbase = (int)(uintptr_t)Vs;
#pragma unroll
        for (int ks = 0; ks < 4; ++ks) {
            bf16x8 AP[2], AF[2], AB[2], BV[4], BF[4], BB[4];
#pragma unroll
            for (int a = 0; a < 2; ++a) { AP[a] = *(const LAS bf16x8*)(Ps + (32 * wr4 + 16 * a + lr) * RS + 32 * ks + 8 * g);
                const u32x4 q = __builtin_bit_cast(u32x4, AQ[a][ks]); u32x4 f, bq;
                f.x = cvt_pk_bf16(bf_lo(q.x) * xfr[a], bf_hi(q.x) * xfr[a]); f.y = cvt_pk_bf16(bf_lo(q.y) * xfr[a], bf_hi(q.y) * xfr[a]); f.z = cvt_pk_bf16(bf_lo(q.z) * xfr[a], bf_hi(q.z) * xfr[a]); f.w = cvt_pk_bf16(bf_lo(q.w) * xfr[a], bf_hi(q.w) * xfr[a]);
                bq.x = cvt_pk_bf16(bf_lo(q.x) * xbr[a], bf_hi(q.x) * xbr[a]); bq.y = cvt_pk_bf16(bf_lo(q.y) * xbr[a], bf_hi(q.y) * xbr[a]); bq.z = cvt_pk_bf16(bf_lo(q.z) * xbr[a], bf_hi(q.z) * xbr[a]); bq.w = cvt_pk_bf16(bf_lo(q.w) * xbr[a], bf_hi(q.w) * xbr[a]);
                AF[a] = __builtin_bit_cast(bf16x8, f); AB[a] = __builtin_bit_cast(bf16x8, bq); }
#pragma unroll
            for (int b = 0; b < 4; ++b) { BF[b] = *(const LAS bf16x8*)(Fs + (64 * wc2 + 16 * b + lr) * RS + 32 * ks + 8 * g); BB[b] = *(const LAS bf16x8*)(Bs + (64 * wc2 + 16 * b + lr) * RS + 32 * ks + 8 * g); }
            tr_frag4(vbase + (32 * ks + 8 * g + q4) * RSB + (64 * wc2 + 4 * p4) * 2, BV);
#pragma unroll
            for (int a = 0; a < 2; ++a)
#pragma unroll
                for (int b = 0; b < 4; ++b) { y[a][b] = mfma16(AP[a], BV[b], y[a][b]); y[a][b] = mfma16(AF[a], BF[b], y[a][b]); y[a][b] = mfma16(AB[a], BB[b], y[a][b]); }
        }
#pragma unroll
        for (int a = 0; a < 2; ++a)
#pragma unroll
            for (int r = 0; r < 4; ++r) { const int i = 32 * wr4 + 16 * a + 4 * g + r;
                float s = 0.f;
#pragma unroll
                for (int b = 0; b < 4; ++b) { const float v = y[a][b][r]; s += v * v; }
                s += __shfl_xor(s, 1); s += __shfl_xor(s, 2); s += __shfl_xor(s, 4); s += __shfl_xor(s, 8);
                if (lr == 0) RSUM[i * 2 + wc2] = s; }
        { const int nx = item + step; if (nx < 2048) { int r0n, hn; float a_, b_; ret_item_geom(nx, dl, r0n, hn, a_, b_); RET_LOAD_QK(r0n, hn); } }
        __syncthreads();
#pragma unroll
        for (int a = 0; a < 2; ++a)
#pragma unroll
            for (int r = 0; r < 4; ++r) { const int i = 32 * wr4 + 16 * a + 4 * g + r;
                const float rs = __builtin_amdgcn_rsqf((RSUM[i * 2] + RSUM[i * 2 + 1]) * (1.0f / 128.0f) + EPS);
#pragma unroll
                for (int b = 0; b < 4; ++b) Ys[i * YS + 64 * wc2 + 16 * b + lr] = y[a][b][r] * rs; }
        __syncthreads();
#pragma unroll
        for (int p = 0; p < 4; ++p) { const int idx = tid + 512 * p, j = idx >> 4, cc = (idx & 15) * 8;
            const f32x4 y0 = *(const LAS f32x4*)(Ys + j * YS + cc), y1 = *(const LAS f32x4*)(Ys + j * YS + cc + 4);
            const u32x4 gg = gv[p];
            const float gt[8] = {bf_lo(gg.x), bf_hi(gg.x), bf_lo(gg.y), bf_hi(gg.y), bf_lo(gg.z), bf_hi(gg.z), bf_lo(gg.w), bf_hi(gg.w)};
            float o[8];
#pragma unroll
            for (int e = 0; e < 8; ++e) { const float sg = gt[e] * __builtin_amdgcn_rcpf(1.0f + __builtin_amdgcn_exp2f(-gt[e] * 1.4426950408889634f)); o[e] = sg * (e < 4 ? y0[e & 3] : y1[e & 3]); }
            u32x4 wv; wv.x = cvt_pk_bf16(o[0], o[1]); wv.y = cvt_pk_bf16(o[2], o[3]); wv.z = cvt_pk_bf16(o[4], o[5]); wv.w = cvt_pk_bf16(o[6], o[7]);
            *(u32x4*)(MIX + ((size_t)r0 * DM + h * 128) + (unsigned)(j * DM + cc)) = wv; }
        __syncthreads();
    }
#undef RET_LOAD_QK
#undef RET_LANE_IDS
}

#ifndef PROBE
#define PROBE 0
#endif
constexpr int REP_P0 = PROBE == 1 ? 2 : 1, REP_R1 = PROBE == 2 ? 2 : 1, REP_R2 = PROBE == 7 ? 2 : 1, REP_R3 = PROBE == 8 ? 2 : 1, REP_G5 = PROBE == 3 ? 2 : 1, REP_ATT = PROBE == 4 ? 3 : 1, REP_G1 = PROBE == 5 ? 2 : 1, REP_PREP0 = PROBE == 6 ? 2 : 1, XTRA_G6 = PROBE == 9, XTRA_G2 = PROBE == 10, XTRA_G4 = PROBE == 11, XTRA_G5P = PROBE == 12; constexpr int XTRA_BARS = PROBE == 13 ? 20 : 0; constexpr int REP_SMALL = PROBE == 14 ? 2 : 1; constexpr bool XTRA_HOTG2 = PROBE == 15, XTRA_G5NULL = PROBE == 16, XTRA_G2NULL = PROBE == 17;
constexpr int CW_FIN = 245760;
static_assert((size_t)CW_FIN * 4 >= CTL_SSQ + 7ull * 16384 * 8 && (size_t)CW_FIN * 4 + 64 * 64 <= CTL_ZERO_BYTES, "panel counters inside the memset region");
constexpr bool FUSE_FINAL = false && (MK_N_LAUNCHES == 1);
constexpr int CW_SPLIT = 8192;
template <class T> __device__ __forceinline__ T* opq(T* p) { GAS T* q = (GAS T*)p; asm volatile("" : "+s"(q)); return (T*)q; }
__global__ void __launch_bounds__(NTHREADS, 2) trunk_fwd(Args args) {
    extern __shared__ __attribute__((aligned(16))) unsigned char lds_raw[];
    LAS unsigned char* lds = (LAS unsigned char*)lds_raw;
    volatile LAS unsigned* MISC = (volatile LAS unsigned*)(lds + MISC_OFF);
    const int G = gridDim.x; const int bx = blockIdx.x; const int vcu = (G % 8 == 0) ? (bx % 8) * (G / 8) + bx / 8 : bx;
#define WSP(T, off) ((T*)(wsp + (off)))
#define ctl WSP(unsigned, WS_CTL)
#define SSQ WSP(unsigned long long, WS_CTL + CTL_SSQ)
#define ROPE WSP(f32x2, WS_ROPE)
#define MEMSS WSP(float, WS_MEMSS)
#define LG2 WSP(float, WS_MEMSS + 8192)
#define WIN WSP(bf16_t, WS_WIN)
#define WOUT WSP(bf16_t, WS_WOUT)
#define WCQ WSP(bf16_t, WS_WCQ)
#define WCKV WSP(bf16_t, WS_WCKV)
#define WCO WSP(bf16_t, WS_WCO)
#define WUP WSP(bf16_t, WS_WUP)
#define WDOWN WSP(bf16_t, WS_WDOWN)
#define XB WSP(bf16_t, WS_XB)
#define PROJ WSP(bf16_t, WS_PROJ)
#define MIX WSP(bf16_t, WS_MIX)
#define CQ WSP(bf16_t, WS_CQ)
#define CO WSP(bf16_t, WS_CO)
#define MEMB WSP(bf16_t, WS_MEMB)
#define MKV WSP(bf16_t, WS_MKV)
#define GH WSP(bf16_t, WS_GH)
#define HB WSP(float, WS_HB)
#define UU WSP(bf16_t, WS_U)
#define SS WSP(bf16_t, WS_U)
#define XRES (args.out)
#define x_prompt (args.in[0])
#define x_sample (args.in[1])
#define mem_prompt (args.in[2])
#define mem_sample (args.in[3])
#define w_in (args.in[4])
#define w_out (args.in[5])
#define decay_logit (args.in[6])
#define q_norm (args.in[7])
#define k_norm (args.in[8])
#define norm_mix (args.in[9])
#define norm_cross (args.in[10])
#define norm_mem (args.in[11])
#define w_cq (args.in[12])
#define w_ckv (args.in[13])
#define w_co (args.in[14])
#define norm_ffn (args.in[15])
#define w_up (args.in[16])
#define conv_w (args.in[17])
#define conv_b (args.in[18])
#define w_down (args.in[19])
#define norm_final (args.in[20])
    if (threadIdx.x < 32) MISC[threadIdx.x] = 0u;
    __syncthreads();
    XcdBarrier bar; bar.bar = (unsigned*)(args.ws + WS_CTL) + CW_BAR; bar.x = 0; bar.st = nullptr;
    if (N_LAUNCHES == 1) bar = xcd_barrier_post((unsigned*)(args.ws + WS_CTL) + CW_BAR, MISC + 8);
    const int lo = args.ph_lo, hi = args.ph_hi;
#ifndef ONLY_SLOT
#define ONLY_SLOT -1
#endif
#define SLOT_ON(s) (ONLY_SLOT < 0 || ONLY_SLOT == (s))
#define INR(k) (lo <= (k) && (k) < hi)
#define IN0 (SLOT_ON(0) && INR(0))
#define INL(s) (SLOT_ON(1 + (s)) && INR(pb + (s)))
#define INF (SLOT_ON(13) && INR(26))
#define INM (SLOT_ON(14) && INR(1))
#ifndef PT_MASK
#define PT_MASK 0
#endif
#ifndef PT_LAYERS
#define PT_LAYERS 3
#endif
    constexpr int PT_K = 4;
    unsigned long long pt_prev = PT_MASK ? wall_clock64() : 0ull, pt_acc = 0ull;
#if PT_EPI
#define PT_MARK(slot, lay) do { if (PT_MASK) { LAS unsigned long long* ec_ = (LAS unsigned long long*)(lds + MISC_OFF + 64); __syncthreads(); if (((PT_MASK >> (slot)) & 1) && ((PT_LAYERS >> (lay)) & 1)) pt_acc += *ec_; __syncthreads(); if (threadIdx.x == 0) *ec_ = 0ull; __syncthreads(); } } while (0)
#else
#define PT_MARK(slot, lay) do { if (PT_MASK) { const unsigned long long now_ = wall_clock64(); if (((PT_MASK >> (slot)) & 1) && ((PT_LAYERS >> (lay)) & 1)) pt_acc += now_ - pt_prev; pt_prev = now_; } } while (0)
#endif
#define SEAM(k) do { if (N_LAUNCHES == 1 && INR(k) && INR((k) + 1)) xcd_barrier(bar); PT_MARK((k) == 0 ? 0 : 1 + ((k) - 2) % 12, (k) < 2 ? 0 : ((k) - 2) / 12); } while (0)
    const int NGW = G * NWAVES;
#define PHASE_LOCALS GAS unsigned char* wsg = (GAS unsigned char*)args.ws; asm volatile("" : "+s"(wsg)); unsigned char* wsp = (unsigned char*)wsg; int tid = threadIdx.x; asm volatile("" : "+v"(tid)); const int lane = tid & 63, wave = __builtin_amdgcn_readfirstlane(tid >> 6), gw = vcu * NWAVES + wave; (void)lane; (void)gw; (void)wave;

    if (IN0) {
        PHASE_LOCALS
        LAS float* scr = (LAS float*)(lds + wave * 16640);
        constexpr int I_IN = 64 * 176, I_OUT = 64 * 64, I_CQ = 64 * 8, I_CKV = 64 * 16, I_CO = 8 * 64, I_UP = 64 * 344, I_DN = 172 * 64;
        constexpr int I_LAYER = I_IN + I_OUT + I_CQ + I_CKV + I_CO + I_UP + I_DN;
        for (int rep = 0; rep < REP_P0; ++rep)
        for (int itr = gw; itr < 2 * I_LAYER; itr += NGW) {
            const int it = 2 * I_LAYER - 1 - itr; const int l = it / I_LAYER; int r = it % I_LAYER;
            if (r < I_IN) { p0_transpose_item<false, true>(w_in + (size_t)l * DM * NIN, DM, NIN, WIN + (size_t)l * NIN * DM, norm_mix + l * DM, 2048, 4096, 0.088388347648318440f, scr, r, lane); continue; } r -= I_IN;
            if (r < I_OUT) { p0_transpose_item<false>(w_out + (size_t)l * DM * DM, DM, DM, WOUT + (size_t)l * DM * DM, nullptr, 0, 0, 1.f, scr, r, lane); continue; } r -= I_OUT;
            if (r < I_CQ) { p0_transpose_item<false>(w_cq + (size_t)l * DM * MEMW, DM, MEMW, WCQ + (size_t)l * MEMW * DM, norm_cross + l * DM, 0, 0, 1.f, scr, r, lane); continue; } r -= I_CQ;
            if (r < I_CKV) { p0_transpose_item<false>(w_ckv + (size_t)l * DM * 1024, DM, 1024, WCKV + (size_t)l * 1024 * DM, norm_mem + l * DM, 0, 0, 1.f, scr, r, lane); continue; } r -= I_CKV;
            if (r < I_CO) { p0_transpose_item<false>(w_co + (size_t)l * MEMW * DM, MEMW, DM, WCO + (size_t)l * DM * MEMW, nullptr, 0, 0, 1.f, scr, r, lane); continue; } r -= I_CO;
            if (r < I_UP) { p0_transpose_item<true>(w_up + (size_t)l * DM * NUP, DM, NUP, WUP + (size_t)l * NUP * DM, norm_ffn + l * DM, 0, 0, 1.f, scr, r, lane); continue; } r -= I_UP;
            p0_transpose_item<false>(w_down + (size_t)l * DFF * DM, DFF, DM, WDOWN + (size_t)l * DM * DFF, nullptr, 0, 0, 1.f, scr, r, lane);
        }
        for (int rep = 0; rep < REP_SMALL; ++rep)
        for (int m = gw; m < MROWS; m += NGW) row_to_bf16(m < 8192 ? x_prompt + (size_t)m * DM : x_sample + (size_t)(m - 8192) * DM, XB + (size_t)m * DM, SSQ + m, lane);
        for (int m = gw; m < MEMROWS; m += NGW) row_to_bf16(m < 1024 ? mem_prompt + (size_t)m * DM : mem_sample + (size_t)(m - 1024) * DM, MEMB + (size_t)m * DM, MEMSS + m, lane);
        if (PROBE == 21) { u32x4* zp = (u32x4*)(wsp + WS_GH); const size_t n16 = (WS_U - WS_GH) / 16; const u32x4 z = {0u, 0u, 0u, 0u};
            for (size_t i = (size_t)bx * NTHREADS + tid; i < n16; i += (size_t)G * NTHREADS) zp[i] = z; }
        if (bx == 0 && tid < 64) LG2[tid] = -log1pf(__expf(-decay_logit[tid])) * 1.4426950408889634f;
        if (bx == 0 && tid >= 64 && tid < 66) {
            const int ll = tid - 64; float gq = 0.f, gk = 0.f;
            for (int d = 0; d < 128; ++d) { gq = fmaxf(gq, fabsf(q_norm[ll * 128 + d])); gk = fmaxf(gk, fabsf(k_norm[ll * 128 + d])); }
            LG2[64 + ll] = fmaxf(0.f, 1.02f * 128.0f * gq * gk * (0.088388347648318440f * 1.4426950408889634f) - 64.0f); }
        for (int e = bx * NTHREADS + tid; e < 128 * 32; e += G * NTHREADS) { const int pos = e >> 5, i = e & 31;
            const float freq = __builtin_amdgcn_exp2f(-(float)i * (13.287712379549449f / 32.0f));
            const float rev = (float)pos * freq * 0.15915494309189535f, fr = rev - __builtin_floorf(rev);
            ROPE[e] = (f32x2){__builtin_amdgcn_cosf(fr), __builtin_amdgcn_sinf(fr)}; }
    }
    SEAM(0);
    for (int l = 0; l < 2; ++l) {
        const int pb = 2 + 12 * l;
        if (INL(0)) {
            PHASE_LOCALS
            pg8::Gemm g{opq(XB), opq(WIN + (size_t)l * NIN * DM), MROWS, NIN, DM}; pg8::StaticOrder S; S.init(MROWS, NIN, G, bx); pg8::EpiProjRope E{PROJ, SSQ + (3 * l) * MROWS, ROPE, q_norm + l * 128, k_norm + l * 128};
            for (int rep = 0; rep < REP_G1; ++rep) pg8::gemm_phase<pg8::EpiProjRope, pg8::StaticOrder, true, true>(lds, lds + XL_OFF, g, S, E);
        }
        SEAM(pb + 0);
        if (INL(2)) {
            PHASE_LOCALS
#define ATT_UNITS(FIXM_) \
            for (int rep = 0; rep < REP_ATT; ++rep) \
            for (int pass = 0; pass < 2; ++pass) \
                for (int u = vcu; u < 512; u += G) { \
                    int rowbase, h, qb, keys; \
                    if (pass == 0) { const int seq = u >> 7, rem = u & 127; h = rem >> 3; qb = rem & 7; rowbase = seq * 2048; keys = 2048; } \
                    else { h = u >> 5; qb = u & 31; rowbase = 8192; keys = 8192; } \
                    const bf16_t* Qb = PROJ + (size_t)(rowbase + qb * 256) * NIN + 8192 + h * 128; \
                    const bf16_t* Kh = PROJ + (size_t)rowbase * NIN + 10240 + (h >> 2) * 128; \
                    bf16_t* Ob = MIX + (size_t)(rowbase + qb * 256) * DM + 2048 + h * 128; \
                    att::attn_dense_body<NIN, NIN, DM, FIXM_>(Qb, Kh, Kh + 512, Ob, keys, lds); \
                    __syncthreads(); \
                }
            if (LG2[64 + l] == 0.f) { ATT_UNITS(true) }
            else { ATT_UNITS(false) }
#undef ATT_UNITS
            for (int rep = 0; rep < REP_R1; ++rep)
            for (int it = vcu; it < 2048; it += G) {
                int r0, h;
                if (it < 1024) { const int sh = it >> 4, c = it & 15; h = sh & 15; r0 = (sh >> 4) * 2048 + c * 128; }
                else { const int i2 = it - 1024; h = i2 >> 6; r0 = 8192 + (i2 & 63) * 128; }
                const float lf2 = LG2[(l * 2 + 0) * 16 + h], lb2 = LG2[(l * 2 + 1) * 16 + h];
                ret_state_item(lds, PROJ, UU, r0, h, it, lf2, lb2);
            }
        }
        SEAM(pb + 2);
        if (INL(3)) {
            PHASE_LOCALS
            for (int rep = 0; rep < REP_R2; ++rep)
            for (int task = bx * NTHREADS + tid; task < 80 * 2 * 2048; task += G * NTHREADS) {
                const int e8 = task & 2047, dir = (task >> 11) & 1, sh = task >> 12;
                const int h = sh & 15, nc = sh < 64 ? 16 : 64, ibase = sh < 64 ? sh * 16 : 1024 + (sh - 64) * 64;
                const float dC = __builtin_amdgcn_exp2f(LG2[(l * 2 + dir) * 16 + h] * 128.0f);
                bf16_t* sp = SS + ((size_t)dir * 2048 + ibase) * 16384 + e8 * 8;
                f32x4 s0 = {0.f, 0.f, 0.f, 0.f}, s1 = s0;
                for (int cb = 0; cb < nc; cb += 8) {
                    u32x4 uv[8];
#pragma unroll
                    for (int k = 0; k < 8; ++k) { const int c = dir ? nc - 1 - (cb + k) : cb + k; uv[k] = *(const u32x4*)(sp + (size_t)c * 16384); }
#pragma unroll
                    for (int k = 0; k < 8; ++k) { const int c = dir ? nc - 1 - (cb + k) : cb + k;
                        u32x4 w; w.x = cvt_pk_bf16(s0[0], s0[1]); w.y = cvt_pk_bf16(s0[2], s0[3]); w.z = cvt_pk_bf16(s1[0], s1[1]); w.w = cvt_pk_bf16(s1[2], s1[3]); *(u32x4*)(sp + (size_t)c * 16384) = w;
                        s0 = s0 * dC + (f32x4){bf_lo(uv[k].x), bf_hi(uv[k].x), bf_lo(uv[k].y), bf_hi(uv[k].y)}; s1 = s1 * dC + (f32x4){bf_lo(uv[k].z), bf_hi(uv[k].z), bf_lo(uv[k].w), bf_hi(uv[k].w)}; }
                }
            }
        }
        SEAM(pb + 3);
        if (INL(4)) {
            PHASE_LOCALS
            for (int rep = 0; rep < REP_R3; ++rep) ret_out_phase(lds, PROJ, SS, MIX, LG2 + l * 32, vcu, G);
        }
        SEAM(pb + 4);
        if (INL(5)) {
            PHASE_LOCALS
            pg8::Gemm g{opq(MIX), opq(WOUT + (size_t)l * DM * DM), MROWS, DM, DM}; pg8::StaticOrder S; S.init(MROWS, DM, G, bx);
            pg8::EpiRes E{XB, SSQ + (3 * l + 1) * MROWS};
            if (XTRA_G2NULL) { pg8::EpiNull E0{(float*)UU}; pg8::gemm_phase<pg8::EpiNull, pg8::StaticOrder, true, true>(lds, lds + XL_OFF, g, S, E0); }
            if (XTRA_G2) { pg8::EpiRes E2{(bf16_t*)UU, (unsigned long long*)HB}; pg8::gemm_phase<pg8::EpiRes, pg8::StaticOrder, true, true>(lds, lds + XL_OFF, g, S, E2); }
            pg8::gemm_phase<pg8::EpiRes, pg8::StaticOrder, true, true>(lds, lds + XL_OFF, g, S, E);
        }
        SEAM(pb + 5);
        if (INL(6)) {
            PHASE_LOCALS
            if (l == 0) {
                if (bx >= 128) { pg8::Gemm g{opq(MEMB), opq(WCKV), MEMROWS, 2048, DM}; pg8::StaticOrder S; S.init(MEMROWS, 2048, G - 128, bx - 128); pg8::EpiProj E{MKV, 2048, nullptr, MEMSS, nullptr, nullptr, 0};
                    pg8::gemm_phase<pg8::EpiProj, pg8::StaticOrder, true, true>(lds, lds + XL_OFF, g, S, E); }
                else { pg8::Gemm g{opq(XB), opq(WCQ + (size_t)l * MEMW * DM), MROWS, MEMW, DM}; pg8::StaticOrder S; S.init(MROWS, MEMW, G, bx); pg8::EpiProj E{CQ, MEMW, SSQ + (3 * l + 1) * MROWS, nullptr, nullptr, nullptr, 0};
                    pg8::gemm_phase<pg8::EpiProj, pg8::StaticOrder, true, true>(lds, lds + XL_OFF, g, S, E); }
            } else {
                pg8::Gemm g{opq(XB), opq(WCQ + (size_t)l * MEMW * DM), MROWS, MEMW, DM}; pg8::SplitLastOrder S; S.init(MROWS, MEMW, G, bx); S.full = (G == 256) ? 0 : 1000000; S.ntl = DM / 64;
                pg8::EpiProj E{CQ, MEMW, SSQ + (3 * l + 1) * MROWS, nullptr, (unsigned long long*)UU, ctl + CW_SPLIT + (2 + l) * 128 * 16, bx & 127};
                pg8::gemm_phase<pg8::EpiProj, pg8::SplitLastOrder, true, true>(lds, lds + XL_OFF, g, S, E);
            }
        }
        SEAM(pb + 6);
        if (INL(7)) {
            PHASE_LOCALS
            for (int rep = 0; rep < REP_SMALL; ++rep)
            for (int u = vcu; u < 256; u += G) { const int rb = u >> 2, h = u & 3, b = rb < 32 ? (rb >> 3) : 4;
                const bf16_t* Kh = MKV + (size_t)(b * 256) * 2048 + l * 1024 + h * 128;
                att::attn_dense_body<MEMW, 2048, MEMW>(CQ + (size_t)(rb * 256) * MEMW + h * 128, Kh, Kh + 512, CO + (size_t)(rb * 256) * MEMW + h * 128, 256, lds);
                __syncthreads(); }
        }
        SEAM(pb + 7);
        if (INL(8)) {
            PHASE_LOCALS
            pg8::Gemm g{opq(CO), opq(WCO + (size_t)l * DM * MEMW), MROWS, DM, MEMW}; pg8::StaticOrder S; S.init(MROWS, DM, G, bx);
            pg8::EpiRes E{XB, SSQ + (3 * l + 2) * MROWS};
            if (XTRA_G4) { pg8::EpiRes E2{(bf16_t*)UU, (unsigned long long*)HB}; pg8::gemm_phase<pg8::EpiRes, pg8::StaticOrder, true, true>(lds, lds + XL_OFF, g, S, E2); }
            pg8::gemm_phase<pg8::EpiRes, pg8::StaticOrder, true, true>(lds, lds + XL_OFF, g, S, E);
        }
        SEAM(pb + 8);
        if (INL(9)) {
            PHASE_LOCALS
            pg8::Gemm g{opq(XB), opq(WUP + (size_t)l * NUP * DM), MROWS, NUP, DM}; pg8::SplitLastOrder S; S.init(MROWS, NUP, G, bx); S.full = (G == 256) ? 21 : 1000000; S.ntl = DM / 64;
            pg8::EpiConv E{wsp, WS_GH, WS_HB, WS_CTL + CTL_SSQ + (size_t)(3 * l + 2) * MROWS * 8, conv_w + (size_t)l * 3 * NUP, conv_b + (size_t)l * NUP, (unsigned long long*)UU, ctl + CW_SPLIT + l * 128 * 16, bx & 127};
            if (PROBE == 19 || PROBE == 20) { pg8::AliasOrder SA; SA.init(MROWS, NUP, G, bx); SA.am = PROBE == 20 ? 7 : ~0; SA.an = PROBE == 19 ? 3 : ~0; pg8::EpiNull E0{(float*)UU}; pg8::gemm_phase<pg8::EpiNull, pg8::AliasOrder, true, true>(lds, lds + XL_OFF, g, SA, E0); }
            if (PROBE == 22) { { u32x4* zp = (u32x4*)(wsp + WS_U); const size_t n16 = (WS_END - WS_U) / 16; const u32x4 z = {0u, 0u, 0u, 0u}; for (size_t i = (size_t)bx * NTHREADS + tid; i < n16; i += (size_t)G * NTHREADS) zp[i] = z; __syncthreads(); } pg8::EpiNull E0{(float*)UU}; pg8::gemm_phase<pg8::EpiNull, pg8::StaticOrder, true, true>(lds, lds + XL_OFF, g, S, E0); }
            if (PROBE == 23) { pg8::EpiNull E0{(float*)UU}; pg8::gemm_phase<pg8::EpiNull, pg8::StaticOrder, true, true>(lds, lds + XL_OFF, g, S, E0); { u32x4* zp = (u32x4*)(wsp + WS_U); const size_t n16 = (WS_END - WS_U) / 16; const u32x4 z = {0u, 0u, 0u, 0u}; for (size_t i = (size_t)bx * NTHREADS + tid; i < n16; i += (size_t)G * NTHREADS) zp[i] = z; __syncthreads(); } }
            if (XTRA_G5NULL) { pg8::EpiNull E0{(float*)UU}; pg8::gemm_phase<pg8::EpiNull, pg8::StaticOrder, true, true>(lds, lds + XL_OFF, g, S, E0); }
            if (XTRA_G5P) { pg8::EpiProj E2{PROJ, NIN, SSQ + (3 * l + 2) * MROWS, nullptr, nullptr, nullptr, 0}; pg8::gemm_phase<pg8::EpiProj, pg8::StaticOrder, true, true>(lds, lds + XL_OFF, g, S, E2); }
            for (int rep = 0; rep < REP_G5; ++rep) pg8::gemm_phase<pg8::EpiConv, pg8::SplitLastOrder, true, true>(lds, lds + XL_OFF, g, S, E);
            if (XTRA_HOTG2) { pg8::Gemm g2{opq(MIX), opq(WOUT + (size_t)l * DM * DM), MROWS, DM, DM}; pg8::StaticOrder S2; S2.init(MROWS, DM, G, bx);
                pg8::EpiRes E2{(bf16_t*)UU, (unsigned long long*)(UU + (size_t)MROWS * DM)}; pg8::gemm_phase<pg8::EpiRes, pg8::StaticOrder, true, true>(lds, lds + XL_OFF, g2, S2, E2); }
        }
        SEAM(pb + 9);
        if (INL(10)) {
            PHASE_LOCALS
            const float* cw = conv_w + (size_t)l * 3 * NUP; const float* cbp = conv_b + (size_t)l * NUP;
            for (int rep = 0; rep < REP_SMALL; ++rep)
            for (int task = bx * NTHREADS + tid; task < 128 * (DFF / 4); task += G * NTHREADS) {
                const int cq = task % (DFF / 4), rt = task / (DFF / 4), pm = rt >> 1, which = rt & 1, c = cq * 4;
                const bool is_start = (pm % 8 == 0) && (pm <= 32), is_end = ((pm % 8 == 7) && (pm < 32)) || (pm == 63);
                const float* hp; const float* hc; const float* hn; bool zp = false, zn = false;
                if (which == 0) { hp = HB + (size_t)((pm > 0 ? pm - 1 : 0) * 4 + 3) * NUP; zp = is_start; hc = HB + (size_t)(pm * 4 + 0) * NUP; hn = HB + (size_t)(pm * 4 + 1) * NUP; }
                else { hp = HB + (size_t)(pm * 4 + 2) * NUP; hc = HB + (size_t)(pm * 4 + 3) * NUP; hn = HB + (size_t)((pm < 63 ? pm + 1 : 63) * 4 + 0) * NUP; zn = is_end; }
                const f32x4 z4 = {0.f, 0.f, 0.f, 0.f};
                const f32x4 pa = zp ? z4 : *(const f32x4*)(hp + c), pu = zp ? z4 : *(const f32x4*)(hp + DFF + c);
                const f32x4 ca = *(const f32x4*)(hc + c), cu = *(const f32x4*)(hc + DFF + c);
                const f32x4 na = zn ? z4 : *(const f32x4*)(hn + c), nu = zn ? z4 : *(const f32x4*)(hn + DFF + c);
                const f32x4 va = *(const f32x4*)(cw + c) * pa + *(const f32x4*)(cw + NUP + c) * ca + *(const f32x4*)(cw + 2 * NUP + c) * na + *(const f32x4*)(cbp + c);
                const f32x4 vu = *(const f32x4*)(cw + DFF + c) * pu + *(const f32x4*)(cw + NUP + DFF + c) * cu + *(const f32x4*)(cw + 2 * NUP + DFF + c) * nu + *(const f32x4*)(cbp + DFF + c);
                const f32x2 g0 = pg8::gelu_pk((f32x2){va[0], va[1]}), g1 = pg8::gelu_pk((f32x2){va[2], va[3]});
                u32x2 w; w.x = cvt_pk_bf16(g0.x * vu[0], g0.y * vu[1]); w.y = cvt_pk_bf16(g1.x * vu[2], g1.y * vu[3]);
                *(u32x2*)(GH + (size_t)(pm * 256 + (which ? 255 : 0)) * DFF + c) = w;
            }
        }
        SEAM(pb + 10);
        if (INL(11)) {
            PHASE_LOCALS
            pg8::Gemm g{opq(GH), opq(WDOWN + (size_t)l * DM * DFF), MROWS, DM, DFF}; pg8::StaticOrder S; S.init(MROWS, DM, G, bx, 1);
            if (XTRA_G6) { pg8::EpiRes E2{(bf16_t*)UU, (unsigned long long*)HB}; pg8::gemm_phase<pg8::EpiRes, pg8::StaticOrder, true, true>(lds, lds + XL_OFF, g, S, E2); }
            if (FUSE_FINAL && l == 1) { pg8::EpiResFinal E{XB, SSQ + (3 * l + 3) * MROWS, ctl + CW_FIN, norm_final, XRES}; pg8::gemm_phase<pg8::EpiResFinal, pg8::StaticOrder, true, true>(lds, lds + XL_OFF, g, S, E); }
            else { pg8::EpiRes E{XB, SSQ + (3 * l + 3) * MROWS}; pg8::gemm_phase<pg8::EpiRes, pg8::StaticOrder, true, true>(lds, lds + XL_OFF, g, S, E); }
        }
        if (!(FUSE_FINAL && l == 1)) SEAM(pb + 11);
    }
    if (N_LAUNCHES == 1) for (int i = 0; i < XTRA_BARS; ++i) xcd_barrier(bar);
    if (INF && !FUSE_FINAL) {
        PHASE_LOCALS
        for (int rep = 0; rep < REP_SMALL; ++rep)
        for (int m = gw; m < MROWS; m += NGW) { const float rs = __builtin_amdgcn_rsqf((float)SSQ[6 * MROWS + m] * (1.0f / 1048576.0f / 4096.0f) + EPS);
            const u32x4* xr = (const u32x4*)(XB + (size_t)m * DM) + lane; f32x4* orow = (f32x4*)(XRES + (size_t)m * DM); const f32x4* gp = (const f32x4*)norm_final;
#pragma unroll
            for (int j = 0; j < 8; ++j) { const u32x4 x = __builtin_nontemporal_load(xr + 64 * j); const int c4 = (64 * j + lane) * 2;
                const f32x4 g0 = gp[c4], g1 = gp[c4 + 1];
                __builtin_nontemporal_store((f32x4){bf_lo(x.x), bf_hi(x.x), bf_lo(x.y), bf_hi(x.y)} * rs * g0, orow + c4);
                __builtin_nontemporal_store((f32x4){bf_lo(x.z), bf_hi(x.z), bf_lo(x.w), bf_hi(x.w)} * rs * g1, orow + c4 + 1); } }
    }
    if (PT_MASK) { PT_MARK(13, 0); if (bx == 0) { const unsigned long long until_ = wall_clock64() + (unsigned long long)PT_K * pt_acc; while (wall_clock64() < until_) __builtin_amdgcn_s_sleep(8); } }
#undef INR
#undef SEAM
}

extern "C" void kernel_launch(void* const* d_in, const int* in_sizes, int n_in, void* d_out, int out_size, void* d_ws, size_t ws_size, hipStream_t stream) {
    static int grid = 0;
    if (grid == 0) {
        if (n_in != 21 || out_size != MROWS * DM || ws_size < WS_END) { fprintf(stderr, "kernel_launch: unexpected shapes: n_in %d out %d ws %zu (need %zu)\n", n_in, out_size, ws_size, (size_t)WS_END); grid = -1; return; }
        int dev = 0, cus = 0, per_cu = 0;
        if (hipGetDevice(&dev) != hipSuccess || hipDeviceGetAttribute(&cus, hipDeviceAttributeMultiprocessorCount, dev) != hipSuccess) { grid = -1; return; }
        if (hipFuncSetAttribute((const void*)trunk_fwd, hipFuncAttributeMaxDynamicSharedMemorySize, LDS_BYTES) != hipSuccess) { fprintf(stderr, "kernel_launch: hipFuncSetAttribute failed\n"); grid = -1; return; }
        if (hipOccupancyMaxActiveBlocksPerMultiprocessor(&per_cu, (const void*)trunk_fwd, NTHREADS, LDS_BYTES) != hipSuccess || per_cu < 1) fprintf(stderr, "kernel_launch: occupancy query reports %d blocks per CU\n", per_cu);
        (void)hipGetLastError();
        grid = cus;
    }
    if (grid < 0) return;
    if (hipMemsetAsync((char*)d_ws + WS_CTL, 0, CTL_ZERO_BYTES, stream) != hipSuccess) { fprintf(stderr, "kernel_launch: memset failed\n"); return; }
    Args a{};
    for (int i = 0; i < 21; ++i) a.in[i] = (const float*)d_in[i];
    a.out = (float*)d_out; a.ws = (unsigned char*)d_ws;
    if (N_LAUNCHES == 1) { a.ph_lo = 0; a.ph_hi = NPHASES; hipLaunchKernelGGL(trunk_fwd, dim3(grid), dim3(NTHREADS), LDS_BYTES, stream, a); }
    else for (int p = 0; p < NPHASES; ++p) { a.ph_lo = p; a.ph_hi = p + 1; hipLaunchKernelGGL(trunk_fwd, dim3(grid), dim3(NTHREADS), LDS_BYTES, stream, a); }
    const hipError_t le = hipPeekAtLastError();
    if (le != hipSuccess) fprintf(stderr, "kernel_launch: launch failed: %s\n", hipGetErrorName(le));
}
```

```cpp
#include <hip/hip_runtime.h>
#include <cstdio>
#include <cstdint>

#define GAS __attribute__((address_space(1)))
#define LAS __attribute__((address_space(3)))
typedef unsigned short bf16_t;
typedef short bf16x8 __attribute__((ext_vector_type(8)));
typedef short s16x4 __attribute__((ext_vector_type(4)));
typedef float f32x4 __attribute__((ext_vector_type(4)));
typedef float f32x2 __attribute__((ext_vector_type(2)));
typedef float f32x16 __attribute__((ext_vector_type(16)));
typedef unsigned u32x4 __attribute__((ext_vector_type(4)));
typedef unsigned u32x2 __attribute__((ext_vector_type(2)));

constexpr int DM = 4096, MROWS = 16384, NIN = 11264, DFF = 11008, NUP = 22016, MEMROWS = 1280, MEMW = 512;
constexpr float EPS = 1e-6f;
#ifndef MK_N_LAUNCHES
#define MK_N_LAUNCHES 1
#endif

__device__ __forceinline__ unsigned cvt_pk_bf16(float lo, float hi) { unsigned r; asm volatile("v_cvt_pk_bf16_f32 %0, %1, %2" : "=v"(r) : "v"(lo), "v"(hi)); return r; }
__device__ __forceinline__ float bf_lo(unsigned w) { return __uint_as_float(w << 16); }
__device__ __forceinline__ float bf_hi(unsigned w) { return __uint_as_float(w & 0xffff0000u); }
__device__ __forceinline__ float bf2f(bf16_t b) { return __uint_as_float(((unsigned)b) << 16); }
__device__ __forceinline__ bf16_t f2bf(float f) { return (bf16_t)(cvt_pk_bf16(f, 0.f) & 0xffffu); }

#ifndef PT_EPI
#define PT_EPI 0
#endif
namespace pg8 {
#define PG8_LAS __attribute__((address_space(3)))
constexpr int BM = 256, BK = 64, HALF = 128, HTB = HALF * BK * 2  , STAGE_BYTES = 8 * HTB, NXCD = 8, WGM = 8;

__host__ __device__ __forceinline__ int lds_byte(int r, int c) { const int st = (r >> 4) * 2 + (c >> 5), rr = r & 15, cc = c & 31, ob = rr * 64 + cc * 2; return st * 1024 + (ob ^ (((ob >> 9) & 1) << 5)); }
__host__ __device__ __forceinline__ void stage_rc(int b, int& R, int& C) { const int st = b / 1024, sb = b % 1024, swz = sb ^ (((sb >> 9) & 1) << 5); R = (st >> 1) * 16 + swz / 64; C = (st & 1) * 32 + (swz % 64) / 2; }
__host__ __device__ __forceinline__ int perm32(int rho) { const int n = rho >> 4, i = rho & 15; return 8 * (i >> 2) + 4 * n + (i & 3); }

struct Unit { int pm, pn, kt0, nkt, fin; };
struct Gemm { const bf16_t* A; const bf16_t* Bt; int M, N, K; };

struct StaticOrder {
    int nM, nN, nwg, G, c, pn_inner;
    __host__ __device__ void init(int M, int N, int G_, int c_, int pn_inner_ = 0) { nM = M / BM; nN = N / BM; nwg = nM * nN; G = G_; c = c_; pn_inner = pn_inner_; }
    __host__ __device__ bool next(int i, Unit& u) const { return map((long)i * G + c, u); }
    __host__ __device__ bool map(long L, Unit& u) const {
        if (L >= nwg) return false;
        int wgid = (int)L; { const int q = nwg / NXCD, r = nwg % NXCD, xcd = wgid % NXCD, off = wgid / NXCD; wgid = (xcd < r ? xcd * (q + 1) : r * (q + 1) + (xcd - r) * q) + off; }
        const int nig = WGM * nN, gid = wgid / nig, fm = gid * WGM, gsz = (nM - fm) < WGM ? (nM - fm) : WGM;
        if (pn_inner) { u.pm = fm + ((wgid % nig) / nN); u.pn = (wgid % nig) % nN; } else { u.pm = fm + ((wgid % nig) % gsz); u.pn = (wgid % nig) / gsz; }
        u.kt0 = 0; u.nkt = 0; u.fin = 1; return true;
    }
    __device__ __forceinline__ void a_ready(const Unit&) const {}
    __device__ __forceinline__ void done(const Unit&) const {}
};

struct AliasOrder : StaticOrder {
    int am, an;
    __device__ bool next(int i, Unit& u) const { const bool r = StaticOrder::next(i, u); u.pm &= am; u.pn &= an; return r; }
};
struct SplitLastOrder : StaticOrder {
    int full, ntl;
    __device__ bool next(int i, Unit& u) const {
        if (i < full) return StaticOrder::next(i, u);
        if (i > full) return false;
        const int half = G / 2, cc = c < half ? c : c - half;
        if (!map((long)full * G + cc, u)) return false;
        u.nkt = ntl / 2; u.kt0 = c < half ? 0 : ntl / 2; u.fin = c < half ? 2 : 3; return true;
    }
};

#define SPLITK_HANDOFF() \
    if (u.fin == 3) { \
            f32x4* dst = (f32x4*)scr + ((size_t)slot * 32) * 512 + (((wr * 4 + wc) * 4 + fq) * 16 + fr); \
_Pragma("unroll") \
            for (int ai = 0; ai < 2; ++ai) \
_Pragma("unroll") \
                for (int bj = 0; bj < 2; ++bj) \
_Pragma("unroll") \
                    for (int m = 0; m < 4; ++m) \
_Pragma("unroll") \
                        for (int n = 0; n < 2; ++n) { const int k = ((ai * 2 + bj) * 4 + m) * 2 + n; f32x4* p = dst + (size_t)k * 512; \
                            asm volatile("global_store_dwordx4 %0, %1, off sc1" :: "v"(p), "v"(acc[ai][bj][m][n]) : "memory"); } \
            asm volatile("s_waitcnt vmcnt(0)" ::: "memory"); __builtin_amdgcn_s_barrier(); asm volatile("" ::: "memory"); \
            if (wr == 0 && wc == 0 && fq == 0 && fr == 0) __hip_atomic_store(flag + slot * 16, 1u, __ATOMIC_RELAXED, __HIP_MEMORY_SCOPE_AGENT); \
            return; \
        } \
    if (u.fin == 2) { \
            if (wr == 0 && wc == 0) { unsigned sp = 0; \
                while ((unsigned)__builtin_amdgcn_readfirstlane(__hip_atomic_load(flag + slot * 16, __ATOMIC_RELAXED, __HIP_MEMORY_SCOPE_AGENT)) == 0u) { __builtin_amdgcn_s_sleep(2); if (++sp > (1u << 20)) break; } \
                __builtin_amdgcn_fence(__ATOMIC_ACQUIRE, "agent"); asm volatile("s_waitcnt vmcnt(0)" ::: "memory"); } \
            asm volatile("" ::: "memory"); __builtin_amdgcn_s_barrier(); asm volatile("" ::: "memory"); \
            const f32x4* src = (const f32x4*)scr + ((size_t)slot * 32) * 512 + (((wr * 4 + wc) * 4 + fq) * 16 + fr); \
_Pragma("unroll") \
            for (int g8 = 0; g8 < 4; ++g8) { f32x4 tp[8]; \
_Pragma("unroll") \
                for (int k8 = 0; k8 < 8; ++k8) tp[k8] = src[(size_t)(g8 * 8 + k8) * 512]; \
                asm volatile("" : "+v"(tp[0]), "+v"(tp[1]), "+v"(tp[2]), "+v"(tp[3]), "+v"(tp[4]), "+v"(tp[5]), "+v"(tp[6]), "+v"(tp[7])); \
_Pragma("unroll") \
                for (int k8 = 0; k8 < 8; ++k8) { const int k = g8 * 8 + k8; acc[k >> 4][(k >> 3) & 1][(k >> 1) & 3][k & 1] += tp[k8]; } } \
        }

__device__ __forceinline__ f32x2 gelu_pk(f32x2 v) {
    const f32x2 av = __builtin_elementwise_abs(v), d = av * 0.2316418882f + 1.0f;
    f32x2 t; t.x = __builtin_amdgcn_rcpf(d.x); t.y = __builtin_amdgcn_rcpf(d.y);
    f32x2 q = t * 0.5307027145f + (-0.7265760135f); q = q * t + 0.7107068705f; q = q * t + (-0.142248368f); q = q * t + 0.127414796f; q = q * t;
    const f32x2 s = (v * v) * (-0.72134752044f);
    f32x2 e; e.x = __builtin_amdgcn_exp2f(s.x); e.y = __builtin_amdgcn_exp2f(s.y);
    const f32x2 m = v * (q * e), r = v - m;
    f32x2 o; o.x = v.x < 0.f ? m.x : r.x; o.y = v.y < 0.f ? m.y : r.y; return o;
}

struct EpiProj {
    static constexpr bool PERM = true, AFTER_DRAIN = false;
    bf16_t* O; int ldc; const unsigned long long* ssq; const float* ssqf;
    unsigned long long* scr; unsigned* flag; int slot;
    __device__ __forceinline__ void operator()(f32x4 (&acc)[2][2][4][2], const Unit& u, int wr, int wc, int fr_, int fq_, PG8_LAS unsigned char*) const {
        int fr = fr_, fq = fq_; asm volatile("" : "+v"(fr), "+v"(fq));
        SPLITK_HANDOFF()
        const int row0 = u.pm * BM + wr * 64 + fr, col0 = u.pn * BM + wc * 32 + 8 * fq;
        float rsv[8];
        if (ssq) { unsigned long long q[8];
#pragma unroll
            for (int k = 0; k < 8; ++k) q[k] = ssq[row0 + (k >> 2) * HALF + (k & 3) * 16];
            asm volatile("" : "+v"(q[0]), "+v"(q[1]), "+v"(q[2]), "+v"(q[3]), "+v"(q[4]), "+v"(q[5]), "+v"(q[6]), "+v"(q[7]));
#pragma unroll
            for (int k = 0; k < 8; ++k) rsv[k] = __builtin_amdgcn_rsqf((float)q[k] * (1.0f / 1048576.0f / 4096.0f) + EPS);
        } else { float q[8];
#pragma unroll
            for (int k = 0; k < 8; ++k) q[k] = ssqf[row0 + (k >> 2) * HALF + (k & 3) * 16];
            asm volatile("" : "+v"(q[0]), "+v"(q[1]), "+v"(q[2]), "+v"(q[3]), "+v"(q[4]), "+v"(q[5]), "+v"(q[6]), "+v"(q[7]));
#pragma unroll
            for (int k = 0; k < 8; ++k) rsv[k] = __builtin_amdgcn_rsqf(q[k] * (1.0f / 4096.0f) + EPS);
        }
#pragma unroll
        for (int ai = 0; ai < 2; ++ai)
#pragma unroll
            for (int m = 0; m < 4; ++m) { const int row = row0 + ai * HALF + m * 16; const float rs = rsv[ai * 4 + m];
                bf16_t* rowp = O + (size_t)row * ldc + col0;
#pragma unroll
                for (int bj = 0; bj < 2; ++bj) { const f32x4 v0 = acc[ai][bj][m][0] * rs, v1 = acc[ai][bj][m][1] * rs;
                    u32x4 w; w.x = cvt_pk_bf16(v0[0], v0[1]); w.y = cvt_pk_bf16(v0[2], v0[3]); w.z = cvt_pk_bf16(v1[0], v1[1]); w.w = cvt_pk_bf16(v1[2], v1[3]);
                    *(u32x4*)(rowp + bj * HALF) = w; } }
    }
};
struct EpiNull {
    static constexpr bool PERM = true, AFTER_DRAIN = false;
    float* sink;
    __device__ __forceinline__ void operator()(f32x4 (&acc)[2][2][4][2], const Unit& u, int wr, int wc, int fr, int fq, PG8_LAS unsigned char*) const {
        float s = 0.f;
#pragma unroll
        for (int ai = 0; ai < 2; ++ai)
#pragma unroll
            for (int bj = 0; bj < 2; ++bj)
#pragma unroll
                for (int m = 0; m < 4; ++m)
#pragma unroll
                    for (int n = 0; n < 2; ++n) s += acc[ai][bj][m][n][0] + acc[ai][bj][m][n][1] + acc[ai][bj][m][n][2] + acc[ai][bj][m][n][3];
        if (s == 123456.789f) sink[u.pm + wr + wc + fr + fq] = s;
    }
};
struct EpiProjRope {
    static constexpr bool PERM = true, AFTER_DRAIN = false;
    bf16_t* O; const unsigned long long* ssq; const f32x2* rope; const float* qn; const float* kn;
    __device__ __forceinline__ void operator()(f32x4 (&acc)[2][2][4][2], const Unit& u, int wr, int wc, int fr_, int fq_, PG8_LAS unsigned char* xl) const {
        int fr = fr_, fq = fq_; asm volatile("" : "+v"(fr), "+v"(fq));
        const int row0 = u.pm * BM + wr * 64 + fr, col0 = u.pn * BM + wc * 32 + 8 * fq;
        const int kind = u.pn < 16 ? 1 : (u.pn >= 32 && u.pn < 42 ? 2 : 0);
        const int qp = 4 * wc + fq, hf = qp >> 3, fi = 4 * (qp & 7);
        float rsv[8];
        { unsigned long long q[8];
#pragma unroll
            for (int k = 0; k < 8; ++k) q[k] = ssq[row0 + (k >> 2) * HALF + (k & 3) * 16];
            asm volatile("" : "+v"(q[0]), "+v"(q[1]), "+v"(q[2]), "+v"(q[3]), "+v"(q[4]), "+v"(q[5]), "+v"(q[6]), "+v"(q[7]));
#pragma unroll
            for (int k = 0; k < 8; ++k) rsv[k] = __builtin_amdgcn_rsqf((float)q[k] * (1.0f / 1048576.0f / 4096.0f) + EPS); }
#pragma unroll
        for (int ai = 0; ai < 2; ++ai)
#pragma unroll
            for (int m = 0; m < 4; ++m) { const float rs = rsv[ai * 4 + m];
#pragma unroll
                for (int bj = 0; bj < 2; ++bj) { acc[ai][bj][m][0] *= rs; acc[ai][bj][m][1] *= rs; } }
        if (kind == 2) {
            PG8_LAS float* PART = (PG8_LAS float*)xl;
#pragma unroll
            for (int ai = 0; ai < 2; ++ai)
#pragma unroll
                for (int m = 0; m < 4; ++m)
#pragma unroll
                    for (int bj = 0; bj < 2; ++bj) { const f32x4 a = acc[ai][bj][m][0], b = acc[ai][bj][m][1];
                        float s = ((a[0] * a[0] + a[1] * a[1]) + (a[2] * a[2] + a[3] * a[3])) + ((b[0] * b[0] + b[1] * b[1]) + (b[2] * b[2] + b[3] * b[3]));
                        s += __shfl_xor(s, 16); s += __shfl_xor(s, 32);
                        if (fq == 0) PART[((ai * HALF + wr * 64 + m * 16 + fr) * 2 + bj) * 4 + wc] = s; }
            asm volatile("s_waitcnt lgkmcnt(0)" ::: "memory"); __builtin_amdgcn_s_barrier(); asm volatile("" ::: "memory");
            const float* gn = (u.pn < 40) ? qn : kn;
            const f32x4 g0 = *(const f32x4*)(gn + 64 * hf + fi), g1 = *(const f32x4*)(gn + 64 * hf + fi + 32);
#pragma unroll
            for (int ai = 0; ai < 2; ++ai)
#pragma unroll
                for (int m = 0; m < 4; ++m)
#pragma unroll
                    for (int bj = 0; bj < 2; ++bj) { const f32x4 ps = *(const PG8_LAS f32x4*)(PART + ((ai * HALF + wr * 64 + m * 16 + fr) * 2 + bj) * 4);
                        const float rh = __builtin_amdgcn_rsqf(((ps[0] + ps[1]) + (ps[2] + ps[3])) * (1.0f / 128.0f) + EPS);
                        acc[ai][bj][m][0] *= g0 * rh; acc[ai][bj][m][1] *= g1 * rh; }
        }
        f32x4 csa[8][2];
        if (kind != 0) {
#pragma unroll
            for (int k = 0; k < 8; ++k) { const int row = row0 + (k >> 2) * HALF + (k & 3) * 16; const int t = row < 8192 ? (row & 2047) : (row - 8192); const int pos = hf ? (t & 63) : (t >> 6);
                const f32x4* rp = (const f32x4*)(rope + pos * 32 + fi); csa[k][0] = rp[0]; csa[k][1] = rp[1]; }
            asm volatile("" : "+v"(csa[0][0]), "+v"(csa[0][1]), "+v"(csa[1][0]), "+v"(csa[1][1]), "+v"(csa[2][0]), "+v"(csa[2][1]), "+v"(csa[3][0]), "+v"(csa[3][1]));
            asm volatile("" : "+v"(csa[4][0]), "+v"(csa[4][1]), "+v"(csa[5][0]), "+v"(csa[5][1]), "+v"(csa[6][0]), "+v"(csa[6][1]), "+v"(csa[7][0]), "+v"(csa[7][1]));
        }
#pragma unroll
        for (int ai = 0; ai < 2; ++ai)
#pragma unroll
            for (int m = 0; m < 4; ++m) { const int row = row0 + ai * HALF + m * 16;
                bf16_t* rowp = O + (size_t)row * NIN + col0;
                f32x4 cs0 = {1.f, 0.f, 1.f, 0.f}, cs1 = cs0;
                if (kind != 0) { cs0 = csa[ai * 4 + m][0]; cs1 = csa[ai * 4 + m][1]; }
#pragma unroll
                for (int bj = 0; bj < 2; ++bj) { f32x4 v0 = acc[ai][bj][m][0], v1 = acc[ai][bj][m][1];
                    if (kind != 0) { const f32x4 c = {cs0[0], cs0[2], cs1[0], cs1[2]}, s = {cs0[1], cs0[3], cs1[1], cs1[3]};
                        const f32x4 y0 = v0 * c - v1 * s, y1 = v1 * c + v0 * s; v0 = y0; v1 = y1; }
                    u32x4 w; w.x = cvt_pk_bf16(v0[0], v0[1]); w.y = cvt_pk_bf16(v0[2], v0[3]); w.z = cvt_pk_bf16(v1[0], v1[1]); w.w = cvt_pk_bf16(v1[2], v1[3]);
                    __builtin_nontemporal_store(w, (u32x4*)(rowp + bj * HALF)); } }
    }
};
struct EpiRes {
    static constexpr bool PERM = true, AFTER_DRAIN = false;
    bf16_t* xb; unsigned long long* ssq_out;
    __device__ __forceinline__ void operator()(f32x4 (&acc)[2][2][4][2], const Unit& u, int wr, int wc, int fr_, int fq_, PG8_LAS unsigned char*) const {
        int fr = fr_, fq = fq_; asm volatile("" : "+v"(fr), "+v"(fq));
        const int row0 = u.pm * BM + wr * 64 + fr, col0 = u.pn * BM + wc * 32 + 8 * fq;
        u32x4 xv[2][4][2];
#pragma unroll
        for (int ai = 0; ai < 2; ++ai)
#pragma unroll
            for (int m = 0; m < 4; ++m)
#pragma unroll
                for (int bj = 0; bj < 2; ++bj) xv[ai][m][bj] = *(const u32x4*)(xb + (size_t)(row0 + ai * HALF + m * 16) * DM + col0 + bj * HALF);
        asm volatile("" : "+v"(xv[0][0][0]), "+v"(xv[0][0][1]), "+v"(xv[0][1][0]), "+v"(xv[0][1][1]), "+v"(xv[0][2][0]), "+v"(xv[0][2][1]), "+v"(xv[0][3][0]), "+v"(xv[0][3][1]));
        asm volatile("" : "+v"(xv[1][0][0]), "+v"(xv[1][0][1]), "+v"(xv[1][1][0]), "+v"(xv[1][1][1]), "+v"(xv[1][2][0]), "+v"(xv[1][2][1]), "+v"(xv[1][3][0]), "+v"(xv[1][3][1]));
#pragma unroll
        for (int ai = 0; ai < 2; ++ai) {
#pragma unroll
            for (int m = 0; m < 4; ++m) { const int row = row0 + ai * HALF + m * 16; bf16_t* rowp = xb + (size_t)row * DM + col0; float s = 0.f;
#pragma unroll
                for (int bj = 0; bj < 2; ++bj) { const u32x4 x = xv[ai][m][bj];
                    const f32x4 v0 = (f32x4){bf_lo(x.x), bf_hi(x.x), bf_lo(x.y), bf_hi(x.y)} + acc[ai][bj][m][0], v1 = (f32x4){bf_lo(x.z), bf_hi(x.z), bf_lo(x.w), bf_hi(x.w)} + acc[ai][bj][m][1];
                    u32x4 w; w.x = cvt_pk_bf16(v0[0], v0[1]); w.y = cvt_pk_bf16(v0[2], v0[3]); w.z = cvt_pk_bf16(v1[0], v1[1]); w.w = cvt_pk_bf16(v1[2], v1[3]);
                    *(u32x4*)(rowp + bj * HALF) = w;
                    s += ((v0[0] * v0[0] + v0[1] * v0[1]) + (v0[2] * v0[2] + v0[3] * v0[3])) + ((v1[0] * v1[0] + v1[1] * v1[1]) + (v1[2] * v1[2] + v1[3] * v1[3])); }
                s += __shfl_xor(s, 16); s += __shfl_xor(s, 32);
                if (fq == 0) __hip_atomic_fetch_add(ssq_out + row, (unsigned long long)(s * 1048576.0f + 0.5f), __ATOMIC_RELAXED, __HIP_MEMORY_SCOPE_AGENT); }
            asm volatile("" ::: "memory");
        }
    }
};
struct EpiResFinal {
    static constexpr bool PERM = true, AFTER_DRAIN = false;
    const bf16_t* xb; unsigned long long* ssq; unsigned* cnt; const float* gain; float* out;
    __device__ __forceinline__ void operator()(f32x4 (&acc)[2][2][4][2], const Unit& u, int wr, int wc, int fr_, int fq_, PG8_LAS unsigned char* xl) const {
        int fr = fr_, fq = fq_; asm volatile("" : "+v"(fr), "+v"(fq));
        const int row0 = u.pm * BM + wr * 64 + fr, col0 = u.pn * BM + wc * 32 + 8 * fq;
#pragma unroll
        for (int ai = 0; ai < 2; ++ai) {
            u32x4 xv[4][2];
#pragma unroll
            for (int m = 0; m < 4; ++m)
#pragma unroll
                for (int bj = 0; bj < 2; ++bj) xv[m][bj] = *(const u32x4*)(xb + (size_t)(row0 + ai * HALF + m * 16) * DM + col0 + bj * HALF);
#pragma unroll
            for (int m = 0; m < 4; ++m) { const int row = row0 + ai * HALF + m * 16; float s = 0.f;
#pragma unroll
                for (int bj = 0; bj < 2; ++bj) { const u32x4 x = xv[m][bj];
                    const f32x4 v0 = (f32x4){bf_lo(x.x), bf_hi(x.x), bf_lo(x.y), bf_hi(x.y)} + acc[ai][bj][m][0], v1 = (f32x4){bf_lo(x.z), bf_hi(x.z), bf_lo(x.w), bf_hi(x.w)} + acc[ai][bj][m][1];
                    acc[ai][bj][m][0] = v0; acc[ai][bj][m][1] = v1;
                    s += ((v0[0] * v0[0] + v0[1] * v0[1]) + (v0[2] * v0[2] + v0[3] * v0[3])) + ((v1[0] * v1[0] + v1[1] * v1[1]) + (v1[2] * v1[2] + v1[3] * v1[3])); }
                s += __shfl_xor(s, 16); s += __shfl_xor(s, 32);
                if (fq == 0) __hip_atomic_fetch_add(ssq + row, (unsigned long long)(s * 1048576.0f + 0.5f), __ATOMIC_RELAXED, __HIP_MEMORY_SCOPE_AGENT); }
            asm volatile("" ::: "memory");
        }
        f32x4 g[2][2];
#pragma unroll
        for (int bj = 0; bj < 2; ++bj) { g[bj][0] = *(const f32x4*)(gain + col0 + bj * HALF); g[bj][1] = *(const f32x4*)(gain + col0 + bj * HALF + 4); }
        asm volatile("s_waitcnt vmcnt(0)" ::: "memory"); __builtin_amdgcn_s_barrier(); asm volatile("" ::: "memory");
        PG8_LAS float* RS = (PG8_LAS float*)xl;
        if (wr == 0 && wc == 0) {
            unsigned* c = cnt + u.pm * 16;
            if (fq == 0 && fr == 0) __hip_atomic_fetch_add(c, 1u, __ATOMIC_RELAXED, __HIP_MEMORY_SCOPE_AGENT);
            unsigned sp = 0;
            while ((unsigned)__builtin_amdgcn_readfirstlane(__hip_atomic_load(c, __ATOMIC_RELAXED, __HIP_MEMORY_SCOPE_AGENT)) < 16u) { __builtin_amdgcn_s_sleep(2); if (++sp > (1u << 20)) break; }
            __builtin_amdgcn_fence(__ATOMIC_ACQUIRE, "agent");
            const unsigned long long* p = ssq + u.pm * BM + (fq * 16 + fr); unsigned long long s0, s1, s2, s3;
            asm volatile("global_load_dwordx2 %0, %4, off sc1\n\tglobal_load_dwordx2 %1, %4, off offset:512 sc1\n\tglobal_load_dwordx2 %2, %4, off offset:1024 sc1\n\tglobal_load_dwordx2 %3, %4, off offset:1536 sc1\n\ts_waitcnt vmcnt(0)"
                         : "=&v"(s0), "=&v"(s1), "=&v"(s2), "=&v"(s3) : "v"(p) : "memory");
            const int l64 = fq * 16 + fr;
            RS[l64] = __builtin_amdgcn_rsqf((float)s0 * (1.0f / 1048576.0f / 4096.0f) + EPS); RS[64 + l64] = __builtin_amdgcn_rsqf((float)s1 * (1.0f / 1048576.0f / 4096.0f) + EPS);
            RS[128 + l64] = __builtin_amdgcn_rsqf((float)s2 * (1.0f / 1048576.0f / 4096.0f) + EPS); RS[192 + l64] = __builtin_amdgcn_rsqf((float)s3 * (1.0f / 1048576.0f / 4096.0f) + EPS);
        }
        __syncthreads();
#pragma unroll
        for (int ai = 0; ai < 2; ++ai)
#pragma unroll
            for (int m = 0; m < 4; ++m) { const int rt = wr * 64 + fr + ai * HALF + m * 16; const float rs = RS[rt]; float* rowp = out + (size_t)(u.pm * BM + rt) * DM + col0;
#pragma unroll
                for (int bj = 0; bj < 2; ++bj) { __builtin_nontemporal_store(acc[ai][bj][m][0] * rs * g[bj][0], (f32x4*)(rowp + bj * HALF)); __builtin_nontemporal_store(acc[ai][bj][m][1] * rs * g[bj][1], (f32x4*)(rowp + bj * HALF + 4)); } }
    }
};
struct EpiConv {
    static constexpr bool PERM = true, AFTER_DRAIN = false;
    unsigned char* ws; size_t gh_off, hb_off, ssq_off; const float* cw; const float* cb; unsigned long long* scr; unsigned* flag; int slot;
    __device__ __forceinline__ void operator()(f32x4 (&acc)[2][2][4][2], const Unit& u, int wr, int wc, int fr_, int fq_, PG8_LAS unsigned char* xl) const {
        int fr = fr_, fq = fq_; asm volatile("" : "+v"(fr), "+v"(fq));
        PG8_LAS float* BND = (PG8_LAS float*)xl;
        bf16_t* GH = (bf16_t*)(ws + gh_off); float* HB = (float*)(ws + hb_off); const unsigned long long* ssq = (const unsigned long long*)(ws + ssq_off);
        const int colw = wc * 32 + 8 * fq;
        SPLITK_HANDOFF()
        PG8_LAS float* CW = (PG8_LAS float*)(xl + 8192);
        const int cwi = (((wr * 4 + wc) * 4 + fq) * 16 + fr) * 2, cwa = cwi >> 8, cwh = (cwi >> 7) & 1, cwc = cwi & 127;
        const f32x2 cwreg = *(const f32x2*)((cwa < 3 ? cw + cwa * NUP : cb) + cwh * DFF + u.pn * 128 + cwc);
        float rsv[8];
        { unsigned long long q[8]; const int row0 = u.pm * BM + wr * 64 + fr;
#pragma unroll
            for (int k = 0; k < 8; ++k) q[k] = ssq[row0 + (k >> 2) * HALF + (k & 3) * 16];
            asm volatile("" : "+v"(q[0]), "+v"(q[1]), "+v"(q[2]), "+v"(q[3]), "+v"(q[4]), "+v"(q[5]), "+v"(q[6]), "+v"(q[7]));
#pragma unroll
            for (int k = 0; k < 8; ++k) rsv[k] = __builtin_amdgcn_rsqf((float)q[k] * (1.0f / 1048576.0f / 4096.0f) + EPS); }
#pragma unroll
        for (int ai = 0; ai < 2; ++ai)
#pragma unroll
            for (int m = 0; m < 4; ++m) { const float rs = rsv[ai * 4 + m];
#pragma unroll
                for (int bj = 0; bj < 2; ++bj)
#pragma unroll
                    for (int n = 0; n < 2; ++n) acc[ai][bj][m][n] *= rs;
                asm volatile("" : "+v"(acc[ai][0][m][0]), "+v"(acc[ai][0][m][1]), "+v"(acc[ai][1][m][0]), "+v"(acc[ai][1][m][1])); }
#pragma unroll
        for (int ai = 0; ai < 2; ++ai)
#pragma unroll
            for (int bj = 0; bj < 2; ++bj)
#pragma unroll
                for (int n = 0; n < 2; ++n) {
                    if (fr == 0)  *(PG8_LAS f32x4*)(BND + ((((ai * 2 + wr) * 2 + 0) * 2 + bj) * 128) + colw + 4 * n) = acc[ai][bj][0][n];
                    if (fr == 15) *(PG8_LAS f32x4*)(BND + ((((ai * 2 + wr) * 2 + 1) * 2 + bj) * 128) + colw + 4 * n) = acc[ai][bj][3][n];
                }
        if (wr == 0 && fr < 2) {
#pragma unroll
            for (int bj = 0; bj < 2; ++bj)
#pragma unroll
                for (int n = 0; n < 2; ++n) *(f32x4*)(HB + (size_t)(u.pm * 4 + fr) * NUP + bj * DFF + u.pn * 128 + colw + 4 * n) = acc[0][bj][0][n];
        }
        if (wr == 1 && fr >= 14) {
#pragma unroll
            for (int bj = 0; bj < 2; ++bj)
#pragma unroll
                for (int n = 0; n < 2; ++n) *(f32x4*)(HB + (size_t)(u.pm * 4 + 2 + (fr - 14)) * NUP + bj * DFF + u.pn * 128 + colw + 4 * n) = acc[1][bj][3][n];
        }
        *(PG8_LAS f32x2*)(CW + cwi) = cwreg;
        asm volatile("s_waitcnt lgkmcnt(0)" ::: "memory"); __builtin_amdgcn_s_barrier(); asm volatile("" ::: "memory");
#define DPPF(oldv, srcv, ctrl) __builtin_bit_cast(float, __builtin_amdgcn_update_dpp(__builtin_bit_cast(int, (float)(oldv)), __builtin_bit_cast(int, (float)(srcv)), (ctrl), 0xf, 0xf, false))
#pragma unroll
        for (int bj = 0; bj < 2; ++bj)
#pragma unroll
            for (int n = 0; n < 2; ++n) {
                const f32x4 w0 = *(const PG8_LAS f32x4*)(CW + (0 * 2 + bj) * 128 + colw + 4 * n), w1 = *(const PG8_LAS f32x4*)(CW + (1 * 2 + bj) * 128 + colw + 4 * n), w2 = *(const PG8_LAS f32x4*)(CW + (2 * 2 + bj) * 128 + colw + 4 * n), bb = *(const PG8_LAS f32x4*)(CW + (3 * 2 + bj) * 128 + colw + 4 * n);
#pragma unroll
                for (int ai = 0; ai < 2; ++ai) {
                    f32x4 pv = {0.f, 0.f, 0.f, 0.f}, nv = pv;
                    if (wr == 1) pv = *(PG8_LAS f32x4*)(BND + ((((ai * 2 + 0) * 2 + 1) * 2 + bj) * 128) + colw + 4 * n);
                    else if (ai == 1) pv = *(PG8_LAS f32x4*)(BND + ((((0 * 2 + 1) * 2 + 1) * 2 + bj) * 128) + colw + 4 * n);
                    if (wr == 0) nv = *(PG8_LAS f32x4*)(BND + ((((ai * 2 + 1) * 2 + 0) * 2 + bj) * 128) + colw + 4 * n);
                    else if (ai == 0) nv = *(PG8_LAS f32x4*)(BND + ((((1 * 2 + 0) * 2 + 0) * 2 + bj) * 128) + colw + 4 * n);
#pragma unroll
                    for (int j = 0; j < 4; ++j) {
                        const float c0 = acc[ai][bj][0][n][j], c1 = acc[ai][bj][1][n][j], c2 = acc[ai][bj][2][n][j], c3 = acc[ai][bj][3][n][j];
                        const float u0 = DPPF(pv[j], c0, 0x111), u1 = DPPF(DPPF(0.f, c0, 0x121), c1, 0x111), u2 = DPPF(DPPF(0.f, c1, 0x121), c2, 0x111), u3 = DPPF(DPPF(0.f, c2, 0x121), c3, 0x111);
                        const float d0 = DPPF(DPPF(0.f, c1, 0x12f), c0, 0x101), d1 = DPPF(DPPF(0.f, c2, 0x12f), c1, 0x101), d2 = DPPF(DPPF(0.f, c3, 0x12f), c2, 0x101), d3 = DPPF(nv[j], c3, 0x101);
                        acc[ai][bj][0][n][j] = w0[j] * u0 + w1[j] * c0 + w2[j] * d0 + bb[j];
                        acc[ai][bj][1][n][j] = w0[j] * u1 + w1[j] * c1 + w2[j] * d1 + bb[j];
                        acc[ai][bj][2][n][j] = w0[j] * u2 + w1[j] * c2 + w2[j] * d2 + bb[j];
                        acc[ai][bj][3][n][j] = w0[j] * u3 + w1[j] * c3 + w2[j] * d3 + bb[j];
                    }
                    asm volatile("" : "+v"(acc[ai][bj][0][n]), "+v"(acc[ai][bj][1][n]), "+v"(acc[ai][bj][2][n]), "+v"(acc[ai][bj][3][n]));
                }
            }
#undef DPPF
#pragma unroll
        for (int ai = 0; ai < 2; ++ai)
#pragma unroll
            for (int m = 0; m < 4; ++m) {
                const int row = u.pm * BM + ai * HALF + wr * 64 + m * 16 + fr;
                const f32x4 a0 = acc[ai][0][m][0], a1 = acc[ai][0][m][1], u0 = acc[ai][1][m][0], u1 = acc[ai][1][m][1];
                const f32x2 g0 = gelu_pk((f32x2){a0[0], a0[1]}), g1 = gelu_pk((f32x2){a0[2], a0[3]}), g2 = gelu_pk((f32x2){a1[0], a1[1]}), g3 = gelu_pk((f32x2){a1[2], a1[3]});
                u32x4 w; w.x = cvt_pk_bf16(g0.x * u0[0], g0.y * u0[1]); w.y = cvt_pk_bf16(g1.x * u0[2], g1.y * u0[3]); w.z = cvt_pk_bf16(g2.x * u1[0], g2.y * u1[1]); w.w = cvt_pk_bf16(g3.x * u1[2], g3.y * u1[3]);
                __builtin_nontemporal_store(w, (u32x4*)(GH + (size_t)row * DFF + u.pn * 128 + colw));
            }
    }
};
template <class Epi, class Sched, bool ALIGN_EPI = false, bool SP2 = false, int BAUX = 0  >
__device__ __forceinline__ void gemm_phase(PG8_LAS unsigned char* lds, PG8_LAS unsigned char* xlds, const Gemm g, const Sched& S, const Epi& E) {
    int tid_ = threadIdx.x; asm volatile("" : "+v"(tid_)); const int tid = tid_, wid = __builtin_amdgcn_readfirstlane(tid >> 6), lane = tid & 63, wr = wid >> 2, wc = wid & 3, fr = lane & 15, fq = lane >> 4;
    const int K = g.K, nt = K / BK;
    unsigned voffA[2], voffB[2];
#pragma unroll
    for (int i = 0; i < 2; ++i) { int R, C; stage_rc(tid * 16 + i * 8192, R, C); const int Rb = Epi::PERM ? ((R & ~31) + perm32(R & 31)) : R;
        voffA[i] = (unsigned)(R * K + C) * 2u; voffB[i] = (unsigned)(Rb * K + C) * 2u; }
    const size_t kstep = (size_t)(BK * 2);
    const size_t hstep = (size_t)HALF * K * 2;
    const size_t tstep = 2 * hstep;
    const unsigned ldsw = (unsigned)wid * 1024u;
    const int aoff = lds_byte(wr * 64 + fr, fq * 8), boff = lds_byte(wc * 32 + fr, fq * 8);
#define PG8_SA(b, h) (((b) * 2 + (h)) * HTB)
#define PG8_SB(b, h) ((4 + (b) * 2 + (h)) * HTB)
#define PG8_STAGE(bufoff, gbase, voff) do { _Pragma("unroll") for (int _i = 0; _i < 2; ++_i) \
        __builtin_amdgcn_global_load_lds((const unsigned*)((const char*)(gbase) + (voff)[_i]), (PG8_LAS unsigned*)(lds + (bufoff) + ldsw + _i * 8192), 16, 0, 0); } while (0)
#define PG8_STAGEB(bufoff, gbase, voff) do { _Pragma("unroll") for (int _i = 0; _i < 2; ++_i) \
        __builtin_amdgcn_global_load_lds((const unsigned*)((const char*)(gbase) + (voff)[_i]), (PG8_LAS unsigned*)(lds + (bufoff) + ldsw + _i * 8192), 16, 0, BAUX); } while (0)
#define PG8_LDA(dst, b, h) do { _Pragma("unroll") for (int m = 0; m < 4; ++m) _Pragma("unroll") for (int k = 0; k < 2; ++k) dst[m][k] = *(const PG8_LAS bf16x8*)(lds + PG8_SA(b, h) + aoff + m * 2048 + k * 1024); } while (0)
#define PG8_LDB(dst, b, h) do { _Pragma("unroll") for (int n = 0; n < 2; ++n) _Pragma("unroll") for (int k = 0; k < 2; ++k) dst[n][k] = *(const PG8_LAS bf16x8*)(lds + PG8_SB(b, h) + boff + n * 2048 + k * 1024); } while (0)
#define PG8_MMA(ai, bj, At, Bt) do { __builtin_amdgcn_s_setprio(1); _Pragma("unroll") for (int m = 0; m < 4; ++m) _Pragma("unroll") for (int n = 0; n < 2; ++n) _Pragma("unroll") for (int k = 0; k < 2; ++k) \
        acc[ai][bj][m][n] = __builtin_amdgcn_mfma_f32_16x16x32_bf16(Bt[n][k], At[m][k], acc[ai][bj][m][n], 0, 0, 0); __builtin_amdgcn_s_setprio(0); } while (0)
#define PG8_WAIT_V(n) asm volatile("s_waitcnt vmcnt(" #n ")" ::: "memory")
#define PG8_WAIT_L(n) asm volatile("s_waitcnt lgkmcnt(" #n ")" ::: "memory")
#define PG8_BAR __builtin_amdgcn_s_barrier()
#define PG8_SCHED __builtin_amdgcn_sched_barrier(0)
    Unit cur, nxt; int ui = 0;
    if (!S.next(0, cur)) return;
    f32x4 acc[2][2][4][2];
#pragma unroll
    for (int a = 0; a < 2; ++a)
#pragma unroll
        for (int b = 0; b < 2; ++b)
#pragma unroll
            for (int m = 0; m < 4; ++m)
#pragma unroll
                for (int n = 0; n < 2; ++n) acc[a][b][m][n] = (f32x4){0.f, 0.f, 0.f, 0.f};
    bf16x8 At[4][2], B0[2][2], B1[2][2];
    const char* cA = (const char*)g.A + (size_t)cur.pm * tstep + (size_t)cur.kt0 * kstep; const char* cB = (const char*)g.Bt + (size_t)cur.pn * tstep + (size_t)cur.kt0 * kstep;
    S.a_ready(cur);
    if constexpr (SP2) {
        PG8_STAGEB(PG8_SB(0, 0), cB, voffB); PG8_STAGEB(PG8_SB(0, 1), cB + hstep, voffB); PG8_STAGE(PG8_SA(0, 0), cA, voffA); PG8_STAGE(PG8_SA(0, 1), cA + hstep, voffA);
        if (wr == 1) PG8_BAR;
        PG8_WAIT_V(2); PG8_BAR;
        PG8_STAGEB(PG8_SB(1, 0), cB + kstep, voffB); PG8_STAGE(PG8_SA(1, 0), cA + kstep, voffA); PG8_STAGEB(PG8_SB(1, 1), cB + hstep + kstep, voffB);
        PG8_WAIT_V(6); PG8_BAR;
    } else {
        PG8_STAGEB(PG8_SB(0, 0), cB, voffB); PG8_STAGE(PG8_SA(0, 0), cA, voffA); PG8_STAGEB(PG8_SB(0, 1), cB + hstep, voffB); PG8_STAGE(PG8_SA(0, 1), cA + hstep, voffA);
        if (wr == 1) PG8_BAR;
        PG8_WAIT_V(4); PG8_BAR;
        PG8_STAGEB(PG8_SB(1, 0), cB + kstep, voffB); PG8_STAGE(PG8_SA(1, 0), cA + kstep, voffA); PG8_STAGEB(PG8_SB(1, 1), cB + hstep + kstep, voffB);
        PG8_WAIT_V(6); PG8_BAR;
    }
    for (;;) {
        const bool has_next = S.next(ui + 1, nxt);
        const char* nA = has_next ? (const char*)g.A + (size_t)nxt.pm * tstep + (size_t)nxt.kt0 * kstep : cA; const char* nB = has_next ? (const char*)g.Bt + (size_t)nxt.pn * tstep + (size_t)nxt.kt0 * kstep : cB;
        const int ntu = cur.nkt ? cur.nkt : nt;
        for (int t = 0; t < ntu; t += 2) {
            const bool last = (t == ntu - 2);
            const char* a1 = cA + (size_t)(t + 1) * kstep;
            const char* a2 = last ? nA : cA + (size_t)(t + 2) * kstep; const char* b2 = last ? nB : cB + (size_t)(t + 2) * kstep;
            const char* a3 = a2 + kstep; const char* b3 = b2 + kstep;
            if (last && has_next) S.a_ready(nxt);
            if constexpr (SP2) {
            PG8_LDB(B0, 0, 0); PG8_LDB(B1, 0, 1); PG8_SCHED; PG8_LDA(At, 0, 0); PG8_STAGE(PG8_SA(1, 1), a1 + hstep, voffA);
            PG8_WAIT_V(8); PG8_WAIT_L(0); PG8_BAR; PG8_MMA(0, 0, At, B0); PG8_MMA(0, 1, At, B1); PG8_BAR; PG8_SCHED;
            PG8_LDA(At, 0, 1); PG8_STAGEB(PG8_SB(0, 0), b2, voffB); PG8_STAGEB(PG8_SB(0, 1), b2 + hstep, voffB); PG8_STAGE(PG8_SA(0, 0), a2, voffA);
            PG8_WAIT_V(8); PG8_WAIT_L(0); PG8_BAR; PG8_MMA(1, 0, At, B0); PG8_MMA(1, 1, At, B1); PG8_BAR; PG8_SCHED;
            PG8_LDB(B0, 1, 0); PG8_LDB(B1, 1, 1); PG8_SCHED; PG8_LDA(At, 1, 0); PG8_STAGE(PG8_SA(0, 1), a2 + hstep, voffA);
            PG8_WAIT_V(8); PG8_WAIT_L(0); PG8_BAR; PG8_MMA(0, 0, At, B0); PG8_MMA(0, 1, At, B1); PG8_BAR; PG8_SCHED;
            PG8_LDA(At, 1, 1); PG8_STAGEB(PG8_SB(1, 0), b3, voffB); PG8_STAGEB(PG8_SB(1, 1), b3 + hstep, voffB); PG8_STAGE(PG8_SA(1, 0), a3, voffA);
            PG8_WAIT_V(8); PG8_WAIT_L(0); PG8_BAR; PG8_MMA(1, 0, At, B0); PG8_MMA(1, 1, At, B1); PG8_BAR; PG8_SCHED;
            } else {
            PG8_LDB(B0, 0, 0); PG8_SCHED; PG8_LDA(At, 0, 0); PG8_STAGE(PG8_SA(1, 1), a1 + hstep, voffA);
            PG8_WAIT_L(8); PG8_BAR; PG8_WAIT_L(0); PG8_MMA(0, 0, At, B0); PG8_BAR; PG8_SCHED;
            PG8_LDB(B1, 0, 1); PG8_STAGEB(PG8_SB(0, 0), b2, voffB);
            PG8_BAR; PG8_WAIT_L(0); PG8_MMA(0, 1, At, B1); PG8_BAR;
            PG8_LDA(At, 0, 1); PG8_STAGE(PG8_SA(0, 0), a2, voffA);
            PG8_BAR; PG8_WAIT_L(0); PG8_MMA(1, 0, At, B0); PG8_BAR; PG8_SCHED;
            PG8_STAGEB(PG8_SB(0, 1), b2 + hstep, voffB);
            PG8_WAIT_V(6); PG8_BAR; PG8_MMA(1, 1, At, B1); PG8_BAR;
            PG8_LDB(B0, 1, 0); PG8_SCHED; PG8_LDA(At, 1, 0); PG8_STAGE(PG8_SA(0, 1), a2 + hstep, voffA);
            PG8_WAIT_L(8); PG8_BAR; PG8_WAIT_L(0); PG8_MMA(0, 0, At, B0); PG8_BAR; PG8_SCHED;
            PG8_LDB(B1, 1, 1); PG8_STAGEB(PG8_SB(1, 0), b3, voffB);
            PG8_BAR; PG8_WAIT_L(0); PG8_MMA(0, 1, At, B1); PG8_BAR;
            PG8_LDA(At, 1, 1); PG8_STAGE(PG8_SA(1, 0), a3, voffA);
            PG8_BAR; PG8_WAIT_L(0); PG8_MMA(1, 0, At, B0); PG8_BAR; PG8_SCHED;
            PG8_STAGEB(PG8_SB(1, 1), b3 + hstep, voffB);
            PG8_WAIT_V(6); PG8_BAR; PG8_MMA(1, 1, At, B1); PG8_BAR;
            }
        }
        if constexpr (ALIGN_EPI) { if (wr == 0) PG8_BAR; }
#if PT_EPI
        { const unsigned long long t0_ = wall_clock64(); E(acc, cur, wr, wc, fr, fq, xlds); const unsigned long long t1_ = wall_clock64();
          if (tid == 0) *(PG8_LAS unsigned long long*)(lds + 143360 + 64) += t1_ - t0_; } S.done(cur);
#else
        E(acc, cur, wr, wc, fr, fq, xlds); S.done(cur);
#endif
        if (!has_next) break;
#pragma unroll
        for (int a = 0; a < 2; ++a)
#pragma unroll
            for (int b = 0; b < 2; ++b)
#pragma unroll
                for (int m = 0; m < 4; ++m)
#pragma unroll
                    for (int n = 0; n < 2; ++n) acc[a][b][m][n] = (f32x4){0.f, 0.f, 0.f, 0.f};
        cur = nxt; cA = nA; cB = nB; ++ui;
        if constexpr (ALIGN_EPI) { if (wr == 1) PG8_BAR; }
    }
    PG8_WAIT_V(0);
    if constexpr (!ALIGN_EPI) { if (wr == 0) PG8_BAR; }
    PG8_BAR;
#undef PG8_SA
#undef PG8_SB
#undef PG8_STAGE
#undef PG8_STAGEB
#undef PG8_LDA
#undef PG8_LDB
#undef PG8_MMA
#undef PG8_WAIT_V
#undef PG8_WAIT_L
#undef PG8_BAR
#undef PG8_SCHED
}
}

namespace att {
constexpr int D = 128, NW = 8, QBLK = 32, KVBLK = 64;
constexpr float SCALE = 0.088388347648318440f;
constexpr float THR = 8.f;
constexpr int SHM_V = KVBLK * D * 2, SHM_K = KVBLK * D * 2, SHM_ATTN = 2 * SHM_V + 2 * SHM_K + NW * 64 * 4;
#define KSWZ(row, colB) ((row) * 256 + ((colB) ^ (((row) & 7) << 4)))
#define SBAR() __builtin_amdgcn_sched_barrier(0)
__device__ __forceinline__ int crow(int r, int hi) { return (r & 3) + 8 * (r >> 2) + 4 * hi; }
__device__ __forceinline__ unsigned cvtpk(float lo, float hi) { unsigned r; asm volatile("v_cvt_pk_bf16_f32 %0, %1, %2" : "=v"(r) : "v"(lo), "v"(hi)); return r; }

template <bool FIXM, bool NOEXP = false> __device__ __forceinline__ void partialSM(f32x16& p0, f32x16& p1, float& m_reg, float& mn, float& alpha, float mshC) {
  constexpr float C = SCALE * 1.4426950408889634f;
  if constexpr (FIXM) {
    alpha = 1.f; mn = 0.f; if constexpr (NOEXP) return;
#pragma unroll
    for (int r = 0; r < 16; ++r) p0[r] = __builtin_amdgcn_exp2f(p0[r]);
    return;
  }
  float pmax = p0[0];
#pragma unroll
  for (int r = 1; r < 16; ++r) pmax = fmaxf(pmax, p0[r]);
#pragma unroll
  for (int r = 0; r < 16; ++r) pmax = fmaxf(pmax, p1[r]);
  { auto rr = __builtin_amdgcn_permlane32_swap(__float_as_uint(pmax), __float_as_uint(pmax), false, false);
    pmax = fmaxf(__uint_as_float(rr[0]), __uint_as_float(rr[1])); }
  if (__builtin_expect(__all(pmax - m_reg <= THR / SCALE), 1)) { mn = m_reg; alpha = 1.f; }
  else { mn = fmaxf(m_reg, pmax); alpha = __builtin_amdgcn_exp2f((m_reg - mn) * C); m_reg = mn; }
  float mnC = -mn * C;
#pragma unroll
  for (int r = 0; r < 16; ++r) p0[r] = fmaf(p0[r], C, mnC);
#pragma unroll
  for (int r = 0; r < 16; ++r) p1[r] = fmaf(p1[r], C, mnC);
#pragma unroll
  for (int r = 0; r < 16; ++r) p0[r] = __builtin_amdgcn_exp2f(p0[r]);
}
__device__ __forceinline__ void finishSM(f32x16& p0, f32x16& p1, float alpha, float& l_reg, bf16x8& pa0, bf16x8& pa1, bf16x8& pa2, bf16x8& pa3) {
#pragma unroll
  for (int r = 0; r < 16; ++r) p1[r] = __builtin_amdgcn_exp2f(p1[r]);
  float ps = 0;
#pragma unroll
  for (int r = 0; r < 16; ++r) ps += p0[r];
#pragma unroll
  for (int r = 0; r < 16; ++r) ps += p1[r];
  { auto rr = __builtin_amdgcn_permlane32_swap(__float_as_uint(ps), __float_as_uint(ps), false, false);
    ps = __uint_as_float(rr[0]) + __uint_as_float(rr[1]); }
  l_reg = l_reg * alpha + ps;
#define PK4(P, BASE, OUT) do { unsigned a0 = cvtpk(P[BASE + 0], P[BASE + 1]), a1 = cvtpk(P[BASE + 2], P[BASE + 3]);   \
    unsigned b0 = cvtpk(P[BASE + 4], P[BASE + 5]), b1 = cvtpk(P[BASE + 6], P[BASE + 7]);                              \
    auto r0 = __builtin_amdgcn_permlane32_swap(a0, b0, false, false); auto r1 = __builtin_amdgcn_permlane32_swap(a1, b1, false, false); \
    u32x4 w = {r0[0], r1[0], r0[1], r1[1]}; OUT = *reinterpret_cast<bf16x8*>(&w); } while (0)
  PK4(p0, 0, pa0); PK4(p0, 8, pa1); PK4(p1, 0, pa2); PK4(p1, 8, pa3);
#undef PK4
}
__device__ __forceinline__ void qkt(f32x16& p0, f32x16& p1, const LAS unsigned char* Ks, const bf16x8* qr, int r32, int hi, float init = 0.f) {
#pragma unroll
  for (int r = 0; r < 16; ++r) { p0[r] = init; p1[r] = init; }
#pragma unroll
  for (int d0 = 0; d0 < 8; ++d0) { int cb = (d0 * 16 + hi * 8) * 2;
    bf16x8 b0 = *reinterpret_cast<const LAS bf16x8*>(Ks + KSWZ(r32, cb));
    bf16x8 b1 = *reinterpret_cast<const LAS bf16x8*>(Ks + KSWZ(32 + r32, cb));
    p0 = __builtin_amdgcn_mfma_f32_32x32x16_bf16(b0, qr[d0], p0, 0, 0, 0);
    p1 = __builtin_amdgcn_mfma_f32_32x32x16_bf16(b1, qr[d0], p1, 0, 0, 0); }
}
#define QF_PK4(P, BASE, OUT) do { unsigned a0 = cvtpk(P[BASE + 0], P[BASE + 1]), a1 = cvtpk(P[BASE + 2], P[BASE + 3]);   \
    unsigned b0 = cvtpk(P[BASE + 4], P[BASE + 5]), b1 = cvtpk(P[BASE + 6], P[BASE + 7]);                              \
    auto r0 = __builtin_amdgcn_permlane32_swap(a0, b0, false, false); auto r1 = __builtin_amdgcn_permlane32_swap(a1, b1, false, false); \
    u32x4 w = {r0[0], r1[0], r0[1], r1[1]}; OUT = *reinterpret_cast<bf16x8*>(&w); } while (0)
#define QF_KRD(D0, X0, X1) do { X0 = *reinterpret_cast<const LAS bf16x8*>(Ks + KSWZ(r32, ((D0) * 16 + hi * 8) * 2)); X1 = *reinterpret_cast<const LAS bf16x8*>(Ks + KSWZ(32 + r32, ((D0) * 16 + hi * 8) * 2)); } while (0)
#define QF_STEP(D0, X0, X1) do { SBAR(); q0 = __builtin_amdgcn_mfma_f32_32x32x16_bf16(X0, qr[D0], q0, 0, 0, 0); q1 = __builtin_amdgcn_mfma_f32_32x32x16_bf16(X1, qr[D0], q1, 0, 0, 0); \
    if ((D0) + 2 < 8) QF_KRD((D0) + 2, X0, X1);                                                                                                                       \
    p1[2 * (D0)] = __builtin_amdgcn_exp2f(p1[2 * (D0)]); p1[2 * (D0) + 1] = __builtin_amdgcn_exp2f(p1[2 * (D0) + 1]); psa += p0[2 * (D0)]; psb += p0[2 * (D0) + 1];     \
    if ((D0) >= 1) { psa += p1[2 * (D0) - 2]; psb += p1[2 * (D0) - 1]; }                                                                                              \
    if ((D0) == 0) QF_PK4(p0, 0, pa0); if ((D0) == 1) QF_PK4(p0, 8, pa1); if ((D0) == 5) QF_PK4(p1, 0, pa2); } while (0)
__device__ __forceinline__ void qk_fin(f32x16& q0, f32x16& q1, const LAS unsigned char* Ks, const bf16x8* qr, int r32, int hi,
                                       f32x16& p0, f32x16& p1, float& l_reg, bf16x8& pa0, bf16x8& pa1, bf16x8& pa2, bf16x8& pa3) {
#pragma unroll
  for (int r = 0; r < 16; ++r) { q0[r] = 0.f; q1[r] = 0.f; }
  bf16x8 ka0, ka1, kb0, kb1; float psa = 0.f, psb = 0.f;
  QF_KRD(0, ka0, ka1); QF_KRD(1, kb0, kb1);
  QF_STEP(0, ka0, ka1); QF_STEP(1, kb0, kb1); QF_STEP(2, ka0, ka1); QF_STEP(3, kb0, kb1); QF_STEP(4, ka0, ka1); QF_STEP(5, kb0, kb1); QF_STEP(6, ka0, ka1); QF_STEP(7, kb0, kb1);
  SBAR();
  psa += p1[14]; psb += p1[15]; QF_PK4(p1, 8, pa3);
  float ps = psa + psb;
  { auto rr = __builtin_amdgcn_permlane32_swap(__float_as_uint(ps), __float_as_uint(ps), false, false);
    ps = __uint_as_float(rr[0]) + __uint_as_float(rr[1]); }
  l_reg += ps;
}
#undef QF_PK4
#undef QF_KRD
#undef QF_STEP
__device__ __forceinline__ int v_st(int k, int c) { const int kk = (k & ~0xC) | ((k & 4) << 1) | ((k & 8) >> 1); return ((kk >> 3) * 4 + (c >> 5)) * 512 + ((kk & 7) * 32 + (c & 31)) * 2; }
__device__ __forceinline__ int v_rd_base(int lane) { return ((lane & 3) << 3) | (((lane >> 2) & 3) << 6) | (((lane >> 4) & 1) << 5) | (((lane >> 5) & 1) << 8); }
constexpr int v_rd_off(int d0, int ks, int half) { return d0 * 512 + ks * 4096 + half * 2048; }
template <int OFF> __device__ __forceinline__ s16x4 tr_read(int vb) {
  s16x4 r; asm volatile("ds_read_b64_tr_b16 %0, %1 offset:%2" : "=&v"(r) : "v"(vb), "i"(OFF) : "memory"); return r;
}
template <int D0> __device__ __forceinline__ void pv_one(f32x16& od, int vb, bf16x8 pa0, bf16x8 pa1, bf16x8 pa2, bf16x8 pa3) {
  const s16x4 l0 = tr_read<v_rd_off(D0, 0, 0)>(vb), h0 = tr_read<v_rd_off(D0, 0, 1)>(vb), l1 = tr_read<v_rd_off(D0, 1, 0)>(vb), h1 = tr_read<v_rd_off(D0, 1, 1)>(vb);
  const s16x4 l2 = tr_read<v_rd_off(D0, 2, 0)>(vb), h2 = tr_read<v_rd_off(D0, 2, 1)>(vb), l3 = tr_read<v_rd_off(D0, 3, 0)>(vb), h3 = tr_read<v_rd_off(D0, 3, 1)>(vb);
  asm volatile("s_waitcnt lgkmcnt(0)" ::: "memory"); SBAR();
#define PK(L, H) (bf16x8){L[0], L[1], L[2], L[3], H[0], H[1], H[2], H[3]}
  od = __builtin_amdgcn_mfma_f32_32x32x16_bf16(pa0, PK(l0, h0), od, 0, 0, 0);
  od = __builtin_amdgcn_mfma_f32_32x32x16_bf16(pa1, PK(l1, h1), od, 0, 0, 0);
  od = __builtin_amdgcn_mfma_f32_32x32x16_bf16(pa2, PK(l2, h2), od, 0, 0, 0);
  od = __builtin_amdgcn_mfma_f32_32x32x16_bf16(pa3, PK(l3, h3), od, 0, 0, 0);
#undef PK
}
__device__ __forceinline__ void pv_d0(f32x16* o, int vb, bf16x8 pa0, bf16x8 pa1, bf16x8 pa2, bf16x8 pa3) {
  pv_one<0>(o[0], vb, pa0, pa1, pa2, pa3); pv_one<1>(o[1], vb, pa0, pa1, pa2, pa3); pv_one<2>(o[2], vb, pa0, pa1, pa2, pa3); pv_one<3>(o[3], vb, pa0, pa1, pa2, pa3);
}
template <int OFF> __device__ __forceinline__ s16x4 tr_rd(const LAS unsigned char* vb) { return __builtin_amdgcn_ds_read_tr16_b64_v4i16((LAS s16x4*)(vb + OFF)); }
#define PV_READS(P, D0) P[0] = tr_rd<v_rd_off(D0, 0, 0)>(vb); P[1] = tr_rd<v_rd_off(D0, 0, 1)>(vb); P[2] = tr_rd<v_rd_off(D0, 1, 0)>(vb); P[3] = tr_rd<v_rd_off(D0, 1, 1)>(vb); \
                        P[4] = tr_rd<v_rd_off(D0, 2, 0)>(vb); P[5] = tr_rd<v_rd_off(D0, 2, 1)>(vb); P[6] = tr_rd<v_rd_off(D0, 3, 0)>(vb); P[7] = tr_rd<v_rd_off(D0, 3, 1)>(vb);
#define PV_PK(L, H) (bf16x8){L[0], L[1], L[2], L[3], H[0], H[1], H[2], H[3]}
#define PV_MMA(OD, P) OD = __builtin_amdgcn_mfma_f32_32x32x16_bf16(pa0, PV_PK(P[0], P[1]), OD, 0, 0, 0); OD = __builtin_amdgcn_mfma_f32_32x32x16_bf16(pa1, PV_PK(P[2], P[3]), OD, 0, 0, 0); \
                      OD = __builtin_amdgcn_mfma_f32_32x32x16_bf16(pa2, PV_PK(P[4], P[5]), OD, 0, 0, 0); OD = __builtin_amdgcn_mfma_f32_32x32x16_bf16(pa3, PV_PK(P[6], P[7]), OD, 0, 0, 0);
#define PV_EXP4(B) do { if constexpr (EXPS) { _Pragma("unroll") for (int r = (B); r < (B) + 4; ++r) pn[r] = __builtin_amdgcn_exp2f(pn[r]); } } while (0)
template <bool EXPS> __device__ __forceinline__ void pv_pipe(f32x16* o, const LAS unsigned char* vb, bf16x8 pa0, bf16x8 pa1, bf16x8 pa2, bf16x8 pa3, f32x16& pn) {
  s16x4 A[8], B[8];
  PV_READS(A, 0) PV_READS(B, 1)
  SBAR(); PV_MMA(o[0], A) PV_EXP4(0); SBAR();
  PV_READS(A, 2)
  SBAR(); PV_MMA(o[1], B) PV_EXP4(4); SBAR();
  PV_READS(B, 3)
  SBAR(); PV_MMA(o[2], A) PV_EXP4(8); SBAR();
  PV_MMA(o[3], B) PV_EXP4(12);
}
#undef PV_READS
#undef PV_PK
#undef PV_MMA
#undef PV_EXP4

template <int LDQ, int LDK, int LDO, bool FIXM = false>
__device__ __forceinline__ void attn_dense_body(const bf16_t* __restrict__ Qb, const bf16_t* __restrict__ Kh, const bf16_t* __restrict__ Vh,
                                                bf16_t* __restrict__ Ob, int seq, LAS unsigned char* lds, float mshC = 0.f) {
  int tid_ = threadIdx.x; asm volatile("" : "+v"(tid_)); const int tid = tid_, wid = tid >> 6, lane = tid & 63, r32 = lane & 31, hi = lane >> 5;
  LAS unsigned char* V_lds = lds; LAS unsigned char* K_lds = lds + 2 * SHM_V;
  LAS float* ws = (LAS float*)(lds + 2 * SHM_V + 2 * SHM_K) + wid * 64; LAS float* li_l = ws; LAS float* al_l = ws + 32;
  float m_reg = -1e30f, l_reg = 0; f32x16 o[4] = {}; bf16x8 qr[8];
  const bf16_t* Qw = Qb + (long)(wid * QBLK + r32) * LDQ + hi * 8;
#pragma unroll
  for (int d0 = 0; d0 < 8; ++d0) qr[d0] = *reinterpret_cast<const bf16x8*>(Qw + d0 * 16);
  asm volatile("" : "+v"(qr[0]), "+v"(qr[1]), "+v"(qr[2]), "+v"(qr[3]), "+v"(qr[4]), "+v"(qr[5]), "+v"(qr[6]), "+v"(qr[7]));
#pragma unroll
  for (int d0 = 0; d0 < 8; ++d0) {
    if constexpr (FIXM) { constexpr float C = SCALE * 1.4426950408889634f; const u32x4 q = __builtin_bit_cast(u32x4, qr[d0]); u32x4 s;
      s.x = cvt_pk_bf16(bf_lo(q.x) * C, bf_hi(q.x) * C); s.y = cvt_pk_bf16(bf_lo(q.y) * C, bf_hi(q.y) * C); s.z = cvt_pk_bf16(bf_lo(q.z) * C, bf_hi(q.z) * C); s.w = cvt_pk_bf16(bf_lo(q.w) * C, bf_hi(q.w) * C);
      qr[d0] = __builtin_bit_cast(bf16x8, s); } }
  const int sr = tid >> 4, sc = (tid & 15) * 8, vst0 = v_st(sr, sc), vst1 = v_st(32 + sr, sc), kc = sc * 2;
  const LAS unsigned char* vbp = V_lds + v_rd_base(lane); const int vb0 = (int)(uintptr_t)V_lds + v_rd_base(lane);
  bf16x8 kr0, kr1, vr0, vr1;
#define KLOAD(k0) do { kr0 = *reinterpret_cast<const bf16x8*>(&Kh[(long)((k0) + sr) * LDK + sc]); kr1 = *reinterpret_cast<const bf16x8*>(&Kh[(long)((k0) + 32 + sr) * LDK + sc]); } while (0)
#define VLOAD(k0) do { vr0 = *reinterpret_cast<const bf16x8*>(&Vh[(long)((k0) + sr) * LDK + sc]); vr1 = *reinterpret_cast<const bf16x8*>(&Vh[(long)((k0) + 32 + sr) * LDK + sc]); } while (0)
#define KWRITE(b) do { *(LAS bf16x8*)(K_lds + (b) * SHM_K + KSWZ(sr, kc)) = kr0; *(LAS bf16x8*)(K_lds + (b) * SHM_K + KSWZ(32 + sr, kc)) = kr1; } while (0)
#define VWRITE(b) do { *(LAS bf16x8*)(V_lds + (b) * SHM_V + vst0) = vr0; *(LAS bf16x8*)(V_lds + (b) * SHM_V + vst1) = vr1; } while (0)
#define RESC(a) do { if constexpr (!FIXM) if (__any((a) < 1.f)) { if (hi == 0) al_l[r32] = (a); asm volatile("s_waitcnt lgkmcnt(0)" ::: "memory"); \
    _Pragma("unroll") for (int d = 0; d < 4; ++d) _Pragma("unroll") for (int r = 0; r < 16; ++r) o[d][r] *= al_l[crow(r, hi)]; } } while (0)
  f32x16 pA0, pA1, pB0, pB1; float mnA, mnB, alA, alB; bf16x8 pa0, pa1, pa2, pa3; const int NT = seq / KVBLK;
  KLOAD(0); VLOAD(0); KWRITE(0); VWRITE(0); KLOAD(KVBLK); VLOAD(KVBLK); __syncthreads();
  qkt(pA0, pA1, K_lds, qr, r32, hi); partialSM<FIXM>(pA0, pA1, m_reg, mnA, alA, mshC);
  KWRITE(1); KLOAD(2 * KVBLK);
  if (tid >= 256) __builtin_amdgcn_s_setprio(1);
  for (int j = 0; j + 2 < NT; j += 2) {
    __syncthreads(); KWRITE(0); VWRITE(1); KLOAD((j + 3) * KVBLK); VLOAD((j + 2) * KVBLK);
    SBAR(); if constexpr (FIXM) qk_fin(pB0, pB1, K_lds + SHM_K, qr, r32, hi, pA0, pA1, l_reg, pa0, pa1, pa2, pa3);
    else { qkt(pB0, pB1, K_lds + SHM_K, qr, r32, hi); finishSM(pA0, pA1, alA, l_reg, pa0, pa1, pa2, pa3); } SBAR();
    pv_pipe<FIXM>(o, vbp, pa0, pa1, pa2, pa3, pB0); partialSM<FIXM, true>(pB0, pB1, m_reg, mnB, alB, mshC); RESC(alB);
    __syncthreads(); KWRITE(1); VWRITE(0); if (j + 4 < NT) KLOAD((j + 4) * KVBLK); VLOAD((j + 3) * KVBLK);
    SBAR(); if constexpr (FIXM) qk_fin(pA0, pA1, K_lds, qr, r32, hi, pB0, pB1, l_reg, pa0, pa1, pa2, pa3);
    else { qkt(pA0, pA1, K_lds, qr, r32, hi); finishSM(pB0, pB1, alB, l_reg, pa0, pa1, pa2, pa3); } SBAR();
    pv_pipe<FIXM>(o, vbp + SHM_V, pa0, pa1, pa2, pa3, pA0); partialSM<FIXM, true>(pA0, pA1, m_reg, mnA, alA, mshC); RESC(alA);
  }
  __builtin_amdgcn_s_setprio(0);
  __syncthreads(); VWRITE(1);
  SBAR(); qkt(pB0, pB1, K_lds + SHM_K, qr, r32, hi);
  finishSM(pA0, pA1, alA, l_reg, pa0, pa1, pa2, pa3); SBAR();
  pv_d0(o, vb0, pa0, pa1, pa2, pa3); partialSM<FIXM>(pB0, pB1, m_reg, mnB, alB, mshC); RESC(alB);
  __syncthreads();
  finishSM(pB0, pB1, alB, l_reg, pa0, pa1, pa2, pa3); SBAR();
  pv_d0(o, vb0 + (int)SHM_V, pa0, pa1, pa2, pa3);
  if (hi == 0) li_l[r32] = l_reg; asm volatile("s_waitcnt lgkmcnt(0)" ::: "memory");
  float rli[16];
#pragma unroll
  for (int r = 0; r < 16; ++r) rli[r] = __builtin_amdgcn_rcpf(li_l[crow(r, hi)]);
  bf16_t* Ow = Ob + (long)(wid * QBLK) * LDO;
#pragma unroll
  for (int r = 0; r < 16; ++r) { int orow = crow(r, hi);
#pragma unroll
    for (int d0 = 0; d0 < 4; ++d0) Ow[(long)orow * LDO + d0 * 32 + r32] = f2bf(o[d0][r] * rli[r]); }
#undef KLOAD
#undef VLOAD
#undef KWRITE
#undef VWRITE
#undef RESC
}
}


constexpr int NWAVES = 8, NTHREADS = 512;
constexpr int N_LAUNCHES = MK_N_LAUNCHES;
constexpr int NPHASES = 27;
constexpr size_t MiB = 1u << 20;
constexpr size_t WS_CTL = 0, CTL_ZERO_BYTES = 1 * MiB;
constexpr size_t WS_ROPE = 1 * MiB, WS_MEMSS = 1 * MiB + 65536;
constexpr size_t WS_WIN = 2 * MiB, WS_WOUT = 178 * MiB, WS_WCQ = 242 * MiB, WS_WCKV = 250 * MiB, WS_WCO = 266 * MiB, WS_WUP = 274 * MiB, WS_WDOWN = 618 * MiB;
constexpr size_t WS_XB = 790 * MiB, WS_PROJ = 918 * MiB, WS_MIX = 1270 * MiB, WS_CQ = 1398 * MiB, WS_CO = 1414 * MiB, WS_MEMB = 1430 * MiB, WS_MKV = 1440 * MiB;
constexpr size_t WS_GH = 1446 * MiB, WS_HB = 1790 * MiB, WS_U = 1812 * MiB, WS_SS = 2068 * MiB, WS_END = 2196 * MiB;
static_assert(WS_WIN + 2ull * NIN * DM * 2 <= WS_WOUT && WS_WUP + 2ull * NUP * DM * 2 <= WS_WDOWN && WS_WDOWN + 2ull * DM * DFF * 2 <= WS_XB, "ws map (weights)");
static_assert(WS_PROJ + (size_t)MROWS * NIN * 2 <= WS_MIX && WS_GH + (size_t)MROWS * DFF * 2 <= WS_HB && WS_HB + 64ull * 4 * NUP * 4 <= WS_U && WS_U + 2ull * 2048 * 16384 * 2 <= WS_SS, "ws map (activations)");
constexpr int CW_BAR = 4096;
constexpr size_t CTL_SSQ = 65536;
static_assert(CTL_SSQ + 7ull * 16384 * 8 <= CTL_ZERO_BYTES, "ssq inside the memset region");
constexpr int RING_BYTES = 131072, XL_OFF = 131072, MISC_OFF = 143360, LDS_BYTES = 147456;
constexpr int RS = 136, RSB = RS * 2, RTB = 128 * RSB;
static_assert(4 * RTB + 1024 <= MISC_OFF && XL_OFF + 8192 + 4096 <= MISC_OFF && MISC_OFF + 128 <= LDS_BYTES, "LDS map");

typedef GAS unsigned gu32;
#define RLX_AGENT __ATOMIC_RELAXED, __HIP_MEMORY_SCOPE_AGENT
#define LDS_WAIT() asm volatile("s_waitcnt lgkmcnt(0)" ::: "memory")
#define VM_WAIT() asm volatile("s_waitcnt vmcnt(0)" ::: "memory")

#define XB_TMO      128
#define XB_XCNT(j)  (256  + 64 * (j))
#define XB_XSUB(j)  (1280 + 64 * (j))
#define XB_XGEN(j)  (2304 + 64 * (j))
#define XB_TOP      3328
#define XB_TOPGEN   3392
#define XCD_BAR_WORDS 3456
#define XB_SPIN_CAP (1u << 18)
__device__ __forceinline__ unsigned xb_ld(unsigned* p)              { return __hip_atomic_load(p, __ATOMIC_RELAXED, __HIP_MEMORY_SCOPE_AGENT); }
__device__ __forceinline__ unsigned xb_add(unsigned* p, unsigned v) { return __hip_atomic_fetch_add(p, v, __ATOMIC_RELAXED, __HIP_MEMORY_SCOPE_AGENT); }
__device__ __forceinline__ unsigned xb_xcc_id() { return (unsigned)__builtin_amdgcn_s_getreg((3 << 11) | 20) & 0xFu; }
#define XB_SPIN(cond, bar) do { unsigned _sp = 0; while (cond) { __builtin_amdgcn_s_sleep(1); \
    if ((++_sp & 255u) == 0u) { if (xb_ld(&(bar)[XB_TMO])) break; if (_sp > XB_SPIN_CAP) { atomicAdd(&(bar)[XB_TMO], 1u); break; } } } } while (0)
struct XcdBarrier { unsigned* bar; unsigned x; volatile LAS unsigned* st; };
__device__ __forceinline__ XcdBarrier xcd_barrier_post(unsigned* bar, volatile LAS unsigned* st) {
    XcdBarrier b; b.bar = bar; b.x = xb_xcc_id(); b.st = st;
    if (threadIdx.x == 0) (void)xb_add(&bar[XB_XCNT(b.x)], 1u);
    return b;
}
__device__ __forceinline__ void xcd_barrier_complete(unsigned* bar, unsigned x, unsigned& nloc, unsigned& nx) {
    const unsigned G = gridDim.x * gridDim.y * gridDim.z;
    unsigned sum, cnt, mine, sp = 0u;
    for (;;) {
        sum = 0u; cnt = 0u; mine = 0u;
#pragma unroll
        for (unsigned j = 0; j < 16; ++j) { const unsigned c = xb_ld(&bar[XB_XCNT(j)]); sum += c; cnt += (c > 0u) ? 1u : 0u; mine = (j == x) ? c : mine; }
        if (sum == G) break;
        __builtin_amdgcn_s_sleep(1);
        if ((++sp & 255u) == 0u) { if (xb_ld(&bar[XB_TMO])) break; if (sp > XB_SPIN_CAP) { atomicAdd(&bar[XB_TMO], 1u); break; } }
    }
    nloc = mine > 0u ? mine : 1u; nx = cnt > 0u ? cnt : 1u;
}
__device__ __forceinline__ void xcd_barrier(const XcdBarrier& b) {
    asm volatile("s_waitcnt vmcnt(0)" ::: "memory");
    __syncthreads();
    if (threadIdx.x == 0) {
        unsigned* bar = b.bar;
        __builtin_amdgcn_s_waitcnt(0);
        unsigned nloc = b.st[0], nx = b.st[1];
        if (nloc == 0u) { xcd_barrier_complete(bar, b.x, nloc, nx); b.st[0] = nloc; b.st[1] = nx; }
        const unsigned old = xb_add(&bar[XB_XSUB(b.x)], 1u);
        const unsigned gen = old / nloc;
        if (old + 1u == (gen + 1u) * nloc) {
            __builtin_amdgcn_fence(__ATOMIC_RELEASE, "agent");
            asm volatile("s_waitcnt vmcnt(0)" ::: "memory");
            const unsigned og = xb_add(&bar[XB_TOP], 1u);
            const unsigned tg = og / nx;
            if (og + 1u == (tg + 1u) * nx) xb_add(&bar[XB_TOPGEN], 1u);
            else XB_SPIN(xb_ld(&bar[XB_TOPGEN]) == tg, bar);
            __builtin_amdgcn_fence(__ATOMIC_ACQUIRE, "agent");
            xb_add(&bar[XB_XGEN(b.x)], 1u);
            asm volatile("s_waitcnt vmcnt(0)" ::: "memory");
        } else {
            XB_SPIN(xb_ld(&bar[XB_XGEN(b.x)]) == gen, bar);
            __builtin_amdgcn_fence(__ATOMIC_ACQUIRE, "agent");
            asm volatile("s_waitcnt vmcnt(0)" ::: "memory");
        }
    }
    __syncthreads();
}

struct Args { const float* in[21]; float* out; unsigned char* ws; int ph_lo, ph_hi; };

template <bool UPMAP, bool ROPEPERM = false>
__device__ __forceinline__ void p0_transpose_item(const float* __restrict__ W, int K, int N, bf16_t* __restrict__ WT, const float* __restrict__ gain, int cs_lo, int cs_hi, float cs, LAS float* scr, int item, int lane) {
    const int nblk = N / 64, kb = item / nblk, nb = item % nblk, k0 = 64 * kb, n0 = 64 * nb;
    const float* src = W + (size_t)k0 * N + n0 + lane;
#pragma unroll 32
    for (int i = 0; i < 64; ++i) scr[i * 65 + lane] = __builtin_nontemporal_load(src + (size_t)i * N);
    LDS_WAIT(); asm volatile("" ::: "memory");
    const int c = lane & 7, rr = lane >> 3;
    float g8[8];
#pragma unroll
    for (int e = 0; e < 8; ++e) g8[e] = gain ? gain[k0 + 8 * c + e] : 1.0f;
    const float csv = (n0 >= cs_lo && n0 < cs_hi) ? cs : 1.0f;
    int orow0 = n0;
    if (UPMAP) { const int nn = n0 < DFF ? n0 : n0 - DFF; orow0 = (nn >> 7) * 256 + (n0 < DFF ? 0 : 128) + (nn & 127); }
    const bool hperm = ROPEPERM && (n0 < 4096 || (n0 >= 8192 && n0 < 10752));
#pragma unroll
    for (int jj = 0; jj < 8; ++jj) { const int n = rr + 8 * jj; const LAS float* s = scr + (8 * c) * 65 + n;
        const int nrow = hperm ? (8 * ((n & 31) >> 2) + (n & 3) + ((n >= 32) ? 4 : 0)) : n;
        u32x4 o;
        o.x = cvt_pk_bf16(s[0 * 65] * g8[0] * csv, s[1 * 65] * g8[1] * csv); o.y = cvt_pk_bf16(s[2 * 65] * g8[2] * csv, s[3 * 65] * g8[3] * csv);
        o.z = cvt_pk_bf16(s[4 * 65] * g8[4] * csv, s[5 * 65] * g8[5] * csv); o.w = cvt_pk_bf16(s[6 * 65] * g8[6] * csv, s[7 * 65] * g8[7] * csv);
        __builtin_nontemporal_store(o, (u32x4*)(WT + (size_t)(orow0 + nrow) * K + k0 + 8 * c)); }
    LDS_WAIT(); asm volatile("" ::: "memory");
}
__device__ __forceinline__ float wave_sum(float v) {
#pragma unroll
    for (int o = 1; o < 64; o <<= 1) v += __shfl_xor(v, o);
    return v;
}
template <class TS> __device__ __forceinline__ void row_to_bf16(const float* __restrict__ xrow, bf16_t* __restrict__ orow, TS* ssq_out, int lane) {
    const f32x4* xr = (const f32x4*)xrow + lane; float s = 0.f;
    u32x2* o8 = (u32x2*)orow + lane;
#pragma unroll
    for (int j = 0; j < 16; ++j) { const f32x4 v = __builtin_nontemporal_load(xr + 64 * j); s += (v[0] * v[0] + v[1] * v[1]) + (v[2] * v[2] + v[3] * v[3]);
        u32x2 w; w.x = cvt_pk_bf16(v[0], v[1]); w.y = cvt_pk_bf16(v[2], v[3]); o8[64 * j] = w; }
    s = wave_sum(s);
    if (lane == 0) { if constexpr (sizeof(TS) == 8) *ssq_out = (TS)(s * 1048576.0f + 0.5f); else *ssq_out = s; }
}

__device__ __forceinline__ void prep_row(bf16_t* __restrict__ prow, int t, const f32x2* __restrict__ rope, const float* __restrict__ qn, const float* __restrict__ kn, int lane) {
    const int hg = lane >> 3, j = lane & 7;
    const int off1 = 8 * j + ((j >= 4) ? 32 : 0);
    const int pos = (j < 4) ? (t >> 6) : (t & 63);
    const f32x2* rp = rope + pos * 32 + 8 * (j & 3);
    f32x2 cs[8];
#pragma unroll
    for (int e = 0; e < 8; ++e) cs[e] = rp[e];
#pragma unroll
    for (int g = 0; g < 7; ++g) {
        const int base = (g < 4) ? g * 1024 : (g < 6 ? 8192 + (g - 4) * 1024 : 10240);
        const bool active = (g < 6) || (hg < 4);
        const int hh = active ? hg : 0;
        bf16_t* p = prow + base + hh * 128 + off1;
        const u32x4 a = *(const u32x4*)p, b = *(const u32x4*)(p + 32);
        float x1[8] = {bf_lo(a.x), bf_hi(a.x), bf_lo(a.y), bf_hi(a.y), bf_lo(a.z), bf_hi(a.z), bf_lo(a.w), bf_hi(a.w)};
        float x2[8] = {bf_lo(b.x), bf_hi(b.x), bf_lo(b.y), bf_hi(b.y), bf_lo(b.z), bf_hi(b.z), bf_lo(b.w), bf_hi(b.w)};
        if (g >= 4) {
            float ss = 0.f;
#pragma unroll
            for (int e = 0; e < 8; ++e) ss += x1[e] * x1[e] + x2[e] * x2[e];
            ss += __shfl_xor(ss, 1); ss += __shfl_xor(ss, 2); ss += __shfl_xor(ss, 4);
            const float rs = __builtin_amdgcn_rsqf(ss * (1.0f / 128.0f) + EPS);
            const float* gn = (g < 6) ? qn : kn;
#pragma unroll
            for (int e = 0; e < 8; ++e) { x1[e] *= rs * gn[off1 + e]; x2[e] *= rs * gn[off1 + 32 + e]; }
        }
        float y1[8], y2[8];
#pragma unroll
        for (int e = 0; e < 8; ++e) { y1[e] = x1[e] * cs[e].x - x2[e] * cs[e].y; y2[e] = x2[e] * cs[e].x + x1[e] * cs[e].y; }
        if (active) {
            u32x4 oa, ob;
            oa.x = cvt_pk_bf16(y1[0], y1[1]); oa.y = cvt_pk_bf16(y1[2], y1[3]); oa.z = cvt_pk_bf16(y1[4], y1[5]); oa.w = cvt_pk_bf16(y1[6], y1[7]);
            ob.x = cvt_pk_bf16(y2[0], y2[1]); ob.y = cvt_pk_bf16(y2[2], y2[3]); ob.z = cvt_pk_bf16(y2[4], y2[5]); ob.w = cvt_pk_bf16(y2[6], y2[7]);
            *(u32x4*)p = oa; *(u32x4*)(p + 32) = ob;
        }
    }
}

__device__ __forceinline__ f32x4 mfma16(bf16x8 a, bf16x8 b, f32x4 c) { return __builtin_amdgcn_mfma_f32_16x16x32_bf16(a, b, c, 0, 0, 0); }
__device__ __forceinline__ bf16x8 tr_frag(int addr) {
    s16x4 lo, hi;
    asm volatile("ds_read_b64_tr_b16 %0, %2\n\tds_read_b64_tr_b16 %1, %2 offset:%3\n\ts_waitcnt lgkmcnt(0)" : "=&v"(lo), "=&v"(hi) : "v"(addr), "i"(4 * RSB) : "memory");
    return (bf16x8){lo[0], lo[1], lo[2], lo[3], hi[0], hi[1], hi[2], hi[3]};
}
__device__ __forceinline__ void tr_frag4(int addr, bf16x8 (&f)[4]) {
    s16x4 l0, h0, l1, h1, l2, h2, l3, h3;
    asm volatile("ds_read_b64_tr_b16 %0, %8\n\tds_read_b64_tr_b16 %1, %8 offset:%9\n\tds_read_b64_tr_b16 %2, %8 offset:32\n\tds_read_b64_tr_b16 %3, %8 offset:%10\n\t"
                 "ds_read_b64_tr_b16 %4, %8 offset:64\n\tds_read_b64_tr_b16 %5, %8 offset:%11\n\tds_read_b64_tr_b16 %6, %8 offset:96\n\tds_read_b64_tr_b16 %7, %8 offset:%12\n\ts_waitcnt lgkmcnt(0)"
                 : "=&v"(l0), "=&v"(h0), "=&v"(l1), "=&v"(h1), "=&v"(l2), "=&v"(h2), "=&v"(l3), "=&v"(h3)
                 : "v"(addr), "i"(4 * RSB), "i"(4 * RSB + 32), "i"(4 * RSB + 64), "i"(4 * RSB + 96) : "memory");
    f[0] = (bf16x8){l0[0], l0[1], l0[2], l0[3], h0[0], h0[1], h0[2], h0[3]}; f[1] = (bf16x8){l1[0], l1[1], l1[2], l1[3], h1[0], h1[1], h1[2], h1[3]};
    f[2] = (bf16x8){l2[0], l2[1], l2[2], l2[3], h2[0], h2[1], h2[2], h2[3]}; f[3] = (bf16x8){l3[0], l3[1], l3[2], l3[3], h3[0], h3[1], h3[2], h3[3]};
}
__device__ __forceinline__ void ret_state_item(LAS unsigned char* lds, const bf16_t* __restrict__ PROJ, bf16_t* __restrict__ U, int r0, int h, int item, float lf2, float lb2) {
    int tid_ = threadIdx.x; asm volatile("" : "+v"(tid_)); const int tid = tid_, lane = tid & 63, w = __builtin_amdgcn_readfirstlane(tid >> 6), g = lane >> 4, lr = lane & 15, q4 = (lane & 15) >> 2, p4 = lane & 3;
    const int wr4 = w >> 1, wc2 = w & 1;
    LAS bf16_t* Kf = (LAS bf16_t*)lds; LAS bf16_t* Kb = Kf + 128 * RS; LAS bf16_t* Vs = Kb + 128 * RS;
#pragma unroll
    for (int p = 0; p < 4; ++p) { const int idx = tid + 512 * p, j = idx >> 4, cc = (idx & 15) * 8;
        const bf16_t* src = PROJ + (size_t)(r0 + j) * NIN + 2048 + h * 128 + cc;
        const u32x4 k = *(const u32x4*)src, v = *(const u32x4*)(src + 2048);
        const float zf = __builtin_amdgcn_exp2f((float)(127 - j) * lf2), zb = __builtin_amdgcn_exp2f((float)j * lb2);
        u32x4 kf, kb;
        kf.x = cvt_pk_bf16(bf_lo(k.x) * zf, bf_hi(k.x) * zf); kf.y = cvt_pk_bf16(bf_lo(k.y) * zf, bf_hi(k.y) * zf); kf.z = cvt_pk_bf16(bf_lo(k.z) * zf, bf_hi(k.z) * zf); kf.w = cvt_pk_bf16(bf_lo(k.w) * zf, bf_hi(k.w) * zf);
        kb.x = cvt_pk_bf16(bf_lo(k.x) * zb, bf_hi(k.x) * zb); kb.y = cvt_pk_bf16(bf_lo(k.y) * zb, bf_hi(k.y) * zb); kb.z = cvt_pk_bf16(bf_lo(k.z) * zb, bf_hi(k.z) * zb); kb.w = cvt_pk_bf16(bf_lo(k.w) * zb, bf_hi(k.w) * zb);
        *(LAS u32x4*)(Kf + j * RS + cc) = kf; *(LAS u32x4*)(Kb + j * RS + cc) = kb; *(LAS u32x4*)(Vs + j * RS + cc) = v; }
    __syncthreads();
    f32x4 af[2][4], ab[2][4];
#pragma unroll
    for (int a = 0; a < 2; ++a)
#pragma unroll
        for (int b = 0; b < 4; ++b) { af[a][b] = (f32x4){0.f, 0.f, 0.f, 0.f}; ab[a][b] = (f32x4){0.f, 0.f, 0.f, 0.f}; }
    const int vbase = (int)(uintptr_t)Vs, fbase = (int)(uintptr_t)Kf, bbase = (int)(uintptr_t)Kb;
#pragma unroll
    for (int ks = 0; ks < 4; ++ks) {
        const int rowoff = (32 * ks + 8 * g + q4) * RSB;
        bf16x8 A4[4], Bf[4], Bb[4];
        tr_frag4(vbase + rowoff + (32 * wr4 + 4 * p4) * 2, A4);
        tr_frag4(fbase + rowoff + (64 * wc2 + 4 * p4) * 2, Bf);
        tr_frag4(bbase + rowoff + (64 * wc2 + 4 * p4) * 2, Bb);
#pragma unroll
        for (int b = 0; b < 4; ++b)
#pragma unroll
            for (int a = 0; a < 2; ++a) { af[a][b] = mfma16(A4[a], Bf[b], af[a][b]); ab[a][b] = mfma16(A4[a], Bb[b], ab[a][b]); }
    }
    LAS float* Ys = (LAS float*)lds;
#pragma unroll
    for (int dir = 0; dir < 2; ++dir) {
        __syncthreads();
#pragma unroll
        for (int a = 0; a < 2; ++a)
#pragma unroll
            for (int b = 0; b < 4; ++b)
#pragma unroll
                for (int r = 0; r < 4; ++r) Ys[(32 * wr4 + 16 * a + 4 * g + r) * 132 + 64 * wc2 + 16 * b + lr] = dir ? ab[a][b][r] : af[a][b][r];
        __syncthreads();
        bf16_t* Ud = U + (size_t)(dir * 2048 + item) * 16384;
#pragma unroll
        for (int p = 0; p < 4; ++p) { const int idx = tid + 512 * p, j = idx >> 4, cc = (idx & 15) * 8;
            const f32x4 y0 = *(const LAS f32x4*)(Ys + j * 132 + cc), y1 = *(const LAS f32x4*)(Ys + j * 132 + cc + 4);
            u32x4 wv; wv.x = cvt_pk_bf16(y0[0], y0[1]); wv.y = cvt_pk_bf16(y0[2], y0[3]); wv.z = cvt_pk_bf16(y1[0], y1[1]); wv.w = cvt_pk_bf16(y1[2], y1[3]);
            *(u32x4*)(Ud + j * 128 + cc) = wv; }
    }
    __syncthreads();
}
constexpr int YS = 132;
static_assert(128 * YS * 4 <= 2 * RTB, "y tile fits the K + V tiles");
__device__ __forceinline__ void ret_item_geom(int it, const float* __restrict__ dl  , int& r0, int& h, float& lf2, float& lb2) {
    if (it < 1024) { const int sh = it >> 4, c = it & 15; h = sh & 15; r0 = (sh >> 4) * 2048 + c * 128; }
    else { const int i2 = it - 1024; h = i2 >> 6; r0 = 8192 + (i2 & 63) * 128; }
    lf2 = dl[h]; lb2 = dl[16 + h];
}
__device__ __forceinline__ void ret_out_phase(LAS unsigned char* lds, const bf16_t* __restrict__ PROJ, const bf16_t* __restrict__ SS, bf16_t* __restrict__ MIX, const float* __restrict__ dl, int first, int step) {
#define RET_LANE_IDS int tid_ = threadIdx.x; asm volatile("" : "+v"(tid_)); const int tid = tid_, lane = tid & 63, w = __builtin_amdgcn_readfirstlane(tid >> 6), g = lane >> 4, lr = lane & 15, q4 = (lane & 15) >> 2, p4 = lane & 3, wr4 = w >> 1, wc2 = w & 1; (void)q4; (void)p4; (void)wc2;
    LAS bf16_t* Ks = (LAS bf16_t*)lds; LAS bf16_t* Vs = Ks + 128 * RS; LAS bf16_t* Fs = Vs + 128 * RS; LAS bf16_t* Bs = Fs + 128 * RS; LAS float* RSUM = (LAS float*)(lds + 4 * RTB);
    LAS bf16_t* Ps = Ks; LAS float* Ys = (LAS float*)lds;
    if (first >= 2048) return;
    bf16x8 AQ[2][4]; u32x4 kv[4];
#define RET_LOAD_QK(r0_, h_) do { \
    _Pragma("unroll") for (int a = 0; a < 2; ++a) _Pragma("unroll") for (int ks = 0; ks < 4; ++ks) AQ[a][ks] = *(const bf16x8*)(PROJ + ((size_t)(r0_) * NIN + (h_) * 128) + (unsigned)((32 * wr4 + 16 * a + lr) * NIN + 32 * ks + 8 * g)); \
    _Pragma("unroll") for (int p = 0; p < 4; ++p) { const int idx = tid + 512 * p, j = idx >> 4, cc = (idx & 15) * 8; kv[p] = *(const u32x4*)(PROJ + ((size_t)(r0_) * NIN + 2048 + (h_) * 128) + (unsigned)(j * NIN + cc)); } } while (0)
    { RET_LANE_IDS int r0, h; float lf2, lb2; ret_item_geom(first, dl, r0, h, lf2, lb2); RET_LOAD_QK(r0, h); }
    for (int item = first; item < 2048; item += step) {
        RET_LANE_IDS
        int r0, h; float lf2, lb2; ret_item_geom(item, dl, r0, h, lf2, lb2);
        const bf16_t* SfT = SS + (size_t)item * 16384; const bf16_t* SbT = SS + (size_t)(2048 + item) * 16384;
        u32x4 vv[4], fv[4], bv[4], gv[4];
#pragma unroll
        for (int p = 0; p < 4; ++p) { const int idx = tid + 512 * p, j = idx >> 4, cc = (idx & 15) * 8;
            const bf16_t* pb = PROJ + ((size_t)r0 * NIN + 4096 + h * 128); const unsigned po = (unsigned)(j * NIN + cc), so = (unsigned)(j * 128 + cc);
            vv[p] = *(const u32x4*)(pb + po); gv[p] = *(const u32x4*)(pb + 2048 + po);
            fv[p] = *(const u32x4*)(SfT + so); bv[p] = *(const u32x4*)(SbT + so); }
#pragma unroll
        for (int p = 0; p < 4; ++p) { const int idx = tid + 512 * p, j = idx >> 4, cc = (idx & 15) * 8; *(LAS u32x4*)(Ks + j * RS + cc) = kv[p]; }
        __syncthreads();
        f32x4 sc[2][4];
#pragma unroll
        for (int a = 0; a < 2; ++a)
#pragma unroll
            for (int b = 0; b < 4; ++b) sc[a][b] = (f32x4){0.f, 0.f, 0.f, 0.f};
#pragma unroll
        for (int ks = 0; ks < 4; ++ks) {
            bf16x8 B[4];
#pragma unroll
            for (int b = 0; b < 4; ++b) B[b] = *(const LAS bf16x8*)(Ks + (64 * wc2 + 16 * b + lr) * RS + 32 * ks + 8 * g);
#pragma unroll
            for (int a = 0; a < 2; ++a)
#pragma unroll
                for (int b = 0; b < 4; ++b) sc[a][b] = mfma16(AQ[a][ks], B[b], sc[a][b]);
        }
#pragma unroll
        for (int a = 0; a < 2; ++a)
#pragma unroll
            for (int b = 0; b < 4; ++b)
#pragma unroll
                for (int r = 0; r < 4; ++r) { const int i = 32 * wr4 + 16 * a + 4 * g + r, j = 64 * wc2 + 16 * b + lr, d = i - j;
                    sc[a][b][r] *= __builtin_amdgcn_exp2f(d >= 0 ? (float)d * lf2 : (float)(-d) * lb2); }
        __syncthreads();
#pragma unroll
        for (int a = 0; a < 2; ++a)
#pragma unroll
            for (int b = 0; b < 4; ++b)
#pragma unroll
                for (int r = 0; r < 4; ++r) Ps[(32 * wr4 + 16 * a + 4 * g + r) * RS + 64 * wc2 + 16 * b + lr] = f2bf(sc[a][b][r]);
#pragma unroll
        for (int p = 0; p < 4; ++p) { const int idx = tid + 512 * p, j = idx >> 4, cc = (idx & 15) * 8;
            *(LAS u32x4*)(Vs + j * RS + cc) = vv[p]; *(LAS u32x4*)(Fs + j * RS + cc) = fv[p]; *(LAS u32x4*)(Bs + j * RS + cc) = bv[p]; }
        __syncthreads();
        f32x4 y[2][4];
#pragma unroll
        for (int a = 0; a < 2; ++a)
#pragma unroll
            for (int b = 0; b < 4; ++b) y[a][b] = (f32x4){0.f, 0.f, 0.f, 0.f};
        float xfr[2], xbr[2];
#pragma unroll
        for (int a = 0; a < 2; ++a) { const int i = 32 * wr4 + 16 * a + lr; xfr[a] = __builtin_amdgcn_exp2f((float)(i + 1) * lf2); xbr[a] = __builtin_amdgcn_exp2f((float)(128 - i) * lb2); }
        const int vbase = (int)(uintptr_t)Vs;
#pragma unroll
        for (int ks = 0; ks < 4; ++ks) {
            bf16x8 AP[2], AF[2], AB[2], BV[4], BF[4], BB[4];
#pragma unroll
            for (int a = 0; a < 2; ++a) { AP[a] = *(const LAS bf16x8*)(Ps + (32 * wr4 + 16 * a + lr) * RS + 32 * ks + 8 * g);
                const u32x4 q = __builtin_bit_cast(u32x4, AQ[a][ks]); u32x4 f, bq;
                f.x = cvt_pk_bf16(bf_lo(q.x) * xfr[a], bf_hi(q.x) * xfr[a]); f.y = cvt_pk_bf16(bf_lo(q.y) * xfr[a], bf_hi(q.y) * xfr[a]); f.z = cvt_pk_bf16(bf_lo(q.z) * xfr[a], bf_hi(q.z) * xfr[a]); f.w = cvt_pk_bf16(bf_lo(q.w) * xfr[a], bf_hi(q.w) * xfr[a]);
                bq.x = cvt_pk_bf16(bf_lo(q.x) * xbr[a], bf_hi(q.x) * xbr[a]); bq.y = cvt_pk_bf16(bf_lo(q.y) * xbr[a], bf_hi(q.y) * xbr[a]); bq.z = cvt_pk_bf16(bf_lo(q.z) * xbr[a], bf_hi(q.z) * xbr[a]); bq.w = cvt_pk_bf16(bf_lo(q.w) * xbr[a], bf_hi(q.w) * xbr[a]);
                AF[a] = __builtin_bit_cast(bf16x8, f); AB[a] = __builtin_bit_cast(bf16x8, bq); }
#pragma unroll
            for (int b = 0; b < 4; ++b) { BF[b] = *(const LAS bf16x8*)(Fs + (64 * wc2 + 16 * b + lr) * RS + 32 * ks + 8 * g); BB[b] = *(const LAS bf16x8*)(Bs + (64 * wc2 + 16 * b + lr) * RS + 32 * ks + 8 * g); }
            tr_frag4(vbase + (32 * ks + 8 * g + q4) * RSB + (64 * wc2 + 4 * p4) * 2, BV);
#pragma unroll
            for (int a = 0; a < 2; ++a)
#pragma unroll
                for (int b = 0; b < 4; ++b) { y[a][b] = mfma16(AP[a], BV[b], y[a][b]); y[a][b] = mfma16(AF[a], BF[b], y[a][b]); y[a][b] = mfma16(AB[a], BB[b], y[a][b]); }
        }
#pragma unroll
        for (int a = 0; a < 2; ++a)
#pragma unroll
            for (int r = 0; r < 4; ++r) { const int i = 32 * wr4 + 16 * a + 4 * g + r;
                float s = 0.f;
#pragma unroll
                for (int b = 0; b < 4; ++b) { const float v = y[a][b][r]; s += v * v; }
                s += __shfl_xor(s, 1); s += __shfl_xor(s, 2); s += __shfl_xor(s, 4); s += __shfl_xor(s, 8);
                if (lr == 0) RSUM[i * 2 + wc2] = s; }
        { const int nx = item + step; if (nx < 2048) { int r0n, hn; float a_, b_; ret_item_geom(nx, dl, r0n, hn, a_, b_); RET_LOAD_QK(r0n, hn); } }
        __syncthreads();
#pragma unroll
        for (int a = 0; a < 2; ++a)
#pragma unroll
            for (int r = 0; r < 4; ++r) { const int i = 32 * wr4 + 16 * a + 4 * g + r;
                const float rs = __builtin_amdgcn_rsqf((RSUM[i * 2] + RSUM[i * 2 + 1]) * (1.0f / 128.0f) + EPS);
#pragma unroll
                for (int b = 0; b < 4; ++b) Ys[i * YS + 64 * wc2 + 16 * b + lr] = y[a][b][r] * rs; }
        __syncthreads();
#pragma unroll
        for (int p = 0; p < 4; ++p) { const int idx = tid + 512 * p, j = idx >> 4, cc = (idx & 15) * 8;
            const f32x4 y0 = *(const LAS f32x4*)(Ys + j * YS + cc), y1 = *(const LAS f32x4*)(Ys + j * YS + cc + 4);
            const u32x4 gg = gv[p];
            const float gt[8] = {bf_lo(gg.x), bf_hi(gg.x), bf_lo(gg.y), bf_hi(gg.y), bf_lo(gg.z), bf_hi(gg.z), bf_lo(gg.w), bf_hi(gg.w)};
            float o[8];
#pragma unroll
            for (int e = 0; e < 8; ++e) { const float sg = gt[e] * __builtin_amdgcn_rcpf(1.0f + __builtin_amdgcn_exp2f(-gt[e] * 1.4426950408889634f)); o[e] = sg * (e < 4 ? y0[e & 3] : y1[e & 3]); }
            u32x4 wv; wv.x = cvt_pk_bf16(o[0], o[1]); wv.y = cvt_pk_bf16(o[2], o[3]); wv.z = cvt_pk_bf16(o[4], o[5]); wv.w = cvt_pk_bf16(o[6], o[7]);
            *(u32x4*)(MIX + ((size_t)r0 * DM + h * 128) + (unsigned)(j * DM + cc)) = wv; }
        __syncthreads();
    }
#undef RET_LOAD_QK
#undef RET_LANE_IDS
}

#ifndef PROBE
#define PROBE 0
#endif
constexpr int REP_P0 = PROBE == 1 ? 2 : 1, REP_R1 = PROBE == 2 ? 2 : 1, REP_R2 = PROBE == 7 ? 2 : 1, REP_R3 = PROBE == 8 ? 2 : 1, REP_G5 = PROBE == 3 ? 2 : 1, REP_ATT = PROBE == 4 ? 3 : 1, REP_G1 = PROBE == 5 ? 2 : 1, REP_PREP0 = PROBE == 6 ? 2 : 1, XTRA_G6 = PROBE == 9, XTRA_G2 = PROBE == 10, XTRA_G4 = PROBE == 11, XTRA_G5P = PROBE == 12; constexpr int XTRA_BARS = PROBE == 13 ? 20 : 0; constexpr int REP_SMALL = PROBE == 14 ? 2 : 1; constexpr bool XTRA_HOTG2 = PROBE == 15, XTRA_G5NULL = PROBE == 16, XTRA_G2NULL = PROBE == 17;
constexpr int CW_FIN = 245760;
static_assert((size_t)CW_FIN * 4 >= CTL_SSQ + 7ull * 16384 * 8 && (size_t)CW_FIN * 4 + 64 * 64 <= CTL_ZERO_BYTES, "panel counters inside the memset region");
constexpr bool FUSE_FINAL = false && (MK_N_LAUNCHES == 1);
constexpr int CW_SPLIT = 8192;
template <class T> __device__ __forceinline__ T* opq(T* p) { GAS T* q = (GAS T*)p; asm volatile("" : "+s"(q)); return (T*)q; }
__global__ void __launch_bounds__(NTHREADS, 2) trunk_fwd(Args args) {
    extern __shared__ __attribute__((aligned(16))) unsigned char lds_raw[];
    LAS unsigned char* lds = (LAS unsigned char*)lds_raw;
    volatile LAS unsigned* MISC = (volatile LAS unsigned*)(lds + MISC_OFF);
    const int G = gridDim.x; const int bx = blockIdx.x; const int vcu = (G % 8 == 0) ? (bx % 8) * (G / 8) + bx / 8 : bx;
#define WSP(T, off) ((T*)(wsp + (off)))
#define ctl WSP(unsigned, WS_CTL)
#define SSQ WSP(unsigned long long, WS_CTL + CTL_SSQ)
#define ROPE WSP(f32x2, WS_ROPE)
#define MEMSS WSP(float, WS_MEMSS)
#define LG2 WSP(float, WS_MEMSS + 8192)
#define WIN WSP(bf16_t, WS_WIN)
#define WOUT WSP(bf16_t, WS_WOUT)
#define WCQ WSP(bf16_t, WS_WCQ)
#define WCKV WSP(bf16_t, WS_WCKV)
#define WCO WSP(bf16_t, WS_WCO)
#define WUP WSP(bf16_t, WS_WUP)
#define WDOWN WSP(bf16_t, WS_WDOWN)
#define XB WSP(bf16_t, WS_XB)
#define PROJ WSP(bf16_t, WS_PROJ)
#define MIX WSP(bf16_t, WS_MIX)
#define CQ WSP(bf16_t, WS_CQ)
#define CO WSP(bf16_t, WS_CO)
#define MEMB WSP(bf16_t, WS_MEMB)
#define MKV WSP(bf16_t, WS_MKV)
#define GH WSP(bf16_t, WS_GH)
#define HB WSP(float, WS_HB)
#define UU WSP(bf16_t, WS_U)
#define SS WSP(bf16_t, WS_U)
#define XRES (args.out)
#define x_prompt (args.in[0])
#define x_sample (args.in[1])
#define mem_prompt (args.in[2])
#define mem_sample (args.in[3])
#define w_in (args.in[4])
#define w_out (args.in[5])
#define decay_logit (args.in[6])
#define q_norm (args.in[7])
#define k_norm (args.in[8])
#define norm_mix (args.in[9])
#define norm_cross (args.in[10])
#define norm_mem (args.in[11])
#define w_cq (args.in[12])
#define w_ckv (args.in[13])
#define w_co (args.in[14])
#define norm_ffn (args.in[15])
#define w_up (args.in[16])
#define conv_w (args.in[17])
#define conv_b (args.in[18])
#define w_down (args.in[19])
#define norm_final (args.in[20])
    if (threadIdx.x < 32) MISC[threadIdx.x] = 0u;
    __syncthreads();
    XcdBarrier bar; bar.bar = (unsigned*)(args.ws + WS_CTL) + CW_BAR; bar.x = 0; bar.st = nullptr;
    if (N_LAUNCHES == 1) bar = xcd_barrier_post((unsigned*)(args.ws + WS_CTL) + CW_BAR, MISC + 8);
    const int lo = args.ph_lo, hi = args.ph_hi;
#ifndef ONLY_SLOT
#define ONLY_SLOT -1
#endif
#define SLOT_ON(s) (ONLY_SLOT < 0 || ONLY_SLOT == (s))
#define INR(k) (lo <= (k) && (k) < hi)
#define IN0 (SLOT_ON(0) && INR(0))
#define INL(s) (SLOT_ON(1 + (s)) && INR(pb + (s)))
#define INF (SLOT_ON(13) && INR(26))
#define INM (SLOT_ON(14) && INR(1))
#ifndef PT_MASK
#define PT_MASK 0
#endif
#ifndef PT_LAYERS
#define PT_LAYERS 3
#endif
    constexpr int PT_K = 4;
    unsigned long long pt_prev = PT_MASK ? wall_clock64() : 0ull, pt_acc = 0ull;
#if PT_EPI
#define PT_MARK(slot, lay) do { if (PT_MASK) { LAS unsigned long long* ec_ = (LAS unsigned long long*)(lds + MISC_OFF + 64); __syncthreads(); if (((PT_MASK >> (slot)) & 1) && ((PT_LAYERS >> (lay)) & 1)) pt_acc += *ec_; __syncthreads(); if (threadIdx.x == 0) *ec_ = 0ull; __syncthreads(); } } while (0)
#else
#define PT_MARK(slot, lay) do { if (PT_MASK) { const unsigned long long now_ = wall_clock64(); if (((PT_MASK >> (slot)) & 1) && ((PT_LAYERS >> (lay)) & 1)) pt_acc += now_ - pt_prev; pt_prev = now_; } } while (0)
#endif
#define SEAM(k) do { if (N_LAUNCHES == 1 && INR(k) && INR((k) + 1)) xcd_barrier(bar); PT_MARK((k) == 0 ? 0 : 1 + ((k) - 2) % 12, (k) < 2 ? 0 : ((k) - 2) / 12); } while (0)
    const int NGW = G * NWAVES;
#define PHASE_LOCALS GAS unsigned char* wsg = (GAS unsigned char*)args.ws; asm volatile("" : "+s"(wsg)); unsigned char* wsp = (unsigned char*)wsg; int tid = threadIdx.x; asm volatile("" : "+v"(tid)); const int lane = tid & 63, wave = __builtin_amdgcn_readfirstlane(tid >> 6), gw = vcu * NWAVES + wave; (void)lane; (void)gw; (void)wave;

    if (IN0) {
        PHASE_LOCALS
        LAS float* scr = (LAS float*)(lds + wave * 16640);
        constexpr int I_IN = 64 * 176, I_OUT = 64 * 64, I_CQ = 64 * 8, I_CKV = 64 * 16, I_CO = 8 * 64, I_UP = 64 * 344, I_DN = 172 * 64;
        constexpr int I_LAYER = I_IN + I_OUT + I_CQ + I_CKV + I_CO + I_UP + I_DN;
        for (int rep = 0; rep < REP_P0; ++rep)
        for (int itr = gw; itr < 2 * I_LAYER; itr += NGW) {
            const int it = 2 * I_LAYER - 1 - itr; const int l = it / I_LAYER; int r = it % I_LAYER;
            if (r < I_IN) { p0_transpose_item<false, true>(w_in + (size_t)l * DM * NIN, DM, NIN, WIN + (size_t)l * NIN * DM, norm_mix + l * DM, 2048, 4096, 0.088388347648318440f, scr, r, lane); continue; } r -= I_IN;
            if (r < I_OUT) { p0_transpose_item<false>(w_out + (size_t)l * DM * DM, DM, DM, WOUT + (size_t)l * DM * DM, nullptr, 0, 0, 1.f, scr, r, lane); continue; } r -= I_OUT;
            if (r < I_CQ) { p0_transpose_item<false>(w_cq + (size_t)l * DM * MEMW, DM, MEMW, WCQ + (size_t)l * MEMW * DM, norm_cross + l * DM, 0, 0, 1.f, scr, r, lane); continue; } r -= I_CQ;
            if (r < I_CKV) { p0_transpose_item<false>(w_ckv + (size_t)l * DM * 1024, DM, 1024, WCKV + (size_t)l * 1024 * DM, norm_mem + l * DM, 0, 0, 1.f, scr, r, lane); continue; } r -= I_CKV;
            if (r < I_CO) { p0_transpose_item<false>(w_co + (size_t)l * MEMW * DM, MEMW, DM, WCO + (size_t)l * DM * MEMW, nullptr, 0, 0, 1.f, scr, r, lane); continue; } r -= I_CO;
            if (r < I_UP) { p0_transpose_item<true>(w_up + (size_t)l * DM * NUP, DM, NUP, WUP + (size_t)l * NUP * DM, norm_ffn + l * DM, 0, 0, 1.f, scr, r, lane); continue; } r -= I_UP;
            p0_transpose_item<false>(w_down + (size_t)l * DFF * DM, DFF, DM, WDOWN + (size_t)l * DM * DFF, nullptr, 0, 0, 1.f, scr, r, lane);
        }
        for (int rep = 0; rep < REP_SMALL; ++rep)
        for (int m = gw; m < MROWS; m += NGW) row_to_bf16(m < 8192 ? x_prompt + (size_t)m * DM : x_sample + (size_t)(m - 8192) * DM, XB + (size_t)m * DM, SSQ + m, lane);
        for (int m = gw; m < MEMROWS; m += NGW) row_to_bf16(m < 1024 ? mem_prompt + (size_t)m * DM : mem_sample + (size_t)(m - 1024) * DM, MEMB + (size_t)m * DM, MEMSS + m, lane);
        if (PROBE == 21) { u32x4* zp = (u32x4*)(wsp + WS_GH); const size_t n16 = (WS_U - WS_GH) / 16; const u32x4 z = {0u, 0u, 0u, 0u};
            for (size_t i = (size_t)bx * NTHREADS + tid; i < n16; i += (size_t)G * NTHREADS) zp[i] = z; }
        if (bx == 0 && tid < 64) LG2[tid] = -log1pf(__expf(-decay_logit[tid])) * 1.4426950408889634f;
        if (bx == 0 && tid >= 64 && tid < 66) {
            const int ll = tid - 64; float gq = 0.f, gk = 0.f;
            for (int d = 0; d < 128; ++d) { gq = fmaxf(gq, fabsf(q_norm[ll * 128 + d])); gk = fmaxf(gk, fabsf(k_norm[ll * 128 + d])); }
            LG2[64 + ll] = fmaxf(0.f, 1.02f * 128.0f * gq * gk * (0.088388347648318440f * 1.4426950408889634f) - 64.0f); }
        for (int e = bx * NTHREADS + tid; e < 128 * 32; e += G * NTHREADS) { const int pos = e >> 5, i = e & 31;
            const float freq = __builtin_amdgcn_exp2f(-(float)i * (13.287712379549449f / 32.0f));
            const float rev = (float)pos * freq * 0.15915494309189535f, fr = rev - __builtin_floorf(rev);
            ROPE[e] = (f32x2){__builtin_amdgcn_cosf(fr), __builtin_amdgcn_sinf(fr)}; }
    }
    SEAM(0);
    for (int l = 0; l < 2; ++l) {
        const int pb = 2 + 12 * l;
        if (INL(0)) {
            PHASE_LOCALS
            pg8::Gemm g{opq(XB), opq(WIN + (size_t)l * NIN * DM), MROWS, NIN, DM}; pg8::StaticOrder S; S.init(MROWS, NIN, G, bx); pg8::EpiProjRope E{PROJ, SSQ + (3 * l) * MROWS, ROPE, q_norm + l * 128, k_norm + l * 128};
            for (int rep = 0; rep < REP_G1; ++rep) pg8::gemm_phase<pg8::EpiProjRope, pg8::StaticOrder, true, true>(lds, lds + XL_OFF, g, S, E);
        }
        SEAM(pb + 0);
        if (INL(2)) {
            PHASE_LOCALS
#define ATT_UNITS(FIXM_) \
            for (int rep = 0; rep < REP_ATT; ++rep) \
            for (int pass = 0; pass < 2; ++pass) \
                for (int u = vcu; u < 512; u += G) { \
                    int rowbase, h, qb, keys; \
                    if (pass == 0) { const int seq = u >> 7, rem = u & 127; h = rem >> 3; qb = rem & 7; rowbase = seq * 2048; keys = 2048; } \
                    else { h = u >> 5; qb = u & 31; rowbase = 8192; keys = 8192; } \
                    const bf16_t* Qb = PROJ + (size_t)(rowbase + qb * 256) * NIN + 8192 + h * 128; \
                    const bf16_t* Kh = PROJ + (size_t)rowbase * NIN + 10240 + (h >> 2) * 128; \
                    bf16_t* Ob = MIX + (size_t)(rowbase + qb * 256) * DM + 2048 + h * 128; \
                    att::attn_dense_body<NIN, NIN, DM, FIXM_>(Qb, Kh, Kh + 512, Ob, keys, lds); \
                    __syncthreads(); \
                }
            if (LG2[64 + l] == 0.f) { ATT_UNITS(true) }
            else { ATT_UNITS(false) }
#undef ATT_UNITS
            for (int rep = 0; rep < REP_R1; ++rep)
            for (int it = vcu; it < 2048; it += G) {
                int r0, h;
                if (it < 1024) { const int sh = it >> 4, c = it & 15; h = sh & 15; r0 = (sh >> 4) * 2048 + c * 128; }
                else { const int i2 = it - 1024; h = i2 >> 6; r0 = 8192 + (i2 & 63) * 128; }
                const float lf2 = LG2[(l * 2 + 0) * 16 + h], lb2 = LG2[(l * 2 + 1) * 16 + h];
                ret_state_item(lds, PROJ, UU, r0, h, it, lf2, lb2);
            }
        }
        SEAM(pb + 2);
        if (INL(3)) {
            PHASE_LOCALS
            for (int rep = 0; rep < REP_R2; ++rep)
            for (int task = bx * NTHREADS + tid; task < 80 * 2 * 2048; task += G * NTHREADS) {
                const int e8 = task & 2047, dir = (task >> 11) & 1, sh = task >> 12;
                const int h = sh & 15, nc = sh < 64 ? 16 : 64, ibase = sh < 64 ? sh * 16 : 1024 + (sh - 64) * 64;
                const float dC = __builtin_amdgcn_exp2f(LG2[(l * 2 + dir) * 16 + h] * 128.0f);
                bf16_t* sp = SS + ((size_t)dir * 2048 + ibase) * 16384 + e8 * 8;
                f32x4 s0 = {0.f, 0.f, 0.f, 0.f}, s1 = s0;
                for (int cb = 0; cb < nc; cb += 8) {
                    u32x4 uv[8];
#pragma unroll
                    for (int k = 0; k < 8; ++k) { const int c = dir ? nc - 1 - (cb + k) : cb + k; uv[k] = *(const u32x4*)(sp + (size_t)c * 16384); }
#pragma unroll
                    for (int k = 0; k < 8; ++k) { const int c = dir ? nc - 1 - (cb + k) : cb + k;
                        u32x4 w; w.x = cvt_pk_bf16(s0[0], s0[1]); w.y = cvt_pk_bf16(s0[2], s0[3]); w.z = cvt_pk_bf16(s1[0], s1[1]); w.w = cvt_pk_bf16(s1[2], s1[3]); *(u32x4*)(sp + (size_t)c * 16384) = w;
                        s0 = s0 * dC + (f32x4){bf_lo(uv[k].x), bf_hi(uv[k].x), bf_lo(uv[k].y), bf_hi(uv[k].y)}; s1 = s1 * dC + (f32x4){bf_lo(uv[k].z), bf_hi(uv[k].z), bf_lo(uv[k].w), bf_hi(uv[k].w)}; }
                }
            }
        }
        SEAM(pb + 3);
        if (INL(4)) {
            PHASE_LOCALS
            for (int rep = 0; rep < REP_R3; ++rep) ret_out_phase(lds, PROJ, SS, MIX, LG2 + l * 32, vcu, G);
        }
        SEAM(pb + 4);
        if (INL(5)) {
            PHASE_LOCALS
            pg8::Gemm g{opq(MIX), opq(WOUT + (size_t)l * DM * DM), MROWS, DM, DM}; pg8::StaticOrder S; S.init(MROWS, DM, G, bx);
            pg8::EpiRes E{XB, SSQ + (3 * l + 1) * MROWS};
            if (XTRA_G2NULL) { pg8::EpiNull E0{(float*)UU}; pg8::gemm_phase<pg8::EpiNull, pg8::StaticOrder, true, true>(lds, lds + XL_OFF, g, S, E0); }
            if (XTRA_G2) { pg8::EpiRes E2{(bf16_t*)UU, (unsigned long long*)HB}; pg8::gemm_phase<pg8::EpiRes, pg8::StaticOrder, true, true>(lds, lds + XL_OFF, g, S, E2); }
            pg8::gemm_phase<pg8::EpiRes, pg8::StaticOrder, true, true>(lds, lds + XL_OFF, g, S, E);
        }
        SEAM(pb + 5);
        if (INL(6)) {
            PHASE_LOCALS
            if (l == 0) {
                if (bx >= 128) { pg8::Gemm g{opq(MEMB), opq(WCKV), MEMROWS, 2048, DM}; pg8::StaticOrder S; S.init(MEMROWS, 2048, G - 128, bx - 128); pg8::EpiProj E{MKV, 2048, nullptr, MEMSS, nullptr, nullptr, 0};
                    pg8::gemm_phase<pg8::EpiProj, pg8::StaticOrder, true, true>(lds, lds + XL_OFF, g, S, E); }
                else { pg8::Gemm g{opq(XB), opq(WCQ + (size_t)l * MEMW * DM), MROWS, MEMW, DM}; pg8::StaticOrder S; S.init(MROWS, MEMW, G, bx); pg8::EpiProj E{CQ, MEMW, SSQ + (3 * l + 1) * MROWS, nullptr, nullptr, nullptr, 0};
                    pg8::gemm_phase<pg8::EpiProj, pg8::StaticOrder, true, true>(lds, lds + XL_OFF, g, S, E); }
            } else {
                pg8::Gemm g{opq(XB), opq(WCQ + (size_t)l * MEMW * DM), MROWS, MEMW, DM}; pg8::SplitLastOrder S; S.init(MROWS, MEMW, G, bx); S.full = (G == 256) ? 0 : 1000000; S.ntl = DM / 64;
                pg8::EpiProj E{CQ, MEMW, SSQ + (3 * l + 1) * MROWS, nullptr, (unsigned long long*)UU, ctl + CW_SPLIT + (2 + l) * 128 * 16, bx & 127};
                pg8::gemm_phase<pg8::EpiProj, pg8::SplitLastOrder, true, true>(lds, lds + XL_OFF, g, S, E);
            }
        }
        SEAM(pb + 6);
        if (INL(7)) {
            PHASE_LOCALS
            for (int rep = 0; rep < REP_SMALL; ++rep)
            for (int u = vcu; u < 256; u += G) { const int rb = u >> 2, h = u & 3, b = rb < 32 ? (rb >> 3) : 4;
                const bf16_t* Kh = MKV + (size_t)(b * 256) * 2048 + l * 1024 + h * 128;
                att::attn_dense_body<MEMW, 2048, MEMW>(CQ + (size_t)(rb * 256) * MEMW + h * 128, Kh, Kh + 512, CO + (size_t)(rb * 256) * MEMW + h * 128, 256, lds);
                __syncthreads(); }
        }
        SEAM(pb + 7);
        if (INL(8)) {
            PHASE_LOCALS
            pg8::Gemm g{opq(CO), opq(WCO + (size_t)l * DM * MEMW), MROWS, DM, MEMW}; pg8::StaticOrder S; S.init(MROWS, DM, G, bx);
            pg8::EpiRes E{XB, SSQ + (3 * l + 2) * MROWS};
            if (XTRA_G4) { pg8::EpiRes E2{(bf16_t*)UU, (unsigned long long*)HB}; pg8::gemm_phase<pg8::EpiRes, pg8::StaticOrder, true, true>(lds, lds + XL_OFF, g, S, E2); }
            pg8::gemm_phase<pg8::EpiRes, pg8::StaticOrder, true, true>(lds, lds + XL_OFF, g, S, E);
        }
        SEAM(pb + 8);
        if (INL(9)) {
            PHASE_LOCALS
            pg8::Gemm g{opq(XB), opq(WUP + (size_t)l * NUP * DM), MROWS, NUP, DM}; pg8::SplitLastOrder S; S.init(MROWS, NUP, G, bx); S.full = (G == 256) ? 21 : 1000000; S.ntl = DM / 64;
            pg8::EpiConv E{wsp, WS_GH, WS_HB, WS_CTL + CTL_SSQ + (size_t)(3 * l + 2) * MROWS * 8, conv_w + (size_t)l * 3 * NUP, conv_b + (size_t)l * NUP, (unsigned long long*)UU, ctl + CW_SPLIT + l * 128 * 16, bx & 127};
            if (PROBE == 19 || PROBE == 20) { pg8::AliasOrder SA; SA.init(MROWS, NUP, G, bx); SA.am = PROBE == 20 ? 7 : ~0; SA.an = PROBE == 19 ? 3 : ~0; pg8::EpiNull E0{(float*)UU}; pg8::gemm_phase<pg8::EpiNull, pg8::AliasOrder, true, true>(lds, lds + XL_OFF, g, SA, E0); }
            if (PROBE == 22) { { u32x4* zp = (u32x4*)(wsp + WS_U); const size_t n16 = (WS_END - WS_U) / 16; const u32x4 z = {0u, 0u, 0u, 0u}; for (size_t i = (size_t)bx * NTHREADS + tid; i < n16; i += (size_t)G * NTHREADS) zp[i] = z; __syncthreads(); } pg8::EpiNull E0{(float*)UU}; pg8::gemm_phase<pg8::EpiNull, pg8::StaticOrder, true, true>(lds, lds + XL_OFF, g, S, E0); }
            if (PROBE == 23) { pg8::EpiNull E0{(float*)UU}; pg8::gemm_phase<pg8::EpiNull, pg8::StaticOrder, true, true>(lds, lds + XL_OFF, g, S, E0); { u32x4* zp = (u32x4*)(wsp + WS_U); const size_t n16 = (WS_END - WS_U) / 16; const u32x4 z = {0u, 0u, 0u, 0u}; for (size_t i = (size_t)bx * NTHREADS + tid; i < n16; i += (size_t)G * NTHREADS) zp[i] = z; __syncthreads(); } }
            if (XTRA_G5NULL) { pg8::EpiNull E0{(float*)UU}; pg8::gemm_phase<pg8::EpiNull, pg8::StaticOrder, true, true>(lds, lds + XL_OFF, g, S, E0); }
            if (XTRA_G5P) { pg8::EpiProj E2{PROJ, NIN, SSQ + (3 * l + 2) * MROWS, nullptr, nullptr, nullptr, 0}; pg8::gemm_phase<pg8::EpiProj, pg8::StaticOrder, true, true>(lds, lds + XL_OFF, g, S, E2); }
            for (int rep = 0; rep < REP_G5; ++rep) pg8::gemm_phase<pg8::EpiConv, pg8::SplitLastOrder, true, true>(lds, lds + XL_OFF, g, S, E);
            if (XTRA_HOTG2) { pg8::Gemm g2{opq(MIX), opq(WOUT + (size_t)l * DM * DM), MROWS, DM, DM}; pg8::StaticOrder S2; S2.init(MROWS, DM, G, bx);
                pg8::EpiRes E2{(bf16_t*)UU, (unsigned long long*)(UU + (size_t)MROWS * DM)}; pg8::gemm_phase<pg8::EpiRes, pg8::StaticOrder, true, true>(lds, lds + XL_OFF, g2, S2, E2); }
        }
        SEAM(pb + 9);
        if (INL(10)) {
            PHASE_LOCALS
            const float* cw = conv_w + (size_t)l * 3 * NUP; const float* cbp = conv_b + (size_t)l * NUP;
            for (int rep = 0; rep < REP_SMALL; ++rep)
            for (int task = bx * NTHREADS + tid; task < 128 * (DFF / 4); task += G * NTHREADS) {
                const int cq = task % (DFF / 4), rt = task / (DFF / 4), pm = rt >> 1, which = rt & 1, c = cq * 4;
                const bool is_start = (pm % 8 == 0) && (pm <= 32), is_end = ((pm % 8 == 7) && (pm < 32)) || (pm == 63);
                const float* hp; const float* hc; const float* hn; bool zp = false, zn = false;
                if (which == 0) { hp = HB + (size_t)((pm > 0 ? pm - 1 : 0) * 4 + 3) * NUP; zp = is_start; hc = HB + (size_t)(pm * 4 + 0) * NUP; hn = HB + (size_t)(pm * 4 + 1) * NUP; }
                else { hp = HB + (size_t)(pm * 4 + 2) * NUP; hc = HB + (size_t)(pm * 4 + 3) * NUP; hn = HB + (size_t)((pm < 63 ? pm + 1 : 63) * 4 + 0) * NUP; zn = is_end; }
                const f32x4 z4 = {0.f, 0.f, 0.f, 0.f};
                const f32x4 pa = zp ? z4 : *(const f32x4*)(hp + c), pu = zp ? z4 : *(const f32x4*)(hp + DFF + c);
                const f32x4 ca = *(const f32x4*)(hc + c), cu = *(const f32x4*)(hc + DFF + c);
                const f32x4 na = zn ? z4 : *(const f32x4*)(hn + c), nu = zn ? z4 : *(const f32x4*)(hn + DFF + c);
                const f32x4 va = *(const f32x4*)(cw + c) * pa + *(const f32x4*)(cw + NUP + c) * ca + *(const f32x4*)(cw + 2 * NUP + c) * na + *(const f32x4*)(cbp + c);
                const f32x4 vu = *(const f32x4*)(cw + DFF + c) * pu + *(const f32x4*)(cw + NUP + DFF + c) * cu + *(const f32x4*)(cw + 2 * NUP + DFF + c) * nu + *(const f32x4*)(cbp + DFF + c);
                const f32x2 g0 = pg8::gelu_pk((f32x2){va[0], va[1]}), g1 = pg8::gelu_pk((f32x2){va[2], va[3]});
                u32x2 w; w.x = cvt_pk_bf16(g0.x * vu[0], g0.y * vu[1]); w.y = cvt_pk_bf16(g1.x * vu[2], g1.y * vu[3]);
                *(u32x2*)(GH + (size_t)(pm * 256 + (which ? 255 : 0)) * DFF + c) = w;
            }
        }
        SEAM(pb + 10);
        if (INL(11)) {
            PHASE_LOCALS
            pg8::Gemm g{opq(GH), opq(WDOWN + (size_t)l * DM * DFF), MROWS, DM, DFF}; pg8::StaticOrder S; S.init(MROWS, DM, G, bx, 1);
            if (XTRA_G6) { pg8::EpiRes E2{(bf16_t*)UU, (unsigned long long*)HB}; pg8::gemm_phase<pg8::EpiRes, pg8::StaticOrder, true, true>(lds, lds + XL_OFF, g, S, E2); }
            if (FUSE_FINAL && l == 1) { pg8::EpiResFinal E{XB, SSQ + (3 * l + 3) * MROWS, ctl + CW_FIN, norm_final, XRES}; pg8::gemm_phase<pg8::EpiResFinal, pg8::StaticOrder, true, true>(lds, lds + XL_OFF, g, S, E); }
            else { pg8::EpiRes E{XB, SSQ + (3 * l + 3) * MROWS}; pg8::gemm_phase<pg8::EpiRes, pg8::StaticOrder, true, true>(lds, lds + XL_OFF, g, S, E); }
        }
        if (!(FUSE_FINAL && l == 1)) SEAM(pb + 11);
    }
    if (N_LAUNCHES == 1) for (int i = 0; i < XTRA_BARS; ++i) xcd_barrier(bar);
    if (INF && !FUSE_FINAL) {
        PHASE_LOCALS
        for (int rep = 0; rep < REP_SMALL; ++rep)
        for (int m = gw; m < MROWS; m += NGW) { const float rs = __builtin_amdgcn_rsqf((float)SSQ[6 * MROWS + m] * (1.0f / 1048576.0f / 4096.0f) + EPS);
            const u32x4* xr = (const u32x4*)(XB + (size_t)m * DM) + lane; f32x4* orow = (f32x4*)(XRES + (size_t)m * DM); const f32x4* gp = (const f32x4*)norm_final;
#pragma unroll
            for (int j = 0; j < 8; ++j) { const u32x4 x = __builtin_nontemporal_load(xr + 64 * j); const int c4 = (64 * j + lane) * 2;
                const f32x4 g0 = gp[c4], g1 = gp[c4 + 1];
                __builtin_nontemporal_store((f32x4){bf_lo(x.x), bf_hi(x.x), bf_lo(x.y), bf_hi(x.y)} * rs * g0, orow + c4);
                __builtin_nontemporal_store((f32x4){bf_lo(x.z), bf_hi(x.z), bf_lo(x.w), bf_hi(x.w)} * rs * g1, orow + c4 + 1); } }
    }
    if (PT_MASK) { PT_MARK(13, 0); if (bx == 0) { const unsigned long long until_ = wall_clock64() + (unsigned long long)PT_K * pt_acc; while (wall_clock64() < until_) __builtin_amdgcn_s_sleep(8); } }
#undef INR
#undef SEAM
}

extern "C" void kernel_launch(void* const* d_in, const int* in_sizes, int n_in, void* d_out, int out_size, void* d_ws, size_t ws_size, hipStream_t stream) {
    static int grid = 0;
    if (grid == 0) {
        if (n_in != 21 || out_size != MROWS * DM || ws_size < WS_END) { fprintf(stderr, "kernel_launch: unexpected shapes: n_in %d out %d ws %zu (need %zu)\n", n_in, out_size, ws_size, (size_t)WS_END); grid = -1; return; }
        int dev = 0, cus = 0, per_cu = 0;
        if (hipGetDevice(&dev) != hipSuccess || hipDeviceGetAttribute(&cus, hipDeviceAttributeMultiprocessorCount, dev) != hipSuccess) { grid = -1; return; }
        if (hipFuncSetAttribute((const void*)trunk_fwd, hipFuncAttributeMaxDynamicSharedMemorySize, LDS_BYTES) != hipSuccess) { fprintf(stderr, "kernel_launch: hipFuncSetAttribute failed\n"); grid = -1; return; }
        if (hipOccupancyMaxActiveBlocksPerMultiprocessor(&per_cu, (const void*)trunk_fwd, NTHREADS, LDS_BYTES) != hipSuccess || per_cu < 1) fprintf(stderr, "kernel_launch: occupancy query reports %d blocks per CU\n", per_cu);
        (void)hipGetLastError();
        grid = cus;
    }
    if (grid < 0) return;
    if (hipMemsetAsync((char*)d_ws + WS_CTL, 0, CTL_ZERO_BYTES, stream) != hipSuccess) { fprintf(stderr, "kernel_launch: memset failed\n"); return; }
    Args a{};
    for (int i = 0; i < 21; ++i) a.in[i] = (const float*)d_in[i];
    a.out = (float*)d_out; a.ws = (unsigned char*)d_ws;
    if (N_LAUNCHES == 1) { a.ph_lo = 0; a.ph_hi = NPHASES; hipLaunchKernelGGL(trunk_fwd, dim3(grid), dim3(NTHREADS), LDS_BYTES, stream, a); }
    else for (int p = 0; p < NPHASES; ++p) { a.ph_lo = p; a.ph_hi = p + 1; hipLaunchKernelGGL(trunk_fwd, dim3(grid), dim3(NTHREADS), LDS_BYTES, stream, a); }
    const hipError_t le = hipPeekAtLastError();
    if (le != hipSuccess) fprintf(stderr, "kernel_launch: launch failed: %s\n", hipGetErrorName(le));
}
```

```cpp
#include <hip/hip_runtime.h>
#include <cstdio>
#include <cstdint>

#define GAS __attribute__((address_space(1)))
#define LAS __attribute__((address_space(3)))
typedef unsigned short bf16_t;
typedef short bf16x8 __attribute__((ext_vector_type(8)));
typedef short s16x4 __attribute__((ext_vector_type(4)));
typedef float f32x4 __attribute__((ext_vector_type(4)));
typedef float f32x2 __attribute__((ext_vector_type(2)));
typedef float f32x16 __attribute__((ext_vector_type(16)));
typedef unsigned u32x4 __attribute__((ext_vector_type(4)));
typedef unsigned u32x2 __attribute__((ext_vector_type(2)));

constexpr int DM = 4096, MROWS = 16384, NIN = 11264, DFF = 11008, NUP = 22016, MEMROWS = 1280, MEMW = 512;
constexpr float EPS = 1e-6f;
#ifndef MK_N_LAUNCHES
#define MK_N_LAUNCHES 1
#endif

__device__ __forceinline__ unsigned cvt_pk_bf16(float lo, float hi) { unsigned r; asm volatile("v_cvt_pk_bf16_f32 %0, %1, %2" : "=v"(r) : "v"(lo), "v"(hi)); return r; }
__device__ __forceinline__ float bf_lo(unsigned w) { return __uint_as_float(w << 16); }
__device__ __forceinline__ float bf_hi(unsigned w) { return __uint_as_float(w & 0xffff0000u); }
__device__ __forceinline__ float bf2f(bf16_t b) { return __uint_as_float(((unsigned)b) << 16); }
__device__ __forceinline__ bf16_t f2bf(float f) { return (bf16_t)(cvt_pk_bf16(f, 0.f) & 0xffffu); }

#ifndef PT_EPI
#define PT_EPI 0
#endif
namespace pg8 {
#define PG8_LAS __attribute__((address_space(3)))
constexpr int BM = 256, BK = 64, HALF = 128, HTB = HALF * BK * 2  , STAGE_BYTES = 8 * HTB, NXCD = 8, WGM = 8;

__host__ __device__ __forceinline__ int lds_byte(int r, int c) { const int st = (r >> 4) * 2 + (c >> 5), rr = r & 15, cc = c & 31, ob = rr * 64 + cc * 2; return st * 1024 + (ob ^ (((ob >> 9) & 1) << 5)); }
__host__ __device__ __forceinline__ void stage_rc(int b, int& R, int& C) { const int st = b / 1024, sb = b % 1024, swz = sb ^ (((sb >> 9) & 1) << 5); R = (st >> 1) * 16 + swz / 64; C = (st & 1) * 32 + (swz % 64) / 2; }
__host__ __device__ __forceinline__ int perm32(int rho) { const int n = rho >> 4, i = rho & 15; return 8 * (i >> 2) + 4 * n + (i & 3); }

struct Unit { int pm, pn, kt0, nkt, fin; };
struct Gemm { const bf16_t* A; const bf16_t* Bt; int M, N, K; };

struct StaticOrder {
    int nM, nN, nwg, G, c, pn_inner;
    __host__ __device__ void init(int M, int N, int G_, int c_, int pn_inner_ = 0) { nM = M / BM; nN = N / BM; nwg = nM * nN; G = G_; c = c_; pn_inner = pn_inner_; }
    __host__ __device__ bool next(int i, Unit& u) const { return map((long)i * G + c, u); }
    __host__ __device__ bool map(long L, Unit& u) const {
        if (L >= nwg) return false;
        int wgid = (int)L; { const int q = nwg / NXCD, r = nwg % NXCD, xcd = wgid % NXCD, off = wgid / NXCD; wgid = (xcd < r ? xcd * (q + 1) : r * (q + 1) + (xcd - r) * q) + off; }
        const int nig = WGM * nN, gid = wgid / nig, fm = gid * WGM, gsz = (nM - fm) < WGM ? (nM - fm) : WGM;
        if (pn_inner) { u.pm = fm + ((wgid % nig) / nN); u.pn = (wgid % nig) % nN; } else { u.pm = fm + ((wgid % nig) % gsz); u.pn = (wgid % nig) / gsz; }
        u.kt0 = 0; u.nkt = 0; u.fin = 1; return true;
    }
    __device__ __forceinline__ void a_ready(const Unit&) const {}
    __device__ __forceinline__ void done(const Unit&) const {}
};

struct AliasOrder : StaticOrder {
    int am, an;
    __device__ bool next(int i, Unit& u) const { const bool r = StaticOrder::next(i, u); u.pm &= am; u.pn &= an; return r; }
};
struct SplitLastOrder : StaticOrder {
    int full, ntl;
    __device__ bool next(int i, Unit& u) const {
        if (i < full) return StaticOrder::next(i, u);
        if (i > full) return false;
        const int half = G / 2, cc = c < half ? c : c - half;
        if (!map((long)full * G + cc, u)) return false;
        u.nkt = ntl / 2; u.kt0 = c < half ? 0 : ntl / 2; u.fin = c < half ? 2 : 3; return true;
    }
};

#define SPLITK_HANDOFF() \
    if (u.fin == 3) { \
            f32x4* dst = (f32x4*)scr + ((size_t)slot * 32) * 512 + (((wr * 4 + wc) * 4 + fq) * 16 + fr); \
_Pragma("unroll") \
            for (int ai = 0; ai < 2; ++ai) \
_Pragma("unroll") \
                for (int bj = 0; bj < 2; ++bj) \
_Pragma("unroll") \
                    for (int m = 0; m < 4; ++m) \
_Pragma("unroll") \
                        for (int n = 0; n < 2; ++n) { const int k = ((ai * 2 + bj) * 4 + m) * 2 + n; f32x4* p = dst + (size_t)k * 512; \
                            asm volatile("global_store_dwordx4 %0, %1, off sc1" :: "v"(p), "v"(acc[ai][bj][m][n]) : "memory"); } \
            asm volatile("s_waitcnt vmcnt(0)" ::: "memory"); __builtin_amdgcn_s_barrier(); asm volatile("" ::: "memory"); \
            if (wr == 0 && wc == 0 && fq == 0 && fr == 0) __hip_atomic_store(flag + slot * 16, 1u, __ATOMIC_RELAXED, __HIP_MEMORY_SCOPE_AGENT); \
            return; \
        } \
    if (u.fin == 2) { \
            if (wr == 0 && wc == 0) { unsigned sp = 0; \
                while ((unsigned)__builtin_amdgcn_readfirstlane(__hip_atomic_load(flag + slot * 16, __ATOMIC_RELAXED, __HIP_MEMORY_SCOPE_AGENT)) == 0u) { __builtin_amdgcn_s_sleep(2); if (++sp > (1u << 20)) break; } \
                __builtin_amdgcn_fence(__ATOMIC_ACQUIRE, "agent"); asm volatile("s_waitcnt vmcnt(0)" ::: "memory"); } \
            asm volatile("" ::: "memory"); __builtin_amdgcn_s_barrier(); asm volatile("" ::: "memory"); \
            const f32x4* src = (const f32x4*)scr + ((size_t)slot * 32) * 512 + (((wr * 4 + wc) * 4 + fq) * 16 + fr); \
_Pragma("unroll") \
            for (int g8 = 0; g8 < 4; ++g8) { f32x4 tp[8]; \
_Pragma("unroll") \
                for (int k8 = 0; k8 < 8; ++k8) tp[k8] = src[(size_t)(g8 * 8 + k8) * 512]; \
                asm volatile("" : "+v"(tp[0]), "+v"(tp[1]), "+v"(tp[2]), "+v"(tp[3]), "+v"(tp[4]), "+v"(tp[5]), "+v"(tp[6]), "+v"(tp[7])); \
_Pragma("unroll") \
                for (int k8 = 0; k8 < 8; ++k8) { const int k = g8 * 8 + k8; acc[k >> 4][(k >> 3) & 1][(k >> 1) & 3][k & 1] += tp[k8]; } } \
        }

__device__ __forceinline__ f32x2 gelu_pk(f32x2 v) {
    const f32x2 av = __builtin_elementwise_abs(v), d = av * 0.2316418882f + 1.0f;
    f32x2 t; t.x = __builtin_amdgcn_rcpf(d.x); t.y = __builtin_amdgcn_rcpf(d.y);
    f32x2 q = t * 0.5307027145f + (-0.7265760135f); q = q * t + 0.7107068705f; q = q * t + (-0.142248368f); q = q * t + 0.127414796f; q = q * t;
    const f32x2 s = (v * v) * (-0.72134752044f);
    f32x2 e; e.x = __builtin_amdgcn_exp2f(s.x); e.y = __builtin_amdgcn_exp2f(s.y);
    const f32x2 m = v * (q * e), r = v - m;
    f32x2 o; o.x = v.x < 0.f ? m.x : r.x; o.y = v.y < 0.f ? m.y : r.y; return o;
}

struct EpiProj {
    static constexpr bool PERM = true, AFTER_DRAIN = false;
    bf16_t* O; int ldc; const unsigned long long* ssq; const float* ssqf;
    unsigned long long* scr; unsigned* flag; int slot;
    __device__ __forceinline__ void operator()(f32x4 (&acc)[2][2][4][2], const Unit& u, int wr, int wc, int fr_, int fq_, PG8_LAS unsigned char*) const {
        int fr = fr_, fq = fq_; asm volatile("" : "+v"(fr), "+v"(fq));
        SPLITK_HANDOFF()
        const int row0 = u.pm * BM + wr * 64 + fr, col0 = u.pn * BM + wc * 32 + 8 * fq;
        float rsv[8];
        if (ssq) { unsigned long long q[8];
#pragma unroll
            for (int k = 0; k < 8; ++k) q[k] = ssq[row0 + (k >> 2) * HALF + (k & 3) * 16];
            asm volatile("" : "+v"(q[0]), "+v"(q[1]), "+v"(q[2]), "+v"(q[3]), "+v"(q[4]), "+v"(q[5]), "+v"(q[6]), "+v"(q[7]));
#pragma unroll
            for (int k = 0; k < 8; ++k) rsv[k] = __builtin_amdgcn_rsqf((float)q[k] * (1.0f / 1048576.0f / 4096.0f) + EPS);
        } else { float q[8];
#pragma unroll
            for (int k = 0; k < 8; ++k) q[k] = ssqf[row0 + (k >> 2) * HALF + (k & 3) * 16];
            asm volatile("" : "+v"(q[0]), "+v"(q[1]), "+v"(q[2]), "+v"(q[3]), "+v"(q[4]), "+v"(q[5]), "+v"(q[6]), "+v"(q[7]));
#pragma unroll
            for (int k = 0; k < 8; ++k) rsv[k] = __builtin_amdgcn_rsqf(q[k] * (1.0f / 4096.0f) + EPS);
        }
#pragma unroll
        for (int ai = 0; ai < 2; ++ai)
#pragma unroll
            for (int m = 0; m < 4; ++m) { const int row = row0 + ai * HALF + m * 16; const float rs = rsv[ai * 4 + m];
                bf16_t* rowp = O + (size_t)row * ldc + col0;
#pragma unroll
                for (int bj = 0; bj < 2; ++bj) { const f32x4 v0 = acc[ai][bj][m][0] * rs, v1 = acc[ai][bj][m][1] * rs;
                    u32x4 w; w.x = cvt_pk_bf16(v0[0], v0[1]); w.y = cvt_pk_bf16(v0[2], v0[3]); w.z = cvt_pk_bf16(v1[0], v1[1]); w.w = cvt_pk_bf16(v1[2], v1[3]);
                    *(u32x4*)(rowp + bj * HALF) = w; } }
    }
};
struct EpiNull {
    static constexpr bool PERM = true, AFTER_DRAIN = false;
    float* sink;
    __device__ __forceinline__ void operator()(f32x4 (&acc)[2][2][4][2], const Unit& u, int wr, int wc, int fr, int fq, PG8_LAS unsigned char*) const {
        float s = 0.f;
#pragma unroll
        for (int ai = 0; ai < 2; ++ai)
#pragma unroll
            for (int bj = 0; bj < 2; ++bj)
#pragma unroll
                for (int m = 0; m < 4; ++m)
#pragma unroll
                    for (int n = 0; n < 2; ++n) s += acc[ai][bj][m][n][0] + acc[ai][bj][m][n][1] + acc[ai][bj][m][n][2] + acc[ai][bj][m][n][3];
        if (s == 123456.789f) sink[u.pm + wr + wc + fr + fq] = s;
    }
};
struct EpiProjRope {
    static constexpr bool PERM = true, AFTER_DRAIN = false;
    bf16_t* O; const unsigned long long* ssq; const f32x2* rope; const float* qn; const float* kn;
    __device__ __forceinline__ void operator()(f32x4 (&acc)[2][2][4][2], const Unit& u, int wr, int wc, int fr_, int fq_, PG8_LAS unsigned char* xl) const {
        int fr = fr_, fq = fq_; asm volatile("" : "+v"(fr), "+v"(fq));
        const int row0 = u.pm * BM + wr * 64 + fr, col0 = u.pn * BM + wc * 32 + 8 * fq;
        const int kind = u.pn < 16 ? 1 : (u.pn >= 32 && u.pn < 42 ? 2 : 0);
        const int qp = 4 * wc + fq, hf = qp >> 3, fi = 4 * (qp & 7);
        float rsv[8];
        { unsigned long long q[8];
#pragma unroll
            for (int k = 0; k < 8; ++k) q[k] = ssq[row0 + (k >> 2) * HALF + (k & 3) * 16];
            asm volatile("" : "+v"(q[0]), "+v"(q[1]), "+v"(q[2]), "+v"(q[3]), "+v"(q[4]), "+v"(q[5]), "+v"(q[6]), "+v"(q[7]));
#pragma unroll
            for (int k = 0; k < 8; ++k) rsv[k] = __builtin_amdgcn_rsqf((float)q[k] * (1.0f / 1048576.0f / 4096.0f) + EPS); }
#pragma unroll
        for (int ai = 0; ai < 2; ++ai)
#pragma unroll
            for (int m = 0; m < 4; ++m) { const float rs = rsv[ai * 4 + m];
#pragma unroll
                for (int bj = 0; bj < 2; ++bj) { acc[ai][bj][m][0] *= rs; acc[ai][bj][m][1] *= rs; } }
        if (kind == 2) {
            PG8_LAS float* PART = (PG8_LAS float*)xl;
#pragma unroll
            for (int ai = 0; ai < 2; ++ai)
#pragma unroll
                for (int m = 0; m < 4; ++m)
#pragma unroll
                    for (int bj = 0; bj < 2; ++bj) { const f32x4 a = acc[ai][bj][m][0], b = acc[ai][bj][m][1];
                        float s = ((a[0] * a[0] + a[1] * a[1]) + (a[2] * a[2] + a[3] * a[3])) + ((b[0] * b[0] + b[1] * b[1]) + (b[2] * b[2] + b[3] * b[3]));
                        s += __shfl_xor(s, 16); s += __shfl_xor(s, 32);
                        if (fq == 0) PART[((ai * HALF + wr * 64 + m * 16 + fr) * 2 + bj) * 4 + wc] = s; }
            asm volatile("s_waitcnt lgkmcnt(0)" ::: "memory"); __builtin_amdgcn_s_barrier(); asm volatile("" ::: "memory");
            const float* gn = (u.pn < 40) ? qn : kn;
            const f32x4 g0 = *(const f32x4*)(gn + 64 * hf + fi), g1 = *(const f32x4*)(gn + 64 * hf + fi + 32);
#pragma unroll
            for (int ai = 0; ai < 2; ++ai)
#pragma unroll
                for (int m = 0; m < 4; ++m)
#pragma unroll
                    for (int bj = 0; bj < 2; ++bj) { const f32x4 ps = *(const PG8_LAS f32x4*)(PART + ((ai * HALF + wr * 64 + m * 16 + fr) * 2 + bj) * 4);
                        const float rh = __builtin_amdgcn_rsqf(((ps[0] + ps[1]) + (ps[2] + ps[3])) * (1.0f / 128.0f) + EPS);
                        acc[ai][bj][m][0] *= g0 * rh; acc[ai][bj][m][1] *= g1 * rh; }
        }
        f32x4 csa[8][2];
        if (kind != 0) {
#pragma unroll
            for (int k = 0; k < 8; ++k) { const int row = row0 + (k >> 2) * HALF + (k & 3) * 16; const int t = row < 8192 ? (row & 2047) : (row - 8192); const int pos = hf ? (t & 63) : (t >> 6);
                const f32x4* rp = (const f32x4*)(rope + pos * 32 + fi); csa[k][0] = rp[0]; csa[k][1] = rp[1]; }
            asm volatile("" : "+v"(csa[0][0]), "+v"(csa[0][1]), "+v"(csa[1][0]), "+v"(csa[1][1]), "+v"(csa[2][0]), "+v"(csa[2][1]), "+v"(csa[3][0]), "+v"(csa[3][1]));
            asm volatile("" : "+v"(csa[4][0]), "+v"(csa[4][1]), "+v"(csa[5][0]), "+v"(csa[5][1]), "+v"(csa[6][0]), "+v"(csa[6][1]), "+v"(csa[7][0]), "+v"(csa[7][1]));
        }
#pragma unroll
        for (int ai = 0; ai < 2; ++ai)
#pragma unroll
            for (int m = 0; m < 4; ++m) { const int row = row0 + ai * HALF + m * 16;
                bf16_t* rowp = O + (size_t)row * NIN + col0;
                f32x4 cs0 = {1.f, 0.f, 1.f, 0.f}, cs1 = cs0;
                if (kind != 0) { cs0 = csa[ai * 4 + m][0]; cs1 = csa[ai * 4 + m][1]; }
#pragma unroll
                for (int bj = 0; bj < 2; ++bj) { f32x4 v0 = acc[ai][bj][m][0], v1 = acc[ai][bj][m][1];
                    if (kind != 0) { const f32x4 c = {cs0[0], cs0[2], cs1[0], cs1[2]}, s = {cs0[1], cs0[3], cs1[1], cs1[3]};
                        const f32x4 y0 = v0 * c - v1 * s, y1 = v1 * c + v0 * s; v0 = y0; v1 = y1; }
                    u32x4 w; w.x = cvt_pk_bf16(v0[0], v0[1]); w.y = cvt_pk_bf16(v0[2], v0[3]); w.z = cvt_pk_bf16(v1[0], v1[1]); w.w = cvt_pk_bf16(v1[2], v1[3]);
                    __builtin_nontemporal_store(w, (u32x4*)(rowp + bj * HALF)); } }
    }
};
struct EpiRes {
    static constexpr bool PERM = true, AFTER_DRAIN = false;
    bf16_t* xb; unsigned long long* ssq_out;
    __device__ __forceinline__ void operator()(f32x4 (&acc)[2][2][4][2], const Unit& u, int wr, int wc, int fr_, int fq_, PG8_LAS unsigned char*) const {
        int fr = fr_, fq = fq_; asm volatile("" : "+v"(fr), "+v"(fq));
        const int row0 = u.pm * BM + wr * 64 + fr, col0 = u.pn * BM + wc * 32 + 8 * fq;
        u32x4 xv[2][4][2];
#pragma unroll
        for (int ai = 0; ai < 2; ++ai)
#pragma unroll
            for (int m = 0; m < 4; ++m)
#pragma unroll
                for (int bj = 0; bj < 2; ++bj) xv[ai][m][bj] = *(const u32x4*)(xb + (size_t)(row0 + ai * HALF + m * 16) * DM + col0 + bj * HALF);
        asm volatile("" : "+v"(xv[0][0][0]), "+v"(xv[0][0][1]), "+v"(xv[0][1][0]), "+v"(xv[0][1][1]), "+v"(xv[0][2][0]), "+v"(xv[0][2][1]), "+v"(xv[0][3][0]), "+v"(xv[0][3][1]));
        asm volatile("" : "+v"(xv[1][0][0]), "+v"(xv[1][0][1]), "+v"(xv[1][1][0]), "+v"(xv[1][1][1]), "+v"(xv[1][2][0]), "+v"(xv[1][2][1]), "+v"(xv[1][3][0]), "+v"(xv[1][3][1]));
#pragma unroll
        for (int ai = 0; ai < 2; ++ai) {
#pragma unroll
            for (int m = 0; m < 4; ++m) { const int row = row0 + ai * HALF + m * 16; bf16_t* rowp = xb + (size_t)row * DM + col0; float s = 0.f;
#pragma unroll
                for (int bj = 0; bj < 2; ++bj) { const u32x4 x = xv[ai][m][bj];
                    const f32x4 v0 = (f32x4){bf_lo(x.x), bf_hi(x.x), bf_lo(x.y), bf_hi(x.y)} + acc[ai][bj][m][0], v1 = (f32x4){bf_lo(x.z), bf_hi(x.z), bf_lo(x.w), bf_hi(x.w)} + acc[ai][bj][m][1];
                    u32x4 w; w.x = cvt_pk_bf16(v0[0], v0[1]); w.y = cvt_pk_bf16(v0[2], v0[3]); w.z = cvt_pk_bf16(v1[0], v1[1]); w.w = cvt_pk_bf16(v1[2], v1[3]);
                    *(u32x4*)(rowp + bj * HALF) = w;
                    s += ((v0[0] * v0[0] + v0[1] * v0[1]) + (v0[2] * v0[2] + v0[3] * v0[3])) + ((v1[0] * v1[0] + v1[1] * v1[1]) + (v1[2] * v1[2] + v1[3] * v1[3])); }
                s += __shfl_xor(s, 16); s += __shfl_xor(s, 32);
                if (fq == 0) __hip_atomic_fetch_add(ssq_out + row, (unsigned long long)(s * 1048576.0f + 0.5f), __ATOMIC_RELAXED, __HIP_MEMORY_SCOPE_AGENT); }
            asm volatile("" ::: "memory");
        }
    }
};
struct EpiResFinal {
    static constexpr bool PERM = true, AFTER_DRAIN = false;
    const bf16_t* xb; unsigned long long* ssq; unsigned* cnt; const float* gain; float* out;
    __device__ __forceinline__ void operator()(f32x4 (&acc)[2][2][4][2], const Unit& u, int wr, int wc, int fr_, int fq_, PG8_LAS unsigned char* xl) const {
        int fr = fr_, fq = fq_; asm volatile("" : "+v"(fr), "+v"(fq));
        const int row0 = u.pm * BM + wr * 64 + fr, col0 = u.pn * BM + wc * 32 + 8 * fq;
#pragma unroll
        for (int ai = 0; ai < 2; ++ai) {
            u32x4 xv[4][2];
#pragma unroll
            for (int m = 0; m < 4; ++m)
#pragma unroll
                for (int bj = 0; bj < 2; ++bj) xv[m][bj] = *(const u32x4*)(xb + (size_t)(row0 + ai * HALF + m * 16) * DM + col0 + bj * HALF);
#pragma unroll
            for (int m = 0; m < 4; ++m) { const int row = row0 + ai * HALF + m * 16; float s = 0.f;
#pragma unroll
                for (int bj = 0; bj < 2; ++bj) { const u32x4 x = xv[m][bj];
                    const f32x4 v0 = (f32x4){bf_lo(x.x), bf_hi(x.x), bf_lo(x.y), bf_hi(x.y)} + acc[ai][bj][m][0], v1 = (f32x4){bf_lo(x.z), bf_hi(x.z), bf_lo(x.w), bf_hi(x.w)} + acc[ai][bj][m][1];
                    acc[ai][bj][m][0] = v0; acc[ai][bj][m][1] = v1;
                    s += ((v0[0] * v0[0] + v0[1] * v0[1]) + (v0[2] * v0[2] + v0[3] * v0[3])) + ((v1[0] * v1[0] + v1[1] * v1[1]) + (v1[2] * v1[2] + v1[3] * v1[3])); }
                s += __shfl_xor(s, 16); s += __shfl_xor(s, 32);
                if (fq == 0) __hip_atomic_fetch_add(ssq + row, (unsigned long long)(s * 1048576.0f + 0.5f), __ATOMIC_RELAXED, __HIP_MEMORY_SCOPE_AGENT); }
            asm volatile("" ::: "memory");
        }
        f32x4 g[2][2];
#pragma unroll
        for (int bj = 0; bj < 2; ++bj) { g[bj][0] = *(const f32x4*)(gain + col0 + bj * HALF); g[bj][1] = *(const f32x4*)(gain + col0 + bj * HALF + 4); }
        asm volatile("s_waitcnt vmcnt(0)" ::: "memory"); __builtin_amdgcn_s_barrier(); asm volatile("" ::: "memory");
        PG8_LAS float* RS = (PG8_LAS float*)xl;
        if (wr == 0 && wc == 0) {
            unsigned* c = cnt + u.pm * 16;
            if (fq == 0 && fr == 0) __hip_atomic_fetch_add(c, 1u, __ATOMIC_RELAXED, __HIP_MEMORY_SCOPE_AGENT);
            unsigned sp = 0;
            while ((unsigned)__builtin_amdgcn_readfirstlane(__hip_atomic_load(c, __ATOMIC_RELAXED, __HIP_MEMORY_SCOPE_AGENT)) < 16u) { __builtin_amdgcn_s_sleep(2); if (++sp > (1u << 20)) break; }
            __builtin_amdgcn_fence(__ATOMIC_ACQUIRE, "agent");
            const unsigned long long* p = ssq + u.pm * BM + (fq * 16 + fr); unsigned long long s0, s1, s2, s3;
            asm volatile("global_load_dwordx2 %0, %4, off sc1\n\tglobal_load_dwordx2 %1, %4, off offset:512 sc1\n\tglobal_load_dwordx2 %2, %4, off offset:1024 sc1\n\tglobal_load_dwordx2 %3, %4, off offset:1536 sc1\n\ts_waitcnt vmcnt(0)"
                         : "=&v"(s0), "=&v"(s1), "=&v"(s2), "=&v"(s3) : "v"(p) : "memory");
            const int l64 = fq * 16 + fr;
            RS[l64] = __builtin_amdgcn_rsqf((float)s0 * (1.0f / 1048576.0f / 4096.0f) + EPS); RS[64 + l64] = __builtin_amdgcn_rsqf((float)s1 * (1.0f / 1048576.0f / 4096.0f) + EPS);
            RS[128 + l64] = __builtin_amdgcn_rsqf((float)s2 * (1.0f / 1048576.0f / 4096.0f) + EPS); RS[192 + l64] = __builtin_amdgcn_rsqf((float)s3 * (1.0f / 1048576.0f / 4096.0f) + EPS);
        }
        __syncthreads();
#pragma unroll
        for (int ai = 0; ai < 2; ++ai)
#pragma unroll
            for (int m = 0; m < 4; ++m) { const int rt = wr * 64 + fr + ai * HALF + m * 16; const float rs = RS[rt]; float* rowp = out + (size_t)(u.pm * BM + rt) * DM + col0;
#pragma unroll
                for (int bj = 0; bj < 2; ++bj) { __builtin_nontemporal_store(acc[ai][bj][m][0] * rs * g[bj][0], (f32x4*)(rowp + bj * HALF)); __builtin_nontemporal_store(acc[ai][bj][m][1] * rs * g[bj][1], (f32x4*)(rowp + bj * HALF + 4)); } }
    }
};
struct EpiConv {
    static constexpr bool PERM = true, AFTER_DRAIN = false;
    unsigned char* ws; size_t gh_off, hb_off, ssq_off; const float* cw; const float* cb; unsigned long long* scr; unsigned* flag; int slot;
    __device__ __forceinline__ void operator()(f32x4 (&acc)[2][2][4][2], const Unit& u, int wr, int wc, int fr_, int fq_, PG8_LAS unsigned char* xl) const {
        int fr = fr_, fq = fq_; asm volatile("" : "+v"(fr), "+v"(fq));
        PG8_LAS float* BND = (PG8_LAS float*)xl;
        bf16_t* GH = (bf16_t*)(ws + gh_off); float* HB = (float*)(ws + hb_off); const unsigned long long* ssq = (const unsigned long long*)(ws + ssq_off);
        const int colw = wc * 32 + 8 * fq;
        SPLITK_HANDOFF()
        PG8_LAS float* CW = (PG8_LAS float*)(xl + 8192);
        const int cwi = (((wr * 4 + wc) * 4 + fq) * 16 + fr) * 2, cwa = cwi >> 8, cwh = (cwi >> 7) & 1, cwc = cwi & 127;
        const f32x2 cwreg = *(const f32x2*)((cwa < 3 ? cw + cwa * NUP : cb) + cwh * DFF + u.pn * 128 + cwc);
        float rsv[8];
        { unsigned long long q[8]; const int row0 = u.pm * BM + wr * 64 + fr;
#pragma unroll
            for (int k = 0; k < 8; ++k) q[k] = ssq[row0 + (k >> 2) * HALF + (k & 3) * 16];
            asm volatile("" : "+v"(q[0]), "+v"(q[1]), "+v"(q[2]), "+v"(q[3]), "+v"(q[4]), "+v"(q[5]), "+v"(q[6]), "+v"(q[7]));
#pragma unroll
            for (int k = 0; k < 8; ++k) rsv[k] = __builtin_amdgcn_rsqf((float)q[k] * (1.0f / 1048576.0f / 4096.0f) + EPS); }
#pragma unroll
        for (int ai = 0; ai < 2; ++ai)
#pragma unroll
            for (int m = 0; m < 4; ++m) { const float rs = rsv[ai * 4 + m];
#pragma unroll
                for (int bj = 0; bj < 2; ++bj)
#pragma unroll
                    for (int n = 0; n < 2; ++n) acc[ai][bj][m][n] *= rs;
                asm volatile("" : "+v"(acc[ai][0][m][0]), "+v"(acc[ai][0][m][1]), "+v"(acc[ai][1][m][0]), "+v"(acc[ai][1][m][1])); }
#pragma unroll
        for (int ai = 0; ai < 2; ++ai)
#pragma unroll
            for (int bj = 0; bj < 2; ++bj)
#pragma unroll
                for (int n = 0; n < 2; ++n) {
                    if (fr == 0)  *(PG8_LAS f32x4*)(BND + ((((ai * 2 + wr) * 2 + 0) * 2 + bj) * 128) + colw + 4 * n) = acc[ai][bj][0][n];
                    if (fr == 15) *(PG8_LAS f32x4*)(BND + ((((ai * 2 + wr) * 2 + 1) * 2 + bj) * 128) + colw + 4 * n) = acc[ai][bj][3][n];
                }
        if (wr == 0 && fr < 2) {
#pragma unroll
            for (int bj = 0; bj < 2; ++bj)
#pragma unroll
                for (int n = 0; n < 2; ++n) *(f32x4*)(HB + (size_t)(u.pm * 4 + fr) * NUP + bj * DFF + u.pn * 128 + colw + 4 * n) = acc[0][bj][0][n];
        }
        if (wr == 1 && fr >= 14) {
#pragma unroll
            for (int bj = 0; bj < 2; ++bj)
#pragma unroll
                for (int n = 0; n < 2; ++n) *(f32x4*)(HB + (size_t)(u.pm * 4 + 2 + (fr - 14)) * NUP + bj * DFF + u.pn * 128 + colw + 4 * n) = acc[1][bj][3][n];
        }
        *(PG8_LAS f32x2*)(CW + cwi) = cwreg;
        asm volatile("s_waitcnt lgkmcnt(0)" ::: "memory"); __builtin_amdgcn_s_barrier(); asm volatile("" ::: "memory");
#define DPPF(oldv, srcv, ctrl) __builtin_bit_cast(float, __builtin_amdgcn_update_dpp(__builtin_bit_cast(int, (float)(oldv)), __builtin_bit_cast(int, (float)(srcv)), (ctrl), 0xf, 0xf, false))
#pragma unroll
        for (int bj = 0; bj < 2; ++bj)
#pragma unroll
            for (int n = 0; n < 2; ++n) {
                const f32x4 w0 = *(const PG8_LAS f32x4*)(CW + (0 * 2 + bj) * 128 + colw + 4 * n), w1 = *(const PG8_LAS f32x4*)(CW + (1 * 2 + bj) * 128 + colw + 4 * n), w2 = *(const PG8_LAS f32x4*)(CW + (2 * 2 + bj) * 128 + colw + 4 * n), bb = *(const PG8_LAS f32x4*)(CW + (3 * 2 + bj) * 128 + colw + 4 * n);
#pragma unroll
                for (int ai = 0; ai < 2; ++ai) {
                    f32x4 pv = {0.f, 0.f, 0.f, 0.f}, nv = pv;
                    if (wr == 1) pv = *(PG8_LAS f32x4*)(BND + ((((ai * 2 + 0) * 2 + 1) * 2 + bj) * 128) + colw + 4 * n);
                    else if (ai == 1) pv = *(PG8_LAS f32x4*)(BND + ((((0 * 2 + 1) * 2 + 1) * 2 + bj) * 128) + colw + 4 * n);
                    if (wr == 0) nv = *(PG8_LAS f32x4*)(BND + ((((ai * 2 + 1) * 2 + 0) * 2 + bj) * 128) + colw + 4 * n);
                    else if (ai == 0) nv = *(PG8_LAS f32x4*)(BND + ((((1 * 2 + 0) * 2 + 0) * 2 + bj) * 128) + colw + 4 * n);
#pragma unroll
                    for (int j = 0; j < 4; ++j) {
                        const float c0 = acc[ai][bj][0][n][j], c1 = acc[ai][bj][1][n][j], c2 = acc[ai][bj][2][n][j], c3 = acc[ai][bj][3][n][j];
                        const float u0 = DPPF(pv[j], c0, 0x111), u1 = DPPF(DPPF(0.f, c0, 0x121), c1, 0x111), u2 = DPPF(DPPF(0.f, c1, 0x121), c2, 0x111), u3 = DPPF(DPPF(0.f, c2, 0x121), c3, 0x111);
                        const float d0 = DPPF(DPPF(0.f, c1, 0x12f), c0, 0x101), d1 = DPPF(DPPF(0.f, c2, 0x12f), c1, 0x101), d2 = DPPF(DPPF(0.f, c3, 0x12f), c2, 0x101), d3 = DPPF(nv[j], c3, 0x101);
                        acc[ai][bj][0][n][j] = w0[j] * u0 + w1[j] * c0 + w2[j] * d0 + bb[j];
                        acc[ai][bj][1][n][j] = w0[j] * u1 + w1[j] * c1 + w2[j] * d1 + bb[j];
                        acc[ai][bj][2][n][j] = w0[j] * u2 + w1[j] * c2 + w2[j] * d2 + bb[j];
                        acc[ai][bj][3][n][j] = w0[j] * u3 + w1[j] * c3 + w2[j] * d3 + bb[j];
                    }
                    asm volatile("" : "+v"(acc[ai][bj][0][n]), "+v"(acc[ai][bj][1][n]), "+v"(acc[ai][bj][2][n]), "+v"(acc[ai][bj][3][n]));
                }
            }
#undef DPPF
#pragma unroll
        for (int ai = 0; ai < 2; ++ai)
#pragma unroll
            for (int m = 0; m < 4; ++m) {
                const int row = u.pm * BM + ai * HALF + wr * 64 + m * 16 + fr;
                const f32x4 a0 = acc[ai][0][m][0], a1 = acc[ai][0][m][1], u0 = acc[ai][1][m][0], u1 = acc[ai][1][m][1];
                const f32x2 g0 = gelu_pk((f32x2){a0[0], a0[1]}), g1 = gelu_pk((f32x2){a0[2], a0[3]}), g2 = gelu_pk((f32x2){a1[0], a1[1]}), g3 = gelu_pk((f32x2){a1[2], a1[3]});
                u32x4 w; w.x = cvt_pk_bf16(g0.x * u0[0], g0.y * u0[1]); w.y = cvt_pk_bf16(g1.x * u0[2], g1.y * u0[3]); w.z = cvt_pk_bf16(g2.x * u1[0], g2.y * u1[1]); w.w = cvt_pk_bf16(g3.x * u1[2], g3.y * u1[3]);
                __builtin_nontemporal_store(w, (u32x4*)(GH + (size_t)row * DFF + u.pn * 128 + colw));
            }
    }
};
template <class Epi, class Sched, bool ALIGN_EPI = false, bool SP2 = false, int BAUX = 0  >
__device__ __forceinline__ void gemm_phase(PG8_LAS unsigned char* lds, PG8_LAS unsigned char* xlds, const Gemm g, const Sched& S, const Epi& E) {
    int tid_ = threadIdx.x; asm volatile("" : "+v"(tid_)); const int tid = tid_, wid = __builtin_amdgcn_readfirstlane(tid >> 6), lane = tid & 63, wr = wid >> 2, wc = wid & 3, fr = lane & 15, fq = lane >> 4;
    const int K = g.K, nt = K / BK;
    unsigned voffA[2], voffB[2];
#pragma unroll
    for (int i = 0; i < 2; ++i) { int R, C; stage_rc(tid * 16 + i * 8192, R, C); const int Rb = Epi::PERM ? ((R & ~31) + perm32(R & 31)) : R;
        voffA[i] = (unsigned)(R * K + C) * 2u; voffB[i] = (unsigned)(Rb * K + C) * 2u; }
    const size_t kstep = (size_t)(BK * 2);
    const size_t hstep = (size_t)HALF * K * 2;
    const size_t tstep = 2 * hstep;
    const unsigned ldsw = (unsigned)wid * 1024u;
    const int aoff = lds_byte(wr * 64 + fr, fq * 8), boff = lds_byte(wc * 32 + fr, fq * 8);
#define PG8_SA(b, h) (((b) * 2 + (h)) * HTB)
#define PG8_SB(b, h) ((4 + (b) * 2 + (h)) * HTB)
#define PG8_STAGE(bufoff, gbase, voff) do { _Pragma("unroll") for (int _i = 0; _i < 2; ++_i) \
        __builtin_amdgcn_global_load_lds((const unsigned*)((const char*)(gbase) + (voff)[_i]), (PG8_LAS unsigned*)(lds + (bufoff) + ldsw + _i * 8192), 16, 0, 0); } while (0)
#define PG8_STAGEB(bufoff, gbase, voff) do { _Pragma("unroll") for (int _i = 0; _i < 2; ++_i) \
        __builtin_amdgcn_global_load_lds((const unsigned*)((const char*)(gbase) + (voff)[_i]), (PG8_LAS unsigned*)(lds + (bufoff) + ldsw + _i * 8192), 16, 0, BAUX); } while (0)
#define PG8_LDA(dst, b, h) do { _Pragma("unroll") for (int m = 0; m < 4; ++m) _Pragma("unroll") for (int k = 0; k < 2; ++k) dst[m][k] = *(const PG8_LAS bf16x8*)(lds + PG8_SA(b, h) + aoff + m * 2048 + k * 1024); } while (0)
#define PG8_LDB(dst, b, h) do { _Pragma("unroll") for (int n = 0; n < 2; ++n) _Pragma("unroll") for (int k = 0; k < 2; ++k) dst[n][k] = *(const PG8_LAS bf16x8*)(lds + PG8_SB(b, h) + boff + n * 2048 + k * 1024); } while (0)
#define PG8_MMA(ai, bj, At, Bt) do { __builtin_amdgcn_s_setprio(1); _Pragma("unroll") for (int m = 0; m < 4; ++m) _Pragma("unroll") for (int n = 0; n < 2; ++n) _Pragma("unroll") for (int k = 0; k < 2; ++k) \
        acc[ai][bj][m][n] = __builtin_amdgcn_mfma_f32_16x16x32_bf16(Bt[n][k], At[m][k], acc[ai][bj][m][n], 0, 0, 0); __builtin_amdgcn_s_setprio(0); } while (0)
#define PG8_WAIT_V(n) asm volatile("s_waitcnt vmcnt(" #n ")" ::: "memory")
#define PG8_WAIT_L(n) asm volatile("s_waitcnt lgkmcnt(" #n ")" ::: "memory")
#define PG8_BAR __builtin_amdgcn_s_barrier()
#define PG8_SCHED __builtin_amdgcn_sched_barrier(0)
    Unit cur, nxt; int ui = 0;
    if (!S.next(0, cur)) return;
    f32x4 acc[2][2][4][2];
#pragma unroll
    for (int a = 0; a < 2; ++a)
#pragma unroll
        for (int b = 0; b < 2; ++b)
#pragma unroll
            for (int m = 0; m < 4; ++m)
#pragma unroll
                for (int n = 0; n < 2; ++n) acc[a][b][m][n] = (f32x4){0.f, 0.f, 0.f, 0.f};
    bf16x8 At[4][2], B0[2][2], B1[2][2];
    const char* cA = (const char*)g.A + (size_t)cur.pm * tstep + (size_t)cur.kt0 * kstep; const char* cB = (const char*)g.Bt + (size_t)cur.pn * tstep + (size_t)cur.kt0 * kstep;
    S.a_ready(cur);
    if constexpr (SP2) {
        PG8_STAGEB(PG8_SB(0, 0), cB, voffB); PG8_STAGEB(PG8_SB(0, 1), cB + hstep, voffB); PG8_STAGE(PG8_SA(0, 0), cA, voffA); PG8_STAGE(PG8_SA(0, 1), cA + hstep, voffA);
        if (wr == 1) PG8_BAR;
        PG8_WAIT_V(2); PG8_BAR;
        PG8_STAGEB(PG8_SB(1, 0), cB + kstep, voffB); PG8_STAGE(PG8_SA(1, 0), cA + kstep, voffA); PG8_STAGEB(PG8_SB(1, 1), cB + hstep + kstep, voffB);
        PG8_WAIT_V(6); PG8_BAR;
    } else {
        PG8_STAGEB(PG8_SB(0, 0), cB, voffB); PG8_STAGE(PG8_SA(0, 0), cA, voffA); PG8_STAGEB(PG8_SB(0, 1), cB + hstep, voffB); PG8_STAGE(PG8_SA(0, 1), cA + hstep, voffA);
        if (wr == 1) PG8_BAR;
        PG8_WAIT_V(4); PG8_BAR;
        PG8_STAGEB(PG8_SB(1, 0), cB + kstep, voffB); PG8_STAGE(PG8_SA(1, 0), cA + kstep, voffA); PG8_STAGEB(PG8_SB(1, 1), cB + hstep + kstep, voffB);
        PG8_WAIT_V(6); PG8_BAR;
    }
    for (;;) {
        const bool has_next = S.next(ui + 1, nxt);
        const char* nA = has_next ? (const char*)g.A + (size_t)nxt.pm * tstep + (size_t)nxt.kt0 * kstep : cA; const char* nB = has_next ? (const char*)g.Bt + (size_t)nxt.pn * tstep + (size_t)nxt.kt0 * kstep : cB;
        const int ntu = cur.nkt ? cur.nkt : nt;
        for (int t = 0; t < ntu; t += 2) {
            const bool last = (t == ntu - 2);
            const char* a1 = cA + (size_t)(t + 1) * kstep;
            const char* a2 = last ? nA : cA + (size_t)(t + 2) * kstep; const char* b2 = last ? nB : cB + (size_t)(t + 2) * kstep;
            const char* a3 = a2 + kstep; const char* b3 = b2 + kstep;
            if (last && has_next) S.a_ready(nxt);
            if constexpr (SP2) {
            PG8_LDB(B0, 0, 0); PG8_LDB(B1, 0, 1); PG8_SCHED; PG8_LDA(At, 0, 0); PG8_STAGE(PG8_SA(1, 1), a1 + hstep, voffA);
            PG8_WAIT_V(8); PG8_WAIT_L(0); PG8_BAR; PG8_MMA(0, 0, At, B0); PG8_MMA(0, 1, At, B1); PG8_BAR; PG8_SCHED;
            PG8_LDA(At, 0, 1); PG8_STAGEB(PG8_SB(0, 0), b2, voffB); PG8_STAGEB(PG8_SB(0, 1), b2 + hstep, voffB); PG8_STAGE(PG8_SA(0, 0), a2, voffA);
            PG8_WAIT_V(8); PG8_WAIT_L(0); PG8_BAR; PG8_MMA(1, 0, At, B0); PG8_MMA(1, 1, At, B1); PG8_BAR; PG8_SCHED;
            PG8_LDB(B0, 1, 0); PG8_LDB(B1, 1, 1); PG8_SCHED; PG8_LDA(At, 1, 0); PG8_STAGE(PG8_SA(0, 1), a2 + hstep, voffA);
            PG8_WAIT_V(8); PG8_WAIT_L(0); PG8_BAR; PG8_MMA(0, 0, At, B0); PG8_MMA(0, 1, At, B1); PG8_BAR; PG8_SCHED;
            PG8_LDA(At, 1, 1); PG8_STAGEB(PG8_SB(1, 0), b3, voffB); PG8_STAGEB(PG8_SB(1, 1), b3 + hstep, voffB); PG8_STAGE(PG8_SA(1, 0), a3, voffA);
            PG8_WAIT_V(8); PG8_WAIT_L(0); PG8_BAR; PG8_MMA(1, 0, At, B0); PG8_MMA(1, 1, At, B1); PG8_BAR; PG8_SCHED;
            } else {
            PG8_LDB(B0, 0, 0); PG8_SCHED; PG8_LDA(At, 0, 0); PG8_STAGE(PG8_SA(1, 1), a1 + hstep, voffA);
            PG8_WAIT_L(8); PG8_BAR; PG8_WAIT_L(0); PG8_MMA(0, 0, At, B0); PG8_BAR; PG8_SCHED;
            PG8_LDB(B1, 0, 1); PG8_STAGEB(PG8_SB(0, 0), b2, voffB);
            PG8_BAR; PG8_WAIT_L(0); PG8_MMA(0, 1, At, B1); PG8_BAR;
            PG8_LDA(At, 0, 1); PG8_STAGE(PG8_SA(0, 0), a2, voffA);
            PG8_BAR; PG8_WAIT_L(0); PG8_MMA(1, 0, At, B0); PG8_BAR; PG8_SCHED;
            PG8_STAGEB(PG8_SB(0, 1), b2 + hstep, voffB);
            PG8_WAIT_V(6); PG8_BAR; PG8_MMA(1, 1, At, B1); PG8_BAR;
            PG8_LDB(B0, 1, 0); PG8_SCHED; PG8_LDA(At, 1, 0); PG8_STAGE(PG8_SA(0, 1), a2 + hstep, voffA);
            PG8_WAIT_L(8); PG8_BAR; PG8_WAIT_L(0); PG8_MMA(0, 0, At, B0); PG8_BAR; PG8_SCHED;
            PG8_LDB(B1, 1, 1); PG8_STAGEB(PG8_SB(1, 0), b3, voffB);
            PG8_BAR; PG8_WAIT_L(0); PG8_MMA(0, 1, At, B1); PG8_BAR;
            PG8_LDA(At, 1, 1); PG8_STAGE(PG8_SA(1, 0), a3, voffA);
            PG8_BAR; PG8_WAIT_L(0); PG8_MMA(1, 0, At, B0); PG8_BAR; PG8_SCHED;
            PG8_STAGEB(PG8_SB(1, 1), b3 + hstep, voffB);
            PG8_WAIT_V(6); PG8_BAR; PG8_MMA(1, 1, At, B1); PG8_BAR;
            }
        }
        if constexpr (ALIGN_EPI) { if (wr == 0) PG8_BAR; }
#if PT_EPI
        { const unsigned long long t0_ = wall_clock64(); E(acc, cur, wr, wc, fr, fq, xlds); const unsigned long long t1_ = wall_clock64();
          if (tid == 0) *(PG8_LAS unsigned long long*)(lds + 143360 + 64) += t1_ - t0_; } S.done(cur);
#else
        E(acc, cur, wr, wc, fr, fq, xlds); S.done(cur);
#endif
        if (!has_next) break;
#pragma unroll
        for (int a = 0; a < 2; ++a)
#pragma unroll
            for (int b = 0; b < 2; ++b)
#pragma unroll
                for (int m = 0; m < 4; ++m)
#pragma unroll
                    for (int n = 0; n < 2; ++n) acc[a][b][m][n] = (f32x4){0.f, 0.f, 0.f, 0.f};
        cur = nxt; cA = nA; cB = nB; ++ui;
        if constexpr (ALIGN_EPI) { if (wr == 1) PG8_BAR; }
    }
    PG8_WAIT_V(0);
    if constexpr (!ALIGN_EPI) { if (wr == 0) PG8_BAR; }
    PG8_BAR;
#undef PG8_SA
#undef PG8_SB
#undef PG8_STAGE
#undef PG8_STAGEB
#undef PG8_LDA
#undef PG8_LDB
#undef PG8_MMA
#undef PG8_WAIT_V
#undef PG8_WAIT_L
#undef PG8_BAR
#undef PG8_SCHED
}
}

namespace att {
constexpr int D = 128, NW = 8, QBLK = 32, KVBLK = 64;
constexpr float SCALE = 0.088388347648318440f;
constexpr float THR = 8.f;
constexpr int SHM_V = KVBLK * D * 2, SHM_K = KVBLK * D * 2, SHM_ATTN = 2 * SHM_V + 2 * SHM_K + NW * 64 * 4;
#define KSWZ(row, colB) ((row) * 256 + ((colB) ^ (((row) & 7) << 4)))
#define SBAR() __builtin_amdgcn_sched_barrier(0)
__device__ __forceinline__ int crow(int r, int hi) { return (r & 3) + 8 * (r >> 2) + 4 * hi; }
__device__ __forceinline__ unsigned cvtpk(float lo, float hi) { unsigned r; asm volatile("v_cvt_pk_bf16_f32 %0, %1, %2" : "=v"(r) : "v"(lo), "v"(hi)); return r; }

template <bool FIXM, bool NOEXP = false> __device__ __forceinline__ void partialSM(f32x16& p0, f32x16& p1, float& m_reg, float& mn, float& alpha, float mshC) {
  constexpr float C = SCALE * 1.4426950408889634f;
  if constexpr (FIXM) {
    alpha = 1.f; mn = 0.f; if constexpr (NOEXP) return;
#pragma unroll
    for (int r = 0; r < 16; ++r) p0[r] = __builtin_amdgcn_exp2f(p0[r]);
    return;
  }
  float pmax = p0[0];
#pragma unroll
  for (int r = 1; r < 16; ++r) pmax = fmaxf(pmax, p0[r]);
#pragma unroll
  for (int r = 0; r < 16; ++r) pmax = fmaxf(pmax, p1[r]);
  { auto rr = __builtin_amdgcn_permlane32_swap(__float_as_uint(pmax), __float_as_uint(pmax), false, false);
    pmax = fmaxf(__uint_as_float(rr[0]), __uint_as_float(rr[1])); }
  if (__builtin_expect(__all(pmax - m_reg <= THR / SCALE), 1)) { mn = m_reg; alpha = 1.f; }
  else { mn = fmaxf(m_reg, pmax); alpha = __builtin_amdgcn_exp2f((m_reg - mn) * C); m_reg = mn; }
  float mnC = -mn * C;
#pragma unroll
  for (int r = 0; r < 16; ++r) p0[r] = fmaf(p0[r], C, mnC);
#pragma unroll
  for (int r = 0; r < 16; ++r) p1[r] = fmaf(p1[r], C, mnC);
#pragma unroll
  for (int r = 0; r < 16; ++r) p0[r] = __builtin_amdgcn_exp2f(p0[r]);
}
__device__ __forceinline__ void finishSM(f32x16& p0, f32x16& p1, float alpha, float& l_reg, bf16x8& pa0, bf16x8& pa1, bf16x8& pa2, bf16x8& pa3) {
#pragma unroll
  for (int r = 0; r < 16; ++r) p1[r] = __builtin_amdgcn_exp2f(p1[r]);
  float ps = 0;
#pragma unroll
  for (int r = 0; r < 16; ++r) ps += p0[r];
#pragma unroll
  for (int r = 0; r < 16; ++r) ps += p1[r];
  { auto rr = __builtin_amdgcn_permlane32_swap(__float_as_uint(ps), __float_as_uint(ps), false, false);
    ps = __uint_as_float(rr[0]) + __uint_as_float(rr[1]); }
  l_reg = l_reg * alpha + ps;
#define PK4(P, BASE, OUT) do { unsigned a0 = cvtpk(P[BASE + 0], P[BASE + 1]), a1 = cvtpk(P[BASE + 2], P[BASE + 3]);   \
    unsigned b0 = cvtpk(P[BASE + 4], P[BASE + 5]), b1 = cvtpk(P[BASE + 6], P[BASE + 7]);                              \
    auto r0 = __builtin_amdgcn_permlane32_swap(a0, b0, false, false); auto r1 = __builtin_amdgcn_permlane32_swap(a1, b1, false, false); \
    u32x4 w = {r0[0], r1[0], r0[1], r1[1]}; OUT = *reinterpret_cast<bf16x8*>(&w); } while (0)
  PK4(p0, 0, pa0); PK4(p0, 8, pa1); PK4(p1, 0, pa2); PK4(p1, 8, pa3);
#undef PK4
}
__device__ __forceinline__ void qkt(f32x16& p0, f32x16& p1, const LAS unsigned char* Ks, const bf16x8* qr, int r32, int hi, float init = 0.f) {
#pragma unroll
  for (int r = 0; r < 16; ++r) { p0[r] = init; p1[r] = init; }
#pragma unroll
  for (int d0 = 0; d0 < 8; ++d0) { int cb = (d0 * 16 + hi * 8) * 2;
    bf16x8 b0 = *reinterpret_cast<const LAS bf16x8*>(Ks + KSWZ(r32, cb));
    bf16x8 b1 = *reinterpret_cast<const LAS bf16x8*>(Ks + KSWZ(32 + r32, cb));
    p0 = __builtin_amdgcn_mfma_f32_32x32x16_bf16(b0, qr[d0], p0, 0, 0, 0);
    p1 = __builtin_amdgcn_mfma_f32_32x32x16_bf16(b1, qr[d0], p1, 0, 0, 0); }
}
#define QF_PK4(P, BASE, OUT) do { unsigned a0 = cvtpk(P[BASE + 0], P[BASE + 1]), a1 = cvtpk(P[BASE + 2], P[BASE + 3]);   \
    unsigned b0 = cvtpk(P[BASE + 4], P[BASE + 5]), b1 = cvtpk(P[BASE + 6], P[BASE + 7]);                              \
    auto r0 = __builtin_amdgcn_permlane32_swap(a0, b0, false, false); auto r1 = __builtin_amdgcn_permlane32_swap(a1, b1, false, false); \
    u32x4 w = {r0[0], r1[0], r0[1], r1[1]}; OUT = *reinterpret_cast<bf16x8*>(&w); } while (0)
#define QF_KRD(D0, X0, X1) do { X0 = *reinterpret_cast<const LAS bf16x8*>(Ks + KSWZ(r32, ((D0) * 16 + hi * 8) * 2)); X1 = *reinterpret_cast<const LAS bf16x8*>(Ks + KSWZ(32 + r32, ((D0) * 16 + hi * 8) * 2)); } while (0)
#define QF_STEP(D0, X0, X1) do { SBAR(); q0 = __builtin_amdgcn_mfma_f32_32x32x16_bf16(X0, qr[D0], q0, 0, 0, 0); q1 = __builtin_amdgcn_mfma_f32_32x32x16_bf16(X1, qr[D0], q1, 0, 0, 0); \
    if ((D0) + 2 < 8) QF_KRD((D0) + 2, X0, X1);                                                                                                                       \
    p1[2 * (D0)] = __builtin_amdgcn_exp2f(p1[2 * (D0)]); p1[2 * (D0) + 1] = __builtin_amdgcn_exp2f(p1[2 * (D0) + 1]); psa += p0[2 * (D0)]; psb += p0[2 * (D0) + 1];     \
    if ((D0) >= 1) { psa += p1[2 * (D0) - 2]; psb += p1[2 * (D0) - 1]; }                                                                                              \
    if ((D0) == 0) QF_PK4(p0, 0, pa0); if ((D0) == 1) QF_PK4(p0, 8, pa1); if ((D0) == 5) QF_PK4(p1, 0, pa2); } while (0)
__device__ __forceinline__ void qk_fin(f32x16& q0, f32x16& q1, const LAS unsigned char* Ks, const bf16x8* qr, int r32, int hi,
                                       f32x16& p0, f32x16& p1, float& l_reg, bf16x8& pa0, bf16x8& pa1, bf16x8& pa2, bf16x8& pa3) {
#pragma unroll
  for (int r = 0; r < 16; ++r) { q0[r] = 0.f; q1[r] = 0.f; }
  bf16x8 ka0, ka1, kb0, kb1; float psa = 0.f, psb = 0.f;
  QF_KRD(0, ka0, ka1); QF_KRD(1, kb0, kb1);
  QF_STEP(0, ka0, ka1); QF_STEP(1, kb0, kb1); QF_STEP(2, ka0, ka1); QF_STEP(3, kb0, kb1); QF_STEP(4, ka0, ka1); QF_STEP(5, kb0, kb1); QF_STEP(6, ka0, ka1); QF_STEP(7, kb0, kb1);
  SBAR();
  psa += p1[14]; psb += p1[15]; QF_PK4(p1, 8, pa3);
  float ps = psa + psb;
  { auto rr = __builtin_amdgcn_permlane32_swap(__float_as_uint(ps), __float_as_uint(ps), false, false);
    ps = __uint_as_float(rr[0]) + __uint_as_float(rr[1]); }
  l_reg += ps;
}
#undef QF_PK4
#undef QF_KRD
#undef QF_STEP
__device__ __forceinline__ int v_st(int k, int c) { const int kk = (k & ~0xC) | ((k & 4) << 1) | ((k & 8) >> 1); return ((kk >> 3) * 4 + (c >> 5)) * 512 + ((kk & 7) * 32 + (c & 31)) * 2; }
__device__ __forceinline__ int v_rd_base(int lane) { return ((lane & 3) << 3) | (((lane >> 2) & 3) << 6) | (((lane >> 4) & 1) << 5) | (((lane >> 5) & 1) << 8); }
constexpr int v_rd_off(int d0, int ks, int half) { return d0 * 512 + ks * 4096 + half * 2048; }
template <int OFF> __device__ __forceinline__ s16x4 tr_read(int vb) {
  s16x4 r; asm volatile("ds_read_b64_tr_b16 %0, %1 offset:%2" : "=&v"(r) : "v"(vb), "i"(OFF) : "memory"); return r;
}
template <int D0> __device__ __forceinline__ void pv_one(f32x16& od, int vb, bf16x8 pa0, bf16x8 pa1, bf16x8 pa2, bf16x8 pa3) {
  const s16x4 l0 = tr_read<v_rd_off(D0, 0, 0)>(vb), h0 = tr_read<v_rd_off(D0, 0, 1)>(vb), l1 = tr_read<v_rd_off(D0, 1, 0)>(vb), h1 = tr_read<v_rd_off(D0, 1, 1)>(vb);
  const s16x4 l2 = tr_read<v_rd_off(D0, 2, 0)>(vb), h2 = tr_read<v_rd_off(D0, 2, 1)>(vb), l3 = tr_read<v_rd_off(D0, 3, 0)>(vb), h3 = tr_read<v_rd_off(D0, 3, 1)>(vb);
  asm volatile("s_waitcnt lgkmcnt(0)" ::: "memory"); SBAR();
#define PK(L, H) (bf16x8){L[0], L[1], L[2], L[3], H[0], H[1], H[2], H[3]}
  od = __builtin_amdgcn_mfma_f32_32x32x16_bf16(pa0, PK(l0, h0), od, 0, 0, 0);
  od = __builtin_amdgcn_mfma_f32_32x32x16_bf16(pa1, PK(l1, h1), od, 0, 0, 0);
  od = __builtin_amdgcn_mfma_f32_32x32x16_bf16(pa2, PK(l2, h2), od, 0, 0, 0);
  od = __builtin_amdgcn_mfma_f32_32x32x16_bf16(pa3, PK(l3, h3), od, 0, 0, 0);
#undef PK
}
__device__ __forceinline__ void pv_d0(f32x16* o, int vb, bf16x8 pa0, bf16x8 pa1, bf16x8 pa2, bf16x8 pa3) {
  pv_one<0>(o[0], vb, pa0, pa1, pa2, pa3); pv_one<1>(o[1], vb, pa0, pa1, pa2, pa3); pv_one<2>(o[2], vb, pa0, pa1, pa2, pa3); pv_one<3>(o[3], vb, pa0, pa1, pa2, pa3);
}
template <int OFF> __device__ __forceinline__ s16x4 tr_rd(const LAS unsigned char* vb) { return __builtin_amdgcn_ds_read_tr16_b64_v4i16((LAS s16x4*)(vb + OFF)); }
#define PV_READS(P, D0) P[0] = tr_rd<v_rd_off(D0, 0, 0)>(vb); P[1] = tr_rd<v_rd_off(D0, 0, 1)>(vb); P[2] = tr_rd<v_rd_off(D0, 1, 0)>(vb); P[3] = tr_rd<v_rd_off(D0, 1, 1)>(vb); \
                        P[4] = tr_rd<v_rd_off(D0, 2, 0)>(vb); P[5] = tr_rd<v_rd_off(D0, 2, 1)>(vb); P[6] = tr_rd<v_rd_off(D0, 3, 0)>(vb); P[7] = tr_rd<v_rd_off(D0, 3, 1)>(vb);
#define PV_PK(L, H) (bf16x8){L[0], L[1], L[2], L[3], H[0], H[1], H[2], H[3]}
#define PV_MMA(OD, P) OD = __builtin_amdgcn_mfma_f32_32x32x16_bf16(pa0, PV_PK(P[0], P[1]), OD, 0, 0, 0); OD = __builtin_amdgcn_mfma_f32_32x32x16_bf16(pa1, PV_PK(P[2], P[3]), OD, 0, 0, 0); \
                      OD = __builtin_amdgcn_mfma_f32_32x32x16_bf16(pa2, PV_PK(P[4], P[5]), OD, 0, 0, 0); OD = __builtin_amdgcn_mfma_f32_32x32x16_bf16(pa3, PV_PK(P[6], P[7]), OD, 0, 0, 0);
#define PV_EXP4(B) do { if constexpr (EXPS) { _Pragma("unroll") for (int r = (B); r < (B) + 4; ++r) pn[r] = __builtin_amdgcn_exp2f(pn[r]); } } while (0)
template <bool EXPS> __device__ __forceinline__ void pv_pipe(f32x16* o, const LAS unsigned char* vb, bf16x8 pa0, bf16x8 pa1, bf16x8 pa2, bf16x8 pa3, f32x16& pn) {
  s16x4 A[8], B[8];
  PV_READS(A, 0) PV_READS(B, 1)
  SBAR(); PV_MMA(o[0], A) PV_EXP4(0); SBAR();
  PV_READS(A, 2)
  SBAR(); PV_MMA(o[1], B) PV_EXP4(4); SBAR();
  PV_READS(B, 3)
  SBAR(); PV_MMA(o[2], A) PV_EXP4(8); SBAR();
  PV_MMA(o[3], B) PV_EXP4(12);
}
#undef PV_READS
#undef PV_PK
#undef PV_MMA
#undef PV_EXP4

template <int LDQ, int LDK, int LDO, bool FIXM = false>
__device__ __forceinline__ void attn_dense_body(const bf16_t* __restrict__ Qb, const bf16_t* __restrict__ Kh, const bf16_t* __restrict__ Vh,
                                                bf16_t* __restrict__ Ob, int seq, LAS unsigned char* lds, float mshC = 0.f) {
  int tid_ = threadIdx.x; asm volatile("" : "+v"(tid_)); const int tid = tid_, wid = tid >> 6, lane = tid & 63, r32 = lane & 31, hi = lane >> 5;
  LAS unsigned char* V_lds = lds; LAS unsigned char* K_lds = lds + 2 * SHM_V;
  LAS float* ws = (LAS float*)(lds + 2 * SHM_V + 2 * SHM_K) + wid * 64; LAS float* li_l = ws; LAS float* al_l = ws + 32;
  float m_reg = -1e30f, l_reg = 0; f32x16 o[4] = {}; bf16x8 qr[8];
  const bf16_t* Qw = Qb + (long)(wid * QBLK + r32) * LDQ + hi * 8;
#pragma unroll
  for (int d0 = 0; d0 < 8; ++d0) qr[d0] = *reinterpret_cast<const bf16x8*>(Qw + d0 * 16);
  asm volatile("" : "+v"(qr[0]), "+v"(qr[1]), "+v"(qr[2]), "+v"(qr[3]), "+v"(qr[4]), "+v"(qr[5]), "+v"(qr[6]), "+v"(qr[7]));
#pragma unroll
  for (int d0 = 0; d0 < 8; ++d0) {
    if constexpr (FIXM) { constexpr float C = SCALE * 1.4426950408889634f; const u32x4 q = __builtin_bit_cast(u32x4, qr[d0]); u32x4 s;
      s.x = cvt_pk_bf16(bf_lo(q.x) * C, bf_hi(q.x) * C); s.y = cvt_pk_bf16(bf_lo(q.y) * C, bf_hi(q.y) * C); s.z = cvt_pk_bf16(bf_lo(q.z) * C, bf_hi(q.z) * C); s.w = cvt_pk_bf16(bf_lo(q.w) * C, bf_hi(q.w) * C);
      qr[d0] = __builtin_bit_cast(bf16x8, s); } }
  const int sr = tid >> 4, sc = (tid & 15) * 8, vst0 = v_st(sr, sc), vst1 = v_st(32 + sr, sc), kc = sc * 2;
  const LAS unsigned char* vbp = V_lds + v_rd_base(lane); const int vb0 = (int)(uintptr_t)V_lds + v_rd_base(lane);
  bf16x8 kr0, kr1, vr0, vr1;
#define KLOAD(k0) do { kr0 = *reinterpret_cast<const bf16x8*>(&Kh[(long)((k0) + sr) * LDK + sc]); kr1 = *reinterpret_cast<const bf16x8*>(&Kh[(long)((k0) + 32 + sr) * LDK + sc]); } while (0)
#define VLOAD(k0) do { vr0 = *reinterpret_cast<const bf16x8*>(&Vh[(long)((k0) + sr) * LDK + sc]); vr1 = *reinterpret_cast<const bf16x8*>(&Vh[(long)((k0) + 32 + sr) * LDK + sc]); } while (0)
#define KWRITE(b) do { *(LAS bf16x8*)(K_lds + (b) * SHM_K + KSWZ(sr, kc)) = kr0; *(LAS bf16x8*)(K_lds + (b) * SHM_K + KSWZ(32 + sr, kc)) = kr1; } while (0)
#define VWRITE(b) do { *(LAS bf16x8*)(V_lds + (b) * SHM_V + vst0) = vr0; *(LAS bf16x8*)(V_lds + (b) * SHM_V + vst1) = vr1; } while (0)
#define RESC(a) do { if constexpr (!FIXM) if (__any((a) < 1.f)) { if (hi == 0) al_l[r32] = (a); asm volatile("s_waitcnt lgkmcnt(0)" ::: "memory"); \
    _Pragma("unroll") for (int d = 0; d < 4; ++d) _Pragma("unroll") for (int r = 0; r < 16; ++r) o[d][r] *= al_l[crow(r, hi)]; } } while (0)
  f32x16 pA0, pA1, pB0, pB1; float mnA, mnB, alA, alB; bf16x8 pa0, pa1, pa2, pa3; const int NT = seq / KVBLK;
  KLOAD(0); VLOAD(0); KWRITE(0); VWRITE(0); KLOAD(KVBLK); VLOAD(KVBLK); __syncthreads();
  qkt(pA0, pA1, K_lds, qr, r32, hi); partialSM<FIXM>(pA0, pA1, m_reg, mnA, alA, mshC);
  KWRITE(1); KLOAD(2 * KVBLK);
  if (tid >= 256) __builtin_amdgcn_s_setprio(1);
  for (int j = 0; j + 2 < NT; j += 2) {
    __syncthreads(); KWRITE(0); VWRITE(1); KLOAD((j + 3) * KVBLK); VLOAD((j + 2) * KVBLK);
    SBAR(); if constexpr (FIXM) qk_fin(pB0, pB1, K_lds + SHM_K, qr, r32, hi, pA0, pA1, l_reg, pa0, pa1, pa2, pa3);
    else { qkt(pB0, pB1, K_lds + SHM_K, qr, r32, hi); finishSM(pA0, pA1, alA, l_reg, pa0, pa1, pa2, pa3); } SBAR();
    pv_pipe<FIXM>(o, vbp, pa0, pa1, pa2, pa3, pB0); partialSM<FIXM, true>(pB0, pB1, m_reg, mnB, alB, mshC); RESC(alB);
    __syncthreads(); KWRITE(1); VWRITE(0); if (j + 4 < NT) KLOAD((j + 4) * KVBLK); VLOAD((j + 3) * KVBLK);
    SBAR(); if constexpr (FIXM) qk_fin(pA0, pA1, K_lds, qr, r32, hi, pB0, pB1, l_reg, pa0, pa1, pa2, pa3);
    else { qkt(pA0, pA1, K_lds, qr, r32, hi); finishSM(pB0, pB1, alB, l_reg, pa0, pa1, pa2, pa3); } SBAR();
    pv_pipe<FIXM>(o, vbp + SHM_V, pa0, pa1, pa2, pa3, pA0); partialSM<FIXM, true>(pA0, pA1, m_reg, mnA, alA, mshC); RESC(alA);
  }
  __builtin_amdgcn_s_setprio(0);
  __syncthreads(); VWRITE(1);
  SBAR(); qkt(pB0, pB1, K_lds + SHM_K, qr, r32, hi);
  finishSM(pA0, pA1, alA, l_reg, pa0, pa1, pa2, pa3); SBAR();
  pv_d0(o, vb0, pa0, pa1, pa2, pa3); partialSM<FIXM>(pB0, pB1, m_reg, mnB, alB, mshC); RESC(alB);
  __syncthreads();
  finishSM(pB0, pB1, alB, l_reg, pa0, pa1, pa2, pa3); SBAR();
  pv_d0(o, vb0 + (int)SHM_V, pa0, pa1, pa2, pa3);
  if (hi == 0) li_l[r32] = l_reg; asm volatile("s_waitcnt lgkmcnt(0)" ::: "memory");
  float rli[16];
#pragma unroll
  for (int r = 0; r < 16; ++r) rli[r] = __builtin_amdgcn_rcpf(li_l[crow(r, hi)]);
  bf16_t* Ow = Ob + (long)(wid * QBLK) * LDO;
#pragma unroll
  for (int r = 0; r < 16; ++r) { int orow = crow(r, hi);
#pragma unroll
    for (int d0 = 0; d0 < 4; ++d0) Ow[(long)orow * LDO + d0 * 32 + r32] = f2bf(o[d0][r] * rli[r]); }
#undef KLOAD
#undef VLOAD
#undef KWRITE
#undef VWRITE
#undef RESC
}
}


constexpr int NWAVES = 8, NTHREADS = 512;
constexpr int N_LAUNCHES = MK_N_LAUNCHES;
constexpr int NPHASES = 27;
constexpr size_t MiB = 1u << 20;
constexpr size_t WS_CTL = 0, CTL_ZERO_BYTES = 1 * MiB;
constexpr size_t WS_ROPE = 1 * MiB, WS_MEMSS = 1 * MiB + 65536;
constexpr size_t WS_WIN = 2 * MiB, WS_WOUT = 178 * MiB, WS_WCQ = 242 * MiB, WS_WCKV = 250 * MiB, WS_WCO = 266 * MiB, WS_WUP = 274 * MiB, WS_WDOWN = 618 * MiB;
constexpr size_t WS_XB = 790 * MiB, WS_PROJ = 918 * MiB, WS_MIX = 1270 * MiB, WS_CQ = 1398 * MiB, WS_CO = 1414 * MiB, WS_MEMB = 1430 * MiB, WS_MKV = 1440 * MiB;
constexpr size_t WS_GH = 1446 * MiB, WS_HB = 1790 * MiB, WS_U = 1812 * MiB, WS_SS = 2068 * MiB, WS_END = 2196 * MiB;
static_assert(WS_WIN + 2ull * NIN * DM * 2 <= WS_WOUT && WS_WUP + 2ull * NUP * DM * 2 <= WS_WDOWN && WS_WDOWN + 2ull * DM * DFF * 2 <= WS_XB, "ws map (weights)");
static_assert(WS_PROJ + (size_t)MROWS * NIN * 2 <= WS_MIX && WS_GH + (size_t)MROWS * DFF * 2 <= WS_HB && WS_HB + 64ull * 4 * NUP * 4 <= WS_U && WS_U + 2ull * 2048 * 16384 * 2 <= WS_SS, "ws map (activations)");
constexpr int CW_BAR = 4096;
constexpr size_t CTL_SSQ = 65536;
static_assert(CTL_SSQ + 7ull * 16384 * 8 <= CTL_ZERO_BYTES, "ssq inside the memset region");
constexpr int RING_BYTES = 131072, XL_OFF = 131072, MISC_OFF = 143360, LDS_BYTES = 147456;
constexpr int RS = 136, RSB = RS * 2, RTB = 128 * RSB;
static_assert(4 * RTB + 1024 <= MISC_OFF && XL_OFF + 8192 + 4096 <= MISC_OFF && MISC_OFF + 128 <= LDS_BYTES, "LDS map");

typedef GAS unsigned gu32;
#define RLX_AGENT __ATOMIC_RELAXED, __HIP_MEMORY_SCOPE_AGENT
#define LDS_WAIT() asm volatile("s_waitcnt lgkmcnt(0)" ::: "memory")
#define VM_WAIT() asm volatile("s_waitcnt vmcnt(0)" ::: "memory")

#define XB_TMO      128
#define XB_XCNT(j)  (256  + 64 * (j))
#define XB_XSUB(j)  (1280 + 64 * (j))
#define XB_XGEN(j)  (2304 + 64 * (j))
#define XB_TOP      3328
#define XB_TOPGEN   3392
#define XCD_BAR_WORDS 3456
#define XB_SPIN_CAP (1u << 18)
static_assert(XB_XCNT(1) - XB_XCNT(0) == 64 && XB_XCNT(15) - XB_XCNT(0) == 960, "the batched loads in xcd_barrier_complete step 256 bytes");
__device__ __forceinline__ unsigned xb_ld(unsigned* p)              { return __hip_atomic_load(p, __ATOMIC_RELAXED, __HIP_MEMORY_SCOPE_AGENT); }
__device__ __forceinline__ unsigned xb_add(unsigned* p, unsigned v) { return __hip_atomic_fetch_add(p, v, __ATOMIC_RELAXED, __HIP_MEMORY_SCOPE_AGENT); }
__device__ __forceinline__ unsigned xb_xcc_id() { return (unsigned)__builtin_amdgcn_s_getreg((3 << 11) | 20) & 0xFu; }
#define XB_SPIN(cond, bar) do { unsigned _sp = 0; while (cond) { __builtin_amdgcn_s_sleep(1); \
    if ((++_sp & 255u) == 0u) { if (xb_ld(&(bar)[XB_TMO])) break; if (_sp > XB_SPIN_CAP) { atomicAdd(&(bar)[XB_TMO], 1u); break; } } } } while (0)
struct XcdBarrier { unsigned* bar; unsigned x; volatile LAS unsigned* st; };
__device__ __forceinline__ XcdBarrier xcd_barrier_post(unsigned* bar, volatile LAS unsigned* st) {
    XcdBarrier b; b.bar = bar; b.x = xb_xcc_id(); b.st = st;
    if (threadIdx.x == 0) (void)xb_add(&bar[XB_XCNT(b.x)], 1u);
    return b;
}
__device__ __forceinline__ void xcd_barrier_complete(unsigned* bar, unsigned x, unsigned& nloc, unsigned& nx) {
    const unsigned G = gridDim.x * gridDim.y * gridDim.z;
    unsigned sum, cnt, mine, sp = 0u;
    for (;;) {
        sum = 0u; cnt = 0u; mine = 0u;
        unsigned cv[16];
        { const unsigned* cb_ = &bar[XB_XCNT(0)];
        asm volatile("global_load_dword %0, %16, off sc1\n\t"
                     "global_load_dword %1, %16, off offset:256 sc1\n\t"
                     "global_load_dword %2, %16, off offset:512 sc1\n\t"
                     "global_load_dword %3, %16, off offset:768 sc1\n\t"
                     "global_load_dword %4, %16, off offset:1024 sc1\n\t"
                     "global_load_dword %5, %16, off offset:1280 sc1\n\t"
                     "global_load_dword %6, %16, off offset:1536 sc1\n\t"
                     "global_load_dword %7, %16, off offset:1792 sc1\n\t"
                     "global_load_dword %8, %16, off offset:2048 sc1\n\t"
                     "global_load_dword %9, %16, off offset:2304 sc1\n\t"
                     "global_load_dword %10, %16, off offset:2560 sc1\n\t"
                     "global_load_dword %11, %16, off offset:2816 sc1\n\t"
                     "global_load_dword %12, %16, off offset:3072 sc1\n\t"
                     "global_load_dword %13, %16, off offset:3328 sc1\n\t"
                     "global_load_dword %14, %16, off offset:3584 sc1\n\t"
                     "global_load_dword %15, %16, off offset:3840 sc1\n\t"
                     "s_waitcnt vmcnt(0)"
                     : "=&v"(cv[0]), "=&v"(cv[1]), "=&v"(cv[2]), "=&v"(cv[3]), "=&v"(cv[4]), "=&v"(cv[5]), "=&v"(cv[6]), "=&v"(cv[7]), "=&v"(cv[8]), "=&v"(cv[9]), "=&v"(cv[10]), "=&v"(cv[11]), "=&v"(cv[12]), "=&v"(cv[13]), "=&v"(cv[14]), "=&v"(cv[15]) : "v"(cb_) : "memory"); }
#pragma unroll
        for (unsigned j = 0; j < 16; ++j) { const unsigned c = cv[j]; sum += c; cnt += (c > 0u) ? 1u : 0u; mine = (j == x) ? c : mine; }
        if (sum == G) break;
        __builtin_amdgcn_s_sleep(1);
        if ((++sp & 255u) == 0u) { if (xb_ld(&bar[XB_TMO])) break; if (sp > XB_SPIN_CAP) { atomicAdd(&bar[XB_TMO], 1u); break; } }
    }
    nloc = mine > 0u ? mine : 1u; nx = cnt > 0u ? cnt : 1u;
}
__device__ __forceinline__ void xcd_barrier(const XcdBarrier& b) {
    asm volatile("s_waitcnt vmcnt(0)" ::: "memory");
    __syncthreads();
    if (threadIdx.x == 0) {
        unsigned* bar = b.bar;
        __builtin_amdgcn_s_waitcnt(0);
        unsigned nloc = b.st[0], nx = b.st[1];
        if (nloc == 0u) { xcd_barrier_complete(bar, b.x, nloc, nx); b.st[0] = nloc; b.st[1] = nx; }
        const unsigned old = xb_add(&bar[XB_XSUB(b.x)], 1u);
        const unsigned gen = old / nloc;
        if (old + 1u == (gen + 1u) * nloc) {
            __builtin_amdgcn_fence(__ATOMIC_RELEASE, "agent");
            asm volatile("s_waitcnt vmcnt(0)" ::: "memory");
            const unsigned og = xb_add(&bar[XB_TOP], 1u);
            const unsigned tg = og / nx;
            if (og + 1u == (tg + 1u) * nx) xb_add(&bar[XB_TOPGEN], 1u);
            else XB_SPIN(xb_ld(&bar[XB_TOPGEN]) == tg, bar);
            __builtin_amdgcn_fence(__ATOMIC_ACQUIRE, "agent");
            xb_add(&bar[XB_XGEN(b.x)], 1u);
            asm volatile("s_waitcnt vmcnt(0)" ::: "memory");
        } else {
            XB_SPIN(xb_ld(&bar[XB_XGEN(b.x)]) == gen, bar);
            __builtin_amdgcn_fence(__ATOMIC_ACQUIRE, "agent");
            asm volatile("s_waitcnt vmcnt(0)" ::: "memory");
        }
    }
    __syncthreads();
}

struct Args { const float* in[21]; float* out; unsigned char* ws; int ph_lo, ph_hi; };

template <bool UPMAP, bool ROPEPERM = false>
__device__ __forceinline__ void p0_transpose_item(const float* __restrict__ W, int K, int N, bf16_t* __restrict__ WT, const float* __restrict__ gain, int cs_lo, int cs_hi, float cs, LAS float* scr, int item, int lane) {
    const int nblk = N / 64, kb = item / nblk, nb = item % nblk, k0 = 64 * kb, n0 = 64 * nb;
    const float* src = W + (size_t)k0 * N + n0 + lane;
#pragma unroll 32
    for (int i = 0; i < 64; ++i) scr[i * 65 + lane] = __builtin_nontemporal_load(src + (size_t)i * N);
    LDS_WAIT(); asm volatile("" ::: "memory");
    const int c = lane & 7, rr = lane >> 3;
    float g8[8];
#pragma unroll
    for (int e = 0; e < 8; ++e) g8[e] = gain ? gain[k0 + 8 * c + e] : 1.0f;
    const float csv = (n0 >= cs_lo && n0 < cs_hi) ? cs : 1.0f;
    int orow0 = n0;
    if (UPMAP) { const int nn = n0 < DFF ? n0 : n0 - DFF; orow0 = (nn >> 7) * 256 + (n0 < DFF ? 0 : 128) + (nn & 127); }
    const bool hperm = ROPEPERM && (n0 < 4096 || (n0 >= 8192 && n0 < 10752));
#pragma unroll
    for (int jj = 0; jj < 8; ++jj) { const int n = rr + 8 * jj; const LAS float* s = scr + (8 * c) * 65 + n;
        const int nrow = hperm ? (8 * ((n & 31) >> 2) + (n & 3) + ((n >= 32) ? 4 : 0)) : n;
        u32x4 o;
        o.x = cvt_pk_bf16(s[0 * 65] * g8[0] * csv, s[1 * 65] * g8[1] * csv); o.y = cvt_pk_bf16(s[2 * 65] * g8[2] * csv, s[3 * 65] * g8[3] * csv);
        o.z = cvt_pk_bf16(s[4 * 65] * g8[4] * csv, s[5 * 65] * g8[5] * csv); o.w = cvt_pk_bf16(s[6 * 65] * g8[6] * csv, s[7 * 65] * g8[7] * csv);
        __builtin_nontemporal_store(o, (u32x4*)(WT + (size_t)(orow0 + nrow) * K + k0 + 8 * c)); }
    LDS_WAIT(); asm volatile("" ::: "memory");
}
__device__ __forceinline__ float wave_sum(float v) {
#pragma unroll
    for (int o = 1; o < 64; o <<= 1) v += __shfl_xor(v, o);
    return v;
}
template <class TS> __device__ __forceinline__ void row_to_bf16(const float* __restrict__ xrow, bf16_t* __restrict__ orow, TS* ssq_out, int lane) {
    const f32x4* xr = (const f32x4*)xrow + lane; float s = 0.f;
    u32x2* o8 = (u32x2*)orow + lane;
#pragma unroll
    for (int j = 0; j < 16; ++j) { const f32x4 v = __builtin_nontemporal_load(xr + 64 * j); s += (v[0] * v[0] + v[1] * v[1]) + (v[2] * v[2] + v[3] * v[3]);
        u32x2 w; w.x = cvt_pk_bf16(v[0], v[1]); w.y = cvt_pk_bf16(v[2], v[3]); o8[64 * j] = w; }
    s = wave_sum(s);
    if (lane == 0) { if constexpr (sizeof(TS) == 8) *ssq_out = (TS)(s * 1048576.0f + 0.5f); else *ssq_out = s; }
}

__device__ __forceinline__ void prep_row(bf16_t* __restrict__ prow, int t, const f32x2* __restrict__ rope, const float* __restrict__ qn, const float* __restrict__ kn, int lane) {
    const int hg = lane >> 3, j = lane & 7;
    const int off1 = 8 * j + ((j >= 4) ? 32 : 0);
    const int pos = (j < 4) ? (t >> 6) : (t & 63);
    const f32x2* rp = rope + pos * 32 + 8 * (j & 3);
    f32x2 cs[8];
#pragma unroll
    for (int e = 0; e < 8; ++e) cs[e] = rp[e];
#pragma unroll
    for (int g = 0; g < 7; ++g) {
        const int base = (g < 4) ? g * 1024 : (g < 6 ? 8192 + (g - 4) * 1024 : 10240);
        const bool active = (g < 6) || (hg < 4);
        const int hh = active ? hg : 0;
        bf16_t* p = prow + base + hh * 128 + off1;
        const u32x4 a = *(const u32x4*)p, b = *(const u32x4*)(p + 32);
        float x1[8] = {bf_lo(a.x), bf_hi(a.x), bf_lo(a.y), bf_hi(a.y), bf_lo(a.z), bf_hi(a.z), bf_lo(a.w), bf_hi(a.w)};
        float x2[8] = {bf_lo(b.x), bf_hi(b.x), bf_lo(b.y), bf_hi(b.y), bf_lo(b.z), bf_hi(b.z), bf_lo(b.w), bf_hi(b.w)};
        if (g >= 4) {
            float ss = 0.f;
#pragma unroll
            for (int e = 0; e < 8; ++e) ss += x1[e] * x1[e] + x2[e] * x2[e];
            ss += __shfl_xor(ss, 1); ss += __shfl_xor(ss, 2); ss += __shfl_xor(ss, 4);
            const float rs = __builtin_amdgcn_rsqf(ss * (1.0f / 128.0f) + EPS);
            const float* gn = (g < 6) ? qn : kn;
#pragma unroll
            for (int e = 0; e < 8; ++e) { x1[e] *= rs * gn[off1 + e]; x2[e] *= rs * gn[off1 + 32 + e]; }
        }
        float y1[8], y2[8];
#pragma unroll
        for (int e = 0; e < 8; ++e) { y1[e] = x1[e] * cs[e].x - x2[e] * cs[e].y; y2[e] = x2[e] * cs[e].x + x1[e] * cs[e].y; }
        if (active) {
            u32x4 oa, ob;
            oa.x = cvt_pk_bf16(y1[0], y1[1]); oa.y = cvt_pk_bf16(y1[2], y1[3]); oa.z = cvt_pk_bf16(y1[4], y1[5]); oa.w = cvt_pk_bf16(y1[6], y1[7]);
            ob.x = cvt_pk_bf16(y2[0], y2[1]); ob.y = cvt_pk_bf16(y2[2], y2[3]); ob.z = cvt_pk_bf16(y2[4], y2[5]); ob.w = cvt_pk_bf16(y2[6], y2[7]);
            *(u32x4*)p = oa; *(u32x4*)(p + 32) = ob;
        }
    }
}

__device__ __forceinline__ f32x4 mfma16(bf16x8 a, bf16x8 b, f32x4 c) { return __builtin_amdgcn_mfma_f32_16x16x32_bf16(a, b, c, 0, 0, 0); }
__device__ __forceinline__ bf16x8 tr_frag(int addr) {
    s16x4 lo, hi;
    asm volatile("ds_read_b64_tr_b16 %0, %2\n\tds_read_b64_tr_b16 %1, %2 offset:%3\n\ts_waitcnt lgkmcnt(0)" : "=&v"(lo), "=&v"(hi) : "v"(addr), "i"(4 * RSB) : "memory");
    return (bf16x8){lo[0], lo[1], lo[2], lo[3], hi[0], hi[1], hi[2], hi[3]};
}
__device__ __forceinline__ void tr_frag4(int addr, bf16x8 (&f)[4]) {
    s16x4 l0, h0, l1, h1, l2, h2, l3, h3;
    asm volatile("ds_read_b64_tr_b16 %0, %8\n\tds_read_b64_tr_b16 %1, %8 offset:%9\n\tds_read_b64_tr_b16 %2, %8 offset:32\n\tds_read_b64_tr_b16 %3, %8 offset:%10\n\t"
                 "ds_read_b64_tr_b16 %4, %8 offset:64\n\tds_read_b64_tr_b16 %5, %8 offset:%11\n\tds_read_b64_tr_b16 %6, %8 offset:96\n\tds_read_b64_tr_b16 %7, %8 offset:%12\n\ts_waitcnt lgkmcnt(0)"
                 : "=&v"(l0), "=&v"(h0), "=&v"(l1), "=&v"(h1), "=&v"(l2), "=&v"(h2), "=&v"(l3), "=&v"(h3)
                 : "v"(addr), "i"(4 * RSB), "i"(4 * RSB + 32), "i"(4 * RSB + 64), "i"(4 * RSB + 96) : "memory");
    f[0] = (bf16x8){l0[0], l0[1], l0[2], l0[3], h0[0], h0[1], h0[2], h0[3]}; f[1] = (bf16x8){l1[0], l1[1], l1[2], l1[3], h1[0], h1[1], h1[2], h1[3]};
    f[2] = (bf16x8){l2[0], l2[1], l2[2], l2[3], h2[0], h2[1], h2[2], h2[3]}; f[3] = (bf16x8){l3[0], l3[1], l3[2], l3[3], h3[0], h3[1], h3[2], h3[3]};
}
__device__ __forceinline__ void ret_state_item(LAS unsigned char* lds, const bf16_t* __restrict__ PROJ, bf16_t* __restrict__ U, int r0, int h, int item, float lf2, float lb2) {
    int tid_ = threadIdx.x; asm volatile("" : "+v"(tid_)); const int tid = tid_, lane = tid & 63, w = __builtin_amdgcn_readfirstlane(tid >> 6), g = lane >> 4, lr = lane & 15, q4 = (lane & 15) >> 2, p4 = lane & 3;
    const int wr4 = w >> 1, wc2 = w & 1;
    LAS bf16_t* Kf = (LAS bf16_t*)lds; LAS bf16_t* Kb = Kf + 128 * RS; LAS bf16_t* Vs = Kb + 128 * RS;
#pragma unroll
    for (int p = 0; p < 4; ++p) { const int idx = tid + 512 * p, j = idx >> 4, cc = (idx & 15) * 8;
        const bf16_t* src = PROJ + (size_t)(r0 + j) * NIN + 2048 + h * 128 + cc;
        const u32x4 k = *(const u32x4*)src, v = *(const u32x4*)(src + 2048);
        const float zf = __builtin_amdgcn_exp2f((float)(127 - j) * lf2), zb = __builtin_amdgcn_exp2f((float)j * lb2);
        u32x4 kf, kb;
        kf.x = cvt_pk_bf16(bf_lo(k.x) * zf, bf_hi(k.x) * zf); kf.y = cvt_pk_bf16(bf_lo(k.y) * zf, bf_hi(k.y) * zf); kf.z = cvt_pk_bf16(bf_lo(k.z) * zf, bf_hi(k.z) * zf); kf.w = cvt_pk_bf16(bf_lo(k.w) * zf, bf_hi(k.w) * zf);
        kb.x = cvt_pk_bf16(bf_lo(k.x) * zb, bf_hi(k.x) * zb); kb.y = cvt_pk_bf16(bf_lo(k.y) * zb, bf_hi(k.y) * zb); kb.z = cvt_pk_bf16(bf_lo(k.z) * zb, bf_hi(k.z) * zb); kb.w = cvt_pk_bf16(bf_lo(k.w) * zb, bf_hi(k.w) * zb);
        *(LAS u32x4*)(Kf + j * RS + cc) = kf; *(LAS u32x4*)(Kb + j * RS + cc) = kb; *(LAS u32x4*)(Vs + j * RS + cc) = v; }
    __syncthreads();
    f32x4 af[2][4], ab[2][4];
#pragma unroll
    for (int a = 0; a < 2; ++a)
#pragma unroll
        for (int b = 0; b < 4; ++b) { af[a][b] = (f32x4){0.f, 0.f, 0.f, 0.f}; ab[a][b] = (f32x4){0.f, 0.f, 0.f, 0.f}; }
    const int vbase = (int)(uintptr_t)Vs, fbase = (int)(uintptr_t)Kf, bbase = (int)(uintptr_t)Kb;
#pragma unroll
    for (int ks = 0; ks < 4; ++ks) {
        const int rowoff = (32 * ks + 8 * g + q4) * RSB;
        bf16x8 A4[4], Bf[4], Bb[4];
        tr_frag4(vbase + rowoff + (32 * wr4 + 4 * p4) * 2, A4);
        tr_frag4(fbase + rowoff + (64 * wc2 + 4 * p4) * 2, Bf);
        tr_frag4(bbase + rowoff + (64 * wc2 + 4 * p4) * 2, Bb);
#pragma unroll
        for (int b = 0; b < 4; ++b)
#pragma unroll
            for (int a = 0; a < 2; ++a) { af[a][b] = mfma16(A4[a], Bf[b], af[a][b]); ab[a][b] = mfma16(A4[a], Bb[b], ab[a][b]); }
    }
    LAS float* Ys = (LAS float*)lds;
#pragma unroll
    for (int dir = 0; dir < 2; ++dir) {
        __syncthreads();
#pragma unroll
        for (int a = 0; a < 2; ++a)
#pragma unroll
            for (int b = 0; b < 4; ++b)
#pragma unroll
                for (int r = 0; r < 4; ++r) Ys[(32 * wr4 + 16 * a + 4 * g + r) * 132 + 64 * wc2 + 16 * b + lr] = dir ? ab[a][b][r] : af[a][b][r];
        __syncthreads();
        bf16_t* Ud = U + (size_t)(dir * 2048 + item) * 16384;
#pragma unroll
        for (int p = 0; p < 4; ++p) { const int idx = tid + 512 * p, j = idx >> 4, cc = (idx & 15) * 8;
            const f32x4 y0 = *(const LAS f32x4*)(Ys + j * 132 + cc), y1 = *(const LAS f32x4*)(Ys + j * 132 + cc + 4);
            u32x4 wv; wv.x = cvt_pk_bf16(y0[0], y0[1]); wv.y = cvt_pk_bf16(y0[2], y0[3]); wv.z = cvt_pk_bf16(y1[0], y1[1]); wv.w = cvt_pk_bf16(y1[2], y1[3]);
            *(u32x4*)(Ud + j * 128 + cc) = wv; }
    }
    __syncthreads();
}
constexpr int YS = 132;
static_assert(128 * YS * 4 <= 2 * RTB, "y tile fits the K + V tiles");
__device__ __forceinline__ void ret_item_geom(int it, const float* __restrict__ dl  , int& r0, int& h, float& lf2, float& lb2) {
    if (it < 1024) { const int sh = it >> 4, c = it & 15; h = sh & 15; r0 = (sh >> 4) * 2048 + c * 128; }
    else { const int i2 = it - 1024; h = i2 >> 6; r0 = 8192 + (i2 & 63) * 128; }
    lf2 = dl[h]; lb2 = dl[16 + h];
}
__device__ __forceinline__ void ret_out_phase(LAS unsigned char* lds, const bf16_t* __restrict__ PROJ, const bf16_t* __restrict__ SS, bf16_t* __restrict__ MIX, const float* __restrict__ dl, int first, int step) {
#define RET_LANE_IDS int tid_ = threadIdx.x; asm volatile("" : "+v"(tid_)); const int tid = tid_, lane = tid & 63, w = __builtin_amdgcn_readfirstlane(tid >> 6), g = lane >> 4, lr = lane & 15, q4 = (lane & 15) >> 2, p4 = lane & 3, wr4 = w >> 1, wc2 = w & 1; (void)q4; (void)p4; (void)wc2;
    LAS bf16_t* Ks = (LAS bf16_t*)lds; LAS bf16_t* Vs = Ks + 128 * RS; LAS bf16_t* Fs = Vs + 128 * RS; LAS bf16_t* Bs = Fs + 128 * RS; LAS float* RSUM = (LAS float*)(lds + 4 * RTB);
    LAS bf16_t* Ps = Ks; LAS float* Ys = (LAS float*)lds;
    if (first >= 2048) return;
    bf16x8 AQ[2][4]; u32x4 kv[4];
#define RET_LOAD_QK(r0_, h_) do { \
    _Pragma("unroll") for (int a = 0; a < 2; ++a) _Pragma("unroll") for (int ks = 0; ks < 4; ++ks) AQ[a][ks] = *(const bf16x8*)(PROJ + ((size_t)(r0_) * NIN + (h_) * 128) + (unsigned)((32 * wr4 + 16 * a + lr) * NIN + 32 * ks + 8 * g)); \
    _Pragma("unroll") for (int p = 0; p < 4; ++p) { const int idx = tid + 512 * p, j = idx >> 4, cc = (idx & 15) * 8; kv[p] = *(const u32x4*)(PROJ + ((size_t)(r0_) * NIN + 2048 + (h_) * 128) + (unsigned)(j * NIN + cc)); } } while (0)
    { RET_LANE_IDS int r0, h; float lf2, lb2; ret_item_geom(first, dl, r0, h, lf2, lb2); RET_LOAD_QK(r0, h); }
    for (int item = first; item < 2048; item += step) {
        RET_LANE_IDS
        int r0, h; float lf2, lb2; ret_item_geom(item, dl, r0, h, lf2, lb2);
        const bf16_t* SfT = SS + (size_t)item * 16384; const bf16_t* SbT = SS + (size_t)(2048 + item) * 16384;
        u32x4 vv[4], fv[4], bv[4], gv[4];
#pragma unroll
        for (int p = 0; p < 4; ++p) { const int idx = tid + 512 * p, j = idx >> 4, cc = (idx & 15) * 8;
            const bf16_t* pb = PROJ + ((size_t)r0 * NIN + 4096 + h * 128); const unsigned po = (unsigned)(j * NIN + cc), so = (unsigned)(j * 128 + cc);
            vv[p] = *(const u32x4*)(pb + po); gv[p] = *(const u32x4*)(pb + 2048 + po);
            fv[p] = *(const u32x4*)(SfT + so); bv[p] = *(const u32x4*)(SbT + so); }
#pragma unroll
        for (int p = 0; p < 4; ++p) { const int idx = tid + 512 * p, j = idx >> 4, cc = (idx & 15) * 8; *(LAS u32x4*)(Ks + j * RS + cc) = kv[p]; }
        __syncthreads();
        f32x4 sc[2][4];
#pragma unroll
        for (int a = 0; a < 2; ++a)
#pragma unroll
            for (int b = 0; b < 4; ++b) sc[a][b] = (f32x4){0.f, 0.f, 0.f, 0.f};
#pragma unroll
        for (int ks = 0; ks < 4; ++ks) {
            bf16x8 B[4];
#pragma unroll
            for (int b = 0; b < 4; ++b) B[b] = *(const LAS bf16x8*)(Ks + (64 * wc2 + 16 * b + lr) * RS + 32 * ks + 8 * g);
#pragma unroll
            for (int a = 0; a < 2; ++a)
#pragma unroll
                for (int b = 0; b < 4; ++b) sc[a][b] = mfma16(AQ[a][ks], B[b], sc[a][b]);
        }
#pragma unroll
        for (int a = 0; a < 2; ++a)
#pragma unroll
            for (int b = 0; b < 4; ++b)
#pragma unroll
                for (int r = 0; r < 4; ++r) { const int i = 32 * wr4 + 16 * a + 4 * g + r, j = 64 * wc2 + 16 * b + lr, d = i - j;
                    sc[a][b][r] *= __builtin_amdgcn_exp2f(d >= 0 ? (float)d * lf2 : (float)(-d) * lb2); }
        __syncthreads();
#pragma unroll
        for (int a = 0; a < 2; ++a)
#pragma unroll
            for (int b = 0; b < 4; ++b)
#pragma unroll
                for (int r = 0; r < 4; ++r) Ps[(32 * wr4 + 16 * a + 4 * g + r) * RS + 64 * wc2 + 16 * b + lr] = f2bf(sc[a][b][r]);
#pragma unroll
        for (int p = 0; p < 4; ++p) { const int idx = tid + 512 * p, j = idx >> 4, cc = (idx & 15) * 8;
            *(LAS u32x4*)(Vs + j * RS + cc) = vv[p]; *(LAS u32x4*)(Fs + j * RS + cc) = fv[p]; *(LAS u32x4*)(Bs + j * RS + cc) = bv[p]; }
        __syncthreads();
        f32x4 y[2][4];
#pragma unroll
        for (int a = 0; a < 2; ++a)
#pragma unroll
            for (int b = 0; b < 4; ++b) y[a][b] = (f32x4){0.f, 0.f, 0.f, 0.f};
        float xfr[2], xbr[2];
#pragma unroll
        for (int a = 0; a < 2; ++a) { const int i = 32 * wr4 + 16 * a + lr; xfr[a] = __builtin_amdgcn_exp2f((float)(i + 1) * lf2); xbr[a] = __builtin_amdgcn_exp2f((float)(128 - i) * lb2); }
        const int vbase = (int)(uintptr_t)Vs;
#pragma unroll
        for (int ks = 0; ks < 4; ++ks) {
            bf16x8 AP[2], AF[2], AB[2], BV[4], BF[4], BB[4];
#pragma unroll
            for (int a = 0; a < 2; ++a) { AP[a] = *(const LAS bf16x8*)(Ps + (32 * wr4 + 16 * a + lr) * RS + 32 * ks + 8 * g);
                const u32x4 q = __builtin_bit_cast(u32x4, AQ[a][ks]); u32x4 f, bq;
                f.x = cvt_pk_bf16(bf_lo(q.x) * xfr[a], bf_hi(q.x) * xfr[a]); f.y = cvt_pk_bf16(bf_lo(q.y) * xfr[a], bf_hi(q.y) * xfr[a]); f.z = cvt_pk_bf16(bf_lo(q.z) * xfr[a], bf_hi(q.z) * xfr[a]); f.w = cvt_pk_bf16(bf_lo(q.w) * xfr[a], bf_hi(q.w) * xfr[a]);
                bq.x = cvt_pk_bf16(bf_lo(q.x) * xbr[a], bf_hi(q.x) * xbr[a]); bq.y = cvt_pk_bf16(bf_lo(q.y) * xbr[a], bf_hi(q.y) * xbr[a]); bq.z = cvt_pk_bf16(bf_lo(q.z) * xbr[a], bf_hi(q.z) * xbr[a]); bq.w = cvt_pk_bf16(bf_lo(q.w) * xbr[a], bf_hi(q.w) * xbr[a]);
                AF[a] = __builtin_bit_cast(bf16x8, f); AB[a] = __builtin_bit_cast(bf16x8, bq); }
#pragma unroll
            for (int b = 0; b < 4; ++b) { BF[b] = *(const LAS bf16x8*)(Fs + (64 * wc2 + 16 * b + lr) * RS + 32 * ks + 8 * g); BB[b] = *(const LAS bf16x8*)(Bs + (64 * wc2 + 16 * b + lr) * RS + 32 * ks + 8 * g); }
            tr_frag4(vbase + (32 * ks + 8 * g + q4) * RSB + (64 * wc2 + 4 * p4) * 2, BV);
#pragma unroll
            for (int a = 0; a < 2; ++a)
#pragma unroll
                for (int b = 0; b < 4; ++b) { y[a][b] = mfma16(AP[a], BV[b], y[a][b]); y[a][b] = mfma16(AF[a], BF[b], y[a][b]); y[a][b] = mfma16(AB[a], BB[b], y[a][b]); }
        }
#pragma unroll
        for (int a = 0; a < 2; ++a)
#pragma unroll
            for (int r = 0; r < 4; ++r) { const int i = 32 * wr4 + 16 * a + 4 * g + r;
                float s = 0.f;
#pragma unroll
                for (int b = 0; b < 4; ++b) { const float v = y[a][b][r]; s += v * v; }
                s += __shfl_xor(s, 1); s += __shfl_xor(s, 2); s += __shfl_xor(s, 4); s += __shfl_xor(s, 8);
                if (lr == 0) RSUM[i * 2 + wc2] = s; }
        { const int nx = item + step; if (nx < 2048) { int r0n, hn; float a_, b_; ret_item_geom(nx, dl, r0n, hn, a_, b_); RET_LOAD_QK(r0n, hn); } }
        __syncthreads();
#pragma unroll
        for (int a = 0; a < 2; ++a)
#pragma unroll
            for (int r = 0; r < 4; ++r) { const int i = 32 * wr4 + 16 * a + 4 * g + r;
                const float rs = __builtin_amdgcn_rsqf((RSUM[i * 2] + RSUM[i * 2 + 1]) * (1.0f / 128.0f) + EPS);
#pragma unroll
                for (int b = 0; b < 4; ++b) Ys[i * YS + 64 * wc2 + 16 * b + lr] = y[a][b][r] * rs; }
        __syncthreads();
#pragma unroll
        for (int p = 0; p < 4; ++p) { const int idx = tid + 512 * p, j = idx >> 4, cc = (idx & 15) * 8;
            const f32x4 y0 = *(const LAS f32x4*)(Ys + j * YS + cc), y1 = *(const LAS f32x4*)(Ys + j * YS + cc + 4);
            const u32x4 gg = gv[p];
            const float gt[8] = {bf_lo(gg.x), bf_hi(gg.x), bf_lo(gg.y), bf_hi(gg.y), bf_lo(gg.z), bf_hi(gg.z), bf_lo(gg.w), bf_hi(gg.w)};
            float o[8];
#pragma unroll
            for (int e = 0; e < 8; ++e) { const float sg = gt[e] * __builtin_amdgcn_rcpf(1.0f + __builtin_amdgcn_exp2f(-gt[e] * 1.4426950408889634f)); o[e] = sg * (e < 4 ? y0[e & 3] : y1[e & 3]); }
            u32x4 wv; wv.x = cvt_pk_bf16(o[0], o[1]); wv.y = cvt_pk_bf16(o[2], o[3]); wv.z = cvt_pk_bf16(o[4], o[5]); wv.w = cvt_pk_bf16(o[6], o[7]);
            *(u32x4*)(MIX + ((size_t)r0 * DM + h * 128) + (unsigned)(j * DM + cc)) = wv; }
        __syncthreads();
    }
#undef RET_LOAD_QK
#undef RET_LANE_IDS
}

#ifndef PROBE
#define PROBE 0
#endif
constexpr int REP_P0 = PROBE == 1 ? 2 : 1, REP_R1 = PROBE == 2 ? 2 : 1, REP_R2 = PROBE == 7 ? 2 : 1, REP_R3 = PROBE == 8 ? 2 : 1, REP_G5 = PROBE == 3 ? 2 : 1, REP_ATT = PROBE == 4 ? 3 : 1, REP_G1 = PROBE == 5 ? 2 : 1, REP_PREP0 = PROBE == 6 ? 2 : 1, XTRA_G6 = PROBE == 9, XTRA_G2 = PROBE == 10, XTRA_G4 = PROBE == 11, XTRA_G5P = PROBE == 12; constexpr int XTRA_BARS = PROBE == 13 ? 20 : 0; constexpr int REP_SMALL = PROBE == 14 ? 2 : 1; constexpr bool XTRA_HOTG2 = PROBE == 15, XTRA_G5NULL = PROBE == 16, XTRA_G2NULL = PROBE == 17;
constexpr int CW_FIN = 245760;
static_assert((size_t)CW_FIN * 4 >= CTL_SSQ + 7ull * 16384 * 8 && (size_t)CW_FIN * 4 + 64 * 64 <= CTL_ZERO_BYTES, "panel counters inside the memset region");
constexpr bool FUSE_FINAL = false && (MK_N_LAUNCHES == 1);
constexpr int CW_SPLIT = 8192;
template <class T> __device__ __forceinline__ T* opq(T* p) { GAS T* q = (GAS T*)p; asm volatile("" : "+s"(q)); return (T*)q; }
__global__ void __launch_bounds__(NTHREADS, 2) trunk_fwd(Args args) {
    extern __shared__ __attribute__((aligned(16))) unsigned char lds_raw[];
    LAS unsigned char* lds = (LAS unsigned char*)lds_raw;
    volatile LAS unsigned* MISC = (volatile LAS unsigned*)(lds + MISC_OFF);
    const int G = gridDim.x; const int bx = blockIdx.x; const int vcu = (G % 8 == 0) ? (bx % 8) * (G / 8) + bx / 8 : bx;
#define WSP(T, off) ((T*)(wsp + (off)))
#define ctl WSP(unsigned, WS_CTL)
#define SSQ WSP(unsigned long long, WS_CTL + CTL_SSQ)
#define ROPE WSP(f32x2, WS_ROPE)
#define MEMSS WSP(float, WS_MEMSS)
#define LG2 WSP(float, WS_MEMSS + 8192)
#define WIN WSP(bf16_t, WS_WIN)
#define WOUT WSP(bf16_t, WS_WOUT)
#define WCQ WSP(bf16_t, WS_WCQ)
#define WCKV WSP(bf16_t, WS_WCKV)
#define WCO WSP(bf16_t, WS_WCO)
#define WUP WSP(bf16_t, WS_WUP)
#define WDOWN WSP(bf16_t, WS_WDOWN)
#define XB WSP(bf16_t, WS_XB)
#define PROJ WSP(bf16_t, WS_PROJ)
#define MIX WSP(bf16_t, WS_MIX)
#define CQ WSP(bf16_t, WS_CQ)
#define CO WSP(bf16_t, WS_CO)
#define MEMB WSP(bf16_t, WS_MEMB)
#define MKV WSP(bf16_t, WS_MKV)
#define GH WSP(bf16_t, WS_GH)
#define HB WSP(float, WS_HB)
#define UU WSP(bf16_t, WS_U)
#define SS WSP(bf16_t, WS_U)
#define XRES (args.out)
#define x_prompt (args.in[0])
#define x_sample (args.in[1])
#define mem_prompt (args.in[2])
#define mem_sample (args.in[3])
#define w_in (args.in[4])
#define w_out (args.in[5])
#define decay_logit (args.in[6])
#define q_norm (args.in[7])
#define k_norm (args.in[8])
#define norm_mix (args.in[9])
#define norm_cross (args.in[10])
#define norm_mem (args.in[11])
#define w_cq (args.in[12])
#define w_ckv (args.in[13])
#define w_co (args.in[14])
#define norm_ffn (args.in[15])
#define w_up (args.in[16])
#define conv_w (args.in[17])
#define conv_b (args.in[18])
#define w_down (args.in[19])
#define norm_final (args.in[20])
    if (threadIdx.x < 32) MISC[threadIdx.x] = 0u;
    __syncthreads();
    XcdBarrier bar; bar.bar = (unsigned*)(args.ws + WS_CTL) + CW_BAR; bar.x = 0; bar.st = nullptr;
    if (N_LAUNCHES == 1) bar = xcd_barrier_post((unsigned*)(args.ws + WS_CTL) + CW_BAR, MISC + 8);
    const int lo = args.ph_lo, hi = args.ph_hi;
#ifndef ONLY_SLOT
#define ONLY_SLOT -1
#endif
#define SLOT_ON(s) (ONLY_SLOT < 0 || ONLY_SLOT == (s))
#define INR(k) (lo <= (k) && (k) < hi)
#define IN0 (SLOT_ON(0) && INR(0))
#define INL(s) (SLOT_ON(1 + (s)) && INR(pb + (s)))
#define INF (SLOT_ON(13) && INR(26))
#define INM (SLOT_ON(14) && INR(1))
#ifndef PT_MASK
#define PT_MASK 0
#endif
#ifndef PT_LAYERS
#define PT_LAYERS 3
#endif
    constexpr int PT_K = 4;
    unsigned long long pt_prev = PT_MASK ? wall_clock64() : 0ull, pt_acc = 0ull;
#if PT_EPI
#define PT_MARK(slot, lay) do { if (PT_MASK) { LAS unsigned long long* ec_ = (LAS unsigned long long*)(lds + MISC_OFF + 64); __syncthreads(); if (((PT_MASK >> (slot)) & 1) && ((PT_LAYERS >> (lay)) & 1)) pt_acc += *ec_; __syncthreads(); if (threadIdx.x == 0) *ec_ = 0ull; __syncthreads(); } } while (0)
#else
#define PT_MARK(slot, lay) do { if (PT_MASK) { const unsigned long long now_ = wall_clock64(); if (((PT_MASK >> (slot)) & 1) && ((PT_LAYERS >> (lay)) & 1)) pt_acc += now_ - pt_prev; pt_prev = now_; } } while (0)
#endif
#define SEAM(k) do { if (N_LAUNCHES == 1 && INR(k) && INR((k) + 1)) xcd_barrier(bar); PT_MARK((k) == 0 ? 0 : 1 + ((k) - 2) % 12, (k) < 2 ? 0 : ((k) - 2) / 12); } while (0)
    const int NGW = G * NWAVES;
#define PHASE_LOCALS GAS unsigned char* wsg = (GAS unsigned char*)args.ws; asm volatile("" : "+s"(wsg)); unsigned char* wsp = (unsigned char*)wsg; int tid = threadIdx.x; asm volatile("" : "+v"(tid)); const int lane = tid & 63, wave = __builtin_amdgcn_readfirstlane(tid >> 6), gw = vcu * NWAVES + wave; (void)lane; (void)gw; (void)wave;

    if (IN0) {
        PHASE_LOCALS
        LAS float* scr = (LAS float*)(lds + wave * 16640);
        constexpr int I_IN = 64 * 176, I_OUT = 64 * 64, I_CQ = 64 * 8, I_CKV = 64 * 16, I_CO = 8 * 64, I_UP = 64 * 344, I_DN = 172 * 64;
        constexpr int I_LAYER = I_IN + I_OUT + I_CQ + I_CKV + I_CO + I_UP + I_DN;
        for (int rep = 0; rep < REP_P0; ++rep)
        for (int itr = gw; itr < 2 * I_LAYER; itr += NGW) {
            const int it = 2 * I_LAYER - 1 - itr; const int l = it / I_LAYER; int r = it % I_LAYER;
            if (r < I_IN) { p0_transpose_item<false, true>(w_in + (size_t)l * DM * NIN, DM, NIN, WIN + (size_t)l * NIN * DM, norm_mix + l * DM, 2048, 4096, 0.088388347648318440f, scr, r, lane); continue; } r -= I_IN;
            if (r < I_OUT) { p0_transpose_item<false>(w_out + (size_t)l * DM * DM, DM, DM, WOUT + (size_t)l * DM * DM, nullptr, 0, 0, 1.f, scr, r, lane); continue; } r -= I_OUT;
            if (r < I_CQ) { p0_transpose_item<false>(w_cq + (size_t)l * DM * MEMW, DM, MEMW, WCQ + (size_t)l * MEMW * DM, norm_cross + l * DM, 0, 0, 1.f, scr, r, lane); continue; } r -= I_CQ;
            if (r < I_CKV) { p0_transpose_item<false>(w_ckv + (size_t)l * DM * 1024, DM, 1024, WCKV + (size_t)l * 1024 * DM, norm_mem + l * DM, 0, 0, 1.f, scr, r, lane); continue; } r -= I_CKV;
            if (r < I_CO) { p0_transpose_item<false>(w_co + (size_t)l * MEMW * DM, MEMW, DM, WCO + (size_t)l * DM * MEMW, nullptr, 0, 0, 1.f, scr, r, lane); continue; } r -= I_CO;
            if (r < I_UP) { p0_transpose_item<true>(w_up + (size_t)l * DM * NUP, DM, NUP, WUP + (size_t)l * NUP * DM, norm_ffn + l * DM, 0, 0, 1.f, scr, r, lane); continue; } r -= I_UP;
            p0_transpose_item<false>(w_down + (size_t)l * DFF * DM, DFF, DM, WDOWN + (size_t)l * DM * DFF, nullptr, 0, 0, 1.f, scr, r, lane);
        }
        for (int rep = 0; rep < REP_SMALL; ++rep)
        for (int m = gw; m < MROWS; m += NGW) row_to_bf16(m < 8192 ? x_prompt + (size_t)m * DM : x_sample + (size_t)(m - 8192) * DM, XB + (size_t)m * DM, SSQ + m, lane);
        for (int m = gw; m < MEMROWS; m += NGW) row_to_bf16(m < 1024 ? mem_prompt + (size_t)m * DM : mem_sample + (size_t)(m - 1024) * DM, MEMB + (size_t)m * DM, MEMSS + m, lane);
        if (PROBE == 21) { u32x4* zp = (u32x4*)(wsp + WS_GH); const size_t n16 = (WS_U - WS_GH) / 16; const u32x4 z = {0u, 0u, 0u, 0u};
            for (size_t i = (size_t)bx * NTHREADS + tid; i < n16; i += (size_t)G * NTHREADS) zp[i] = z; }
        if (bx == 0 && tid < 64) LG2[tid] = -log1pf(__expf(-decay_logit[tid])) * 1.4426950408889634f;
        if (bx == 0 && tid >= 64 && tid < 66) {
            const int ll = tid - 64; float gq = 0.f, gk = 0.f;
            for (int d = 0; d < 128; ++d) { gq = fmaxf(gq, fabsf(q_norm[ll * 128 + d])); gk = fmaxf(gk, fabsf(k_norm[ll * 128 + d])); }
            LG2[64 + ll] = fmaxf(0.f, 1.02f * 128.0f * gq * gk * (0.088388347648318440f * 1.4426950408889634f) - 64.0f); }
        for (int e = bx * NTHREADS + tid; e < 128 * 32; e += G * NTHREADS) { const int pos = e >> 5, i = e & 31;
            const float freq = __builtin_amdgcn_exp2f(-(float)i * (13.287712379549449f / 32.0f));
            const float rev = (float)pos * freq * 0.15915494309189535f, fr = rev - __builtin_floorf(rev);
            ROPE[e] = (f32x2){__builtin_amdgcn_cosf(fr), __builtin_amdgcn_sinf(fr)}; }
    }
    SEAM(0);
    for (int l = 0; l < 2; ++l) {
        const int pb = 2 + 12 * l;
        if (INL(0)) {
            PHASE_LOCALS
            pg8::Gemm g{opq(XB), opq(WIN + (size_t)l * NIN * DM), MROWS, NIN, DM}; pg8::StaticOrder S; S.init(MROWS, NIN, G, bx); pg8::EpiProjRope E{PROJ, SSQ + (3 * l) * MROWS, ROPE, q_norm + l * 128, k_norm + l * 128};
            for (int rep = 0; rep < REP_G1; ++rep) pg8::gemm_phase<pg8::EpiProjRope, pg8::StaticOrder, true, true>(lds, lds + XL_OFF, g, S, E);
        }
        SEAM(pb + 0);
        if (INL(2)) {
            PHASE_LOCALS
#define ATT_UNITS(FIXM_) \
            for (int rep = 0; rep < REP_ATT; ++rep) \
            for (int pass = 0; pass < 2; ++pass) \
                for (int u = vcu; u < 512; u += G) { \
                    int rowbase, h, qb, keys; \
                    if (pass == 0) { const int seq = u >> 7, rem = u & 127; h = rem >> 3; qb = rem & 7; rowbase = seq * 2048; keys = 2048; } \
                    else { h = u >> 5; qb = u & 31; rowbase = 8192; keys = 8192; } \
                    const bf16_t* Qb = PROJ + (size_t)(rowbase + qb * 256) * NIN + 8192 + h * 128; \
                    const bf16_t* Kh = PROJ + (size_t)rowbase * NIN + 10240 + (h >> 2) * 128; \
                    bf16_t* Ob = MIX + (size_t)(rowbase + qb * 256) * DM + 2048 + h * 128; \
                    att::attn_dense_body<NIN, NIN, DM, FIXM_>(Qb, Kh, Kh + 512, Ob, keys, lds); \
                    __syncthreads(); \
                }
            if (LG2[64 + l] == 0.f) { ATT_UNITS(true) }
            else { ATT_UNITS(false) }
#undef ATT_UNITS
            for (int rep = 0; rep < REP_R1; ++rep)
            for (int it = vcu; it < 2048; it += G) {
                int r0, h;
                if (it < 1024) { const int sh = it >> 4, c = it & 15; h = sh & 15; r0 = (sh >> 4) * 2048 + c * 128; }
                else { const int i2 = it - 1024; h = i2 >> 6; r0 = 8192 + (i2 & 63) * 128; }
                const float lf2 = LG2[(l * 2 + 0) * 16 + h], lb2 = LG2[(l * 2 + 1) * 16 + h];
                ret_state_item(lds, PROJ, UU, r0, h, it, lf2, lb2);
            }
        }
        SEAM(pb + 2);
        if (INL(3)) {
            PHASE_LOCALS
            for (int rep = 0; rep < REP_R2; ++rep)
            for (int task = bx * NTHREADS + tid; task < 80 * 2 * 2048; task += G * NTHREADS) {
                const int e8 = task & 2047, dir = (task >> 11) & 1, sh = task >> 12;
                const int h = sh & 15, nc = sh < 64 ? 16 : 64, ibase = sh < 64 ? sh * 16 : 1024 + (sh - 64) * 64;
                const float dC = __builtin_amdgcn_exp2f(LG2[(l * 2 + dir) * 16 + h] * 128.0f);
                bf16_t* sp = SS + ((size_t)dir * 2048 + ibase) * 16384 + e8 * 8;
                f32x4 s0 = {0.f, 0.f, 0.f, 0.f}, s1 = s0;
                for (int cb = 0; cb < nc; cb += 8) {
                    u32x4 uv[8];
#pragma unroll
                    for (int k = 0; k < 8; ++k) { const int c = dir ? nc - 1 - (cb + k) : cb + k; uv[k] = *(const u32x4*)(sp + (size_t)c * 16384); }
#pragma unroll
                    for (int k = 0; k < 8; ++k) { const int c = dir ? nc - 1 - (cb + k) : cb + k;
                        u32x4 w; w.x = cvt_pk_bf16(s0[0], s0[1]); w.y = cvt_pk_bf16(s0[2], s0[3]); w.z = cvt_pk_bf16(s1[0], s1[1]); w.w = cvt_pk_bf16(s1[2], s1[3]); *(u32x4*)(sp + (size_t)c * 16384) = w;
                        s0 = s0 * dC + (f32x4){bf_lo(uv[k].x), bf_hi(uv[k].x), bf_lo(uv[k].y), bf_hi(uv[k].y)}; s1 = s1 * dC + (f32x4){bf_lo(uv[k].z), bf_hi(uv[k].z), bf_lo(uv[k].w), bf_hi(uv[k].w)}; }
                }
            }
        }
        SEAM(pb + 3);
        if (INL(4)) {
            PHASE_LOCALS
            for (int rep = 0; rep < REP_R3; ++rep) ret_out_phase(lds, PROJ, SS, MIX, LG2 + l * 32, vcu, G);
        }
        SEAM(pb + 4);
        if (INL(5)) {
            PHASE_LOCALS
            pg8::Gemm g{opq(MIX), opq(WOUT + (size_t)l * DM * DM), MROWS, DM, DM}; pg8::StaticOrder S; S.init(MROWS, DM, G, bx);
            pg8::EpiRes E{XB, SSQ + (3 * l + 1) * MROWS};
            if (XTRA_G2NULL) { pg8::EpiNull E0{(float*)UU}; pg8::gemm_phase<pg8::EpiNull, pg8::StaticOrder, true, true>(lds, lds + XL_OFF, g, S, E0); }
            if (XTRA_G2) { pg8::EpiRes E2{(bf16_t*)UU, (unsigned long long*)HB}; pg8::gemm_phase<pg8::EpiRes, pg8::StaticOrder, true, true>(lds, lds + XL_OFF, g, S, E2); }
            pg8::gemm_phase<pg8::EpiRes, pg8::StaticOrder, true, true>(lds, lds + XL_OFF, g, S, E);
        }
        SEAM(pb + 5);
        if (INL(6)) {
            PHASE_LOCALS
            if (l == 0) {
                if (bx >= 128) { pg8::Gemm g{opq(MEMB), opq(WCKV), MEMROWS, 2048, DM}; pg8::StaticOrder S; S.init(MEMROWS, 2048, G - 128, bx - 128); pg8::EpiProj E{MKV, 2048, nullptr, MEMSS, nullptr, nullptr, 0};
                    pg8::gemm_phase<pg8::EpiProj, pg8::StaticOrder, true, true>(lds, lds + XL_OFF, g, S, E); }
                else { pg8::Gemm g{opq(XB), opq(WCQ + (size_t)l * MEMW * DM), MROWS, MEMW, DM}; pg8::StaticOrder S; S.init(MROWS, MEMW, G, bx); pg8::EpiProj E{CQ, MEMW, SSQ + (3 * l + 1) * MROWS, nullptr, nullptr, nullptr, 0};
                    pg8::gemm_phase<pg8::EpiProj, pg8::StaticOrder, true, true>(lds, lds + XL_OFF, g, S, E); }
            } else {
                pg8::Gemm g{opq(XB), opq(WCQ + (size_t)l * MEMW * DM), MROWS, MEMW, DM}; pg8::SplitLastOrder S; S.init(MROWS, MEMW, G, bx); S.full = (G == 256) ? 0 : 1000000; S.ntl = DM / 64;
                pg8::EpiProj E{CQ, MEMW, SSQ + (3 * l + 1) * MROWS, nullptr, (unsigned long long*)UU, ctl + CW_SPLIT + (2 + l) * 128 * 16, bx & 127};
                pg8::gemm_phase<pg8::EpiProj, pg8::SplitLastOrder, true, true>(lds, lds + XL_OFF, g, S, E);
            }
        }
        SEAM(pb + 6);
        if (INL(7)) {
            PHASE_LOCALS
            for (int rep = 0; rep < REP_SMALL; ++rep)
            for (int u = vcu; u < 256; u += G) { const int rb = u >> 2, h = u & 3, b = rb < 32 ? (rb >> 3) : 4;
                const bf16_t* Kh = MKV + (size_t)(b * 256) * 2048 + l * 1024 + h * 128;
                att::attn_dense_body<MEMW, 2048, MEMW>(CQ + (size_t)(rb * 256) * MEMW + h * 128, Kh, Kh + 512, CO + (size_t)(rb * 256) * MEMW + h * 128, 256, lds);
                __syncthreads(); }
        }
        SEAM(pb + 7);
        if (INL(8)) {
            PHASE_LOCALS
            pg8::Gemm g{opq(CO), opq(WCO + (size_t)l * DM * MEMW), MROWS, DM, MEMW}; pg8::StaticOrder S; S.init(MROWS, DM, G, bx);
            pg8::EpiRes E{XB, SSQ + (3 * l + 2) * MROWS};
            if (XTRA_G4) { pg8::EpiRes E2{(bf16_t*)UU, (unsigned long long*)HB}; pg8::gemm_phase<pg8::EpiRes, pg8::StaticOrder, true, true>(lds, lds + XL_OFF, g, S, E2); }
            pg8::gemm_phase<pg8::EpiRes, pg8::StaticOrder, true, true>(lds, lds + XL_OFF, g, S, E);
        }
        SEAM(pb + 8);
        if (INL(9)) {
            PHASE_LOCALS
            pg8::Gemm g{opq(XB), opq(WUP + (size_t)l * NUP * DM), MROWS, NUP, DM}; pg8::SplitLastOrder S; S.init(MROWS, NUP, G, bx); S.full = (G == 256) ? 21 : 1000000; S.ntl = DM / 64;
            pg8::EpiConv E{wsp, WS_GH, WS_HB, WS_CTL + CTL_SSQ + (size_t)(3 * l + 2) * MROWS * 8, conv_w + (size_t)l * 3 * NUP, conv_b + (size_t)l * NUP, (unsigned long long*)UU, ctl + CW_SPLIT + l * 128 * 16, bx & 127};
            if (PROBE == 19 || PROBE == 20) { pg8::AliasOrder SA; SA.init(MROWS, NUP, G, bx); SA.am = PROBE == 20 ? 7 : ~0; SA.an = PROBE == 19 ? 3 : ~0; pg8::EpiNull E0{(float*)UU}; pg8::gemm_phase<pg8::EpiNull, pg8::AliasOrder, true, true>(lds, lds + XL_OFF, g, SA, E0); }
            if (PROBE == 22) { { u32x4* zp = (u32x4*)(wsp + WS_U); const size_t n16 = (WS_END - WS_U) / 16; const u32x4 z = {0u, 0u, 0u, 0u}; for (size_t i = (size_t)bx * NTHREADS + tid; i < n16; i += (size_t)G * NTHREADS) zp[i] = z; __syncthreads(); } pg8::EpiNull E0{(float*)UU}; pg8::gemm_phase<pg8::EpiNull, pg8::StaticOrder, true, true>(lds, lds + XL_OFF, g, S, E0); }
            if (PROBE == 23) { pg8::EpiNull E0{(float*)UU}; pg8::gemm_phase<pg8::EpiNull, pg8::StaticOrder, true, true>(lds, lds + XL_OFF, g, S, E0); { u32x4* zp = (u32x4*)(wsp + WS_U); const size_t n16 = (WS_END - WS_U) / 16; const u32x4 z = {0u, 0u, 0u, 0u}; for (size_t i = (size_t)bx * NTHREADS + tid; i < n16; i += (size_t)G * NTHREADS) zp[i] = z; __syncthreads(); } }
            if (XTRA_G5NULL) { pg8::EpiNull E0{(float*)UU}; pg8::gemm_phase<pg8::EpiNull, pg8::StaticOrder, true, true>(lds, lds + XL_OFF, g, S, E0); }
            if (XTRA_G5P) { pg8::EpiProj E2{PROJ, NIN, SSQ + (3 * l + 2) * MROWS, nullptr, nullptr, nullptr, 0}; pg8::gemm_phase<pg8::EpiProj, pg8::StaticOrder, true, true>(lds, lds + XL_OFF, g, S, E2); }
            for (int rep = 0; rep < REP_G5; ++rep) pg8::gemm_phase<pg8::EpiConv, pg8::SplitLastOrder, true, true>(lds, lds + XL_OFF, g, S, E);
            if (XTRA_HOTG2) { pg8::Gemm g2{opq(MIX), opq(WOUT + (size_t)l * DM * DM), MROWS, DM, DM}; pg8::StaticOrder S2; S2.init(MROWS, DM, G, bx);
                pg8::EpiRes E2{(bf16_t*)UU, (unsigned long long*)(UU + (size_t)MROWS * DM)}; pg8::gemm_phase<pg8::EpiRes, pg8::StaticOrder, true, true>(lds, lds + XL_OFF, g2, S2, E2); }
        }
        SEAM(pb + 9);
        if (INL(10)) {
            PHASE_LOCALS
            const float* cw = conv_w + (size_t)l * 3 * NUP; const float* cbp = conv_b + (size_t)l * NUP;
            for (int rep = 0; rep < REP_SMALL; ++rep)
            for (int task = bx * NTHREADS + tid; task < 128 * (DFF / 4); task += G * NTHREADS) {
                const int cq = task % (DFF / 4), rt = task / (DFF / 4), pm = rt >> 1, which = rt & 1, c = cq * 4;
                const bool is_start = (pm % 8 == 0) && (pm <= 32), is_end = ((pm % 8 == 7) && (pm < 32)) || (pm == 63);
                const float* hp; const float* hc; const float* hn; bool zp = false, zn = false;
                if (which == 0) { hp = HB + (size_t)((pm > 0 ? pm - 1 : 0) * 4 + 3) * NUP; zp = is_start; hc = HB + (size_t)(pm * 4 + 0) * NUP; hn = HB + (size_t)(pm * 4 + 1) * NUP; }
                else { hp = HB + (size_t)(pm * 4 + 2) * NUP; hc = HB + (size_t)(pm * 4 + 3) * NUP; hn = HB + (size_t)((pm < 63 ? pm + 1 : 63) * 4 + 0) * NUP; zn = is_end; }
                const f32x4 z4 = {0.f, 0.f, 0.f, 0.f};
                const f32x4 pa = zp ? z4 : *(const f32x4*)(hp + c), pu = zp ? z4 : *(const f32x4*)(hp + DFF + c);
                const f32x4 ca = *(const f32x4*)(hc + c), cu = *(const f32x4*)(hc + DFF + c);
                f32x4 na = zn ? z4 : *(const f32x4*)(hn + c), nu = zn ? z4 : *(const f32x4*)(hn + DFF + c);
                f32x4 w0a = *(const f32x4*)(cw + c), w1a = *(const f32x4*)(cw + NUP + c), w2a = *(const f32x4*)(cw + 2 * NUP + c), bba = *(const f32x4*)(cbp + c);
                f32x4 w0u = *(const f32x4*)(cw + DFF + c), w1u = *(const f32x4*)(cw + NUP + DFF + c), w2u = *(const f32x4*)(cw + 2 * NUP + DFF + c), bbu = *(const f32x4*)(cbp + DFF + c);
                asm volatile("" : "+v"(na), "+v"(nu), "+v"(w0a), "+v"(w1a), "+v"(w2a), "+v"(bba), "+v"(w0u), "+v"(w1u), "+v"(w2u), "+v"(bbu));
                const f32x4 va = w0a * pa + w1a * ca + w2a * na + bba;
                const f32x4 vu = w0u * pu + w1u * cu + w2u * nu + bbu;
                const f32x2 g0 = pg8::gelu_pk((f32x2){va[0], va[1]}), g1 = pg8::gelu_pk((f32x2){va[2], va[3]});
                u32x2 w; w.x = cvt_pk_bf16(g0.x * vu[0], g0.y * vu[1]); w.y = cvt_pk_bf16(g1.x * vu[2], g1.y * vu[3]);
                *(u32x2*)(GH + (size_t)(pm * 256 + (which ? 255 : 0)) * DFF + c) = w;
            }
        }
        SEAM(pb + 10);
        if (INL(11)) {
            PHASE_LOCALS
            pg8::Gemm g{opq(GH), opq(WDOWN + (size_t)l * DM * DFF), MROWS, DM, DFF}; pg8::StaticOrder S; S.init(MROWS, DM, G, bx, 1);
            if (XTRA_G6) { pg8::EpiRes E2{(bf16_t*)UU, (unsigned long long*)HB}; pg8::gemm_phase<pg8::EpiRes, pg8::StaticOrder, true, true>(lds, lds + XL_OFF, g, S, E2); }
            if (FUSE_FINAL && l == 1) { pg8::EpiResFinal E{XB, SSQ + (3 * l + 3) * MROWS, ctl + CW_FIN, norm_final, XRES}; pg8::gemm_phase<pg8::EpiResFinal, pg8::StaticOrder, true, true>(lds, lds + XL_OFF, g, S, E); }
            else { pg8::EpiRes E{XB, SSQ + (3 * l + 3) * MROWS}; pg8::gemm_phase<pg8::EpiRes, pg8::StaticOrder, true, true>(lds, lds + XL_OFF, g, S, E); }
        }
        if (!(FUSE_FINAL && l == 1)) SEAM(pb + 11);
    }
    if (N_LAUNCHES == 1) for (int i = 0; i < XTRA_BARS; ++i) xcd_barrier(bar);
    if (INF && !FUSE_FINAL) {
        PHASE_LOCALS
        for (int rep = 0; rep < REP_SMALL; ++rep)
        for (int m = gw; m < MROWS; m += NGW) { const float rs = __builtin_amdgcn_rsqf((float)SSQ[6 * MROWS + m] * (1.0f / 1048576.0f / 4096.0f) + EPS);
            const u32x4* xr = (const u32x4*)(XB + (size_t)m * DM) + lane; f32x4* orow = (f32x4*)(XRES + (size_t)m * DM); const f32x4* gp = (const f32x4*)norm_final;
#pragma unroll
            for (int j = 0; j < 8; ++j) { const u32x4 x = __builtin_nontemporal_load(xr + 64 * j); const int c4 = (64 * j + lane) * 2;
                const f32x4 g0 = gp[c4], g1 = gp[c4 + 1];
                __builtin_nontemporal_store((f32x4){bf_lo(x.x), bf_hi(x.x), bf_lo(x.y), bf_hi(x.y)} * rs * g0, orow + c4);
                __builtin_nontemporal_store((f32x4){bf_lo(x.z), bf_hi(x.z), bf_lo(x.w), bf_hi(x.w)} * rs * g1, orow + c4 + 1); } }
    }
    if (PT_MASK) { PT_MARK(13, 0); if (bx == 0) { const unsigned long long until_ = wall_clock64() + (unsigned long long)PT_K * pt_acc; while (wall_clock64() < until_) __builtin_amdgcn_s_sleep(8); } }
#undef INR
#undef SEAM
}

extern "C" void kernel_launch(void* const* d_in, const int* in_sizes, int n_in, void* d_out, int out_size, void* d_ws, size_t ws_size, hipStream_t stream) {
    static int grid = 0;
    if (grid == 0) {
        if (n_in != 21 || out_size != MROWS * DM || ws_size < WS_END) { fprintf(stderr, "kernel_launch: unexpected shapes: n_in %d out %d ws %zu (need %zu)\n", n_in, out_size, ws_size, (size_t)WS_END); grid = -1; return; }
        int dev = 0, cus = 0, per_cu = 0;
        if (hipGetDevice(&dev) != hipSuccess || hipDeviceGetAttribute(&cus, hipDeviceAttributeMultiprocessorCount, dev) != hipSuccess) { grid = -1; return; }
        if (hipFuncSetAttribute((const void*)trunk_fwd, hipFuncAttributeMaxDynamicSharedMemorySize, LDS_BYTES) != hipSuccess) { fprintf(stderr, "kernel_launch: hipFuncSetAttribute failed\n"); grid = -1; return; }
        if (hipOccupancyMaxActiveBlocksPerMultiprocessor(&per_cu, (const void*)trunk_fwd, NTHREADS, LDS_BYTES) != hipSuccess || per_cu < 1) fprintf(stderr, "kernel_launch: occupancy query reports %d blocks per CU\n", per_cu);
        (void)hipGetLastError();
        grid = cus;
    }
    if (grid < 0) return;
    if (hipMemsetAsync((char*)d_ws + WS_CTL, 0, CTL_ZERO_BYTES, stream) != hipSuccess) { fprintf(stderr, "kernel_launch: memset failed\n"); return; }
    Args a{};
    for (int i = 0; i < 21; ++i) a.in[i] = (const float*)d_in[i];
    a.out = (float*)d_out; a.ws = (unsigned char*)d_ws;
    if (N_LAUNCHES == 1) { a.ph_lo = 0; a.ph_hi = NPHASES; hipLaunchKernelGGL(trunk_fwd, dim3(grid), dim3(NTHREADS), LDS_BYTES, stream, a); }
    else for (int p = 0; p < NPHASES; ++p) { a.ph_lo = p; a.ph_hi = p + 1; hipLaunchKernelGGL(trunk_fwd, dim3(grid), dim3(NTHREADS), LDS_BYTES, stream, a); }
    const hipError_t le = hipPeekAtLastError();
    if (le != hipSuccess) fprintf(stderr, "kernel_launch: launch failed: %s\n", hipGetErrorName(le));
}
```
